# Optimizing an MI355X kernel written in HIP

```python
import jax
import jax.numpy as jnp
from jax import lax
import numpy as np

D_MODEL = 1024
BATCH = 32
SEQ = 2048
DEPTH = 1

CHUNK = 64
Q_BLOCK = 128
PLE_DIM = 256
EPS = 1e-6
ROPE_THETA = 500000.0

RET_HEADS = 8
RET_DK = 64
RET_DV = 64
RET_THETA = 10000.0
RET_W = RET_HEADS * RET_DV

DSA_HEADS = 8
DSA_HEAD_DIM = 64
DSA_ROPE = DSA_HEAD_DIM // 4
DSA_NOPE = DSA_HEAD_DIM - DSA_ROPE
DSA_LATENT = 128
DSA_VDIM = 64
DSA_W = DSA_HEADS * DSA_VDIM
TOPK_MAX = 256

IDX_HEADS = 8
IDX_DIM = 32
IDX_ROPE = IDX_DIM // 4

MIX_W = RET_W + DSA_W

IN_SPLITS = (RET_HEADS * RET_DK, RET_HEADS * RET_DK, RET_W, RET_W,
             DSA_HEADS * DSA_HEAD_DIM, DSA_LATENT, DSA_ROPE, DSA_W,
             IDX_HEADS * IDX_DIM, IDX_DIM, IDX_HEADS)
IN_WIDTH = sum(IN_SPLITS)

kernel_name = "hybrid_retention_dsa_block"


def rms_norm(x, g):
    xf = x.astype(jnp.float32)
    y = xf * lax.rsqrt(jnp.mean(xf * xf, -1, keepdims=True) + EPS)
    return (y * g.astype(jnp.float32)).astype(x.dtype)


def head_group_norm(o, g):
    of = o.astype(jnp.float32)
    mu = jnp.mean(of, -1, keepdims=True)
    var = jnp.mean(jnp.square(of - mu), -1, keepdims=True)
    y = ((of - mu) * lax.rsqrt(var + EPS)).reshape(o.shape[:-2] + (-1,))
    return (y * g.astype(jnp.float32)).astype(o.dtype)


def rotary(x, pos, theta):
    r = x.shape[-1]
    inv = theta ** (-jnp.arange(0, r, 2, dtype=jnp.float32) / r)
    ang = pos.astype(jnp.float32)[:, None] * inv[None, :]
    shape = (ang.shape[0],) + (1,) * (x.ndim - 3) + (r // 2,)
    cos = jnp.cos(ang).reshape(shape)
    sin = jnp.sin(ang).reshape(shape)
    xf = x.astype(jnp.float32)
    x1, x2 = xf[..., : r // 2], xf[..., r // 2:]
    out = jnp.concatenate([x1 * cos - x2 * sin, x2 * cos + x1 * sin], -1)
    return out.astype(x.dtype)


def partial_rotary(x, pos, n_rot, theta):
    return jnp.concatenate([rotary(x[..., :n_rot], pos, theta), x[..., n_rot:]], -1)


def retention(q, k, v):
    B, S, H, dk = q.shape
    dv = v.shape[-1]
    nC = S // CHUNK
    dt = q.dtype
    log_g = jnp.log1p(-jnp.exp2(-5.0 - jnp.arange(H, dtype=jnp.float32)))
    n = jnp.arange(CHUNK, dtype=jnp.float32)
    intra = jnp.exp(log_g[:, None, None] * jnp.abs(n[:, None] - n[None, :]))
    zeta = jnp.exp(log_g[:, None] * (CHUNK - 1 - n)[None, :])
    xi = jnp.exp(log_g[:, None] * (n + 1.0)[None, :])
    chunk_decay = jnp.exp(log_g * CHUNK)[:, None, None]

    qc = q.reshape(B, nC, CHUNK, H, dk) * (dk ** -0.5)
    kc = k.reshape(B, nC, CHUNK, H, dk)
    vc = v.reshape(B, nC, CHUNK, H, dv)

    scores = jnp.einsum('bcnhd,bcmhd->bchnm', qc, kc) * intra.astype(dt)
    o_intra = jnp.einsum('bchnm,bcmhe->bcnhe', scores, vc)

    kv = jnp.einsum('bcmhd,bcmhe,hm->cbhde', kc, vc, zeta.astype(dt)).astype(jnp.float32)

    def step(state, kv_c):
        return chunk_decay * state + kv_c, state

    _, prev = lax.scan(step, jnp.zeros((B, H, dk, dv), jnp.float32), kv)
    o_cross = jnp.einsum('bcnhd,cbhde,hn->bcnhe', qc, prev.astype(dt), xi.astype(dt))
    return (o_intra + o_cross).reshape(B, S, H, dv)


def sparse_attention(q_nope, q_pe, c_kv, k_pe, q_idx, k_idx, w_idx, w_uk, w_uv):
    B, S = c_kv.shape[:2]
    n_sel = min(TOPK_MAX, S // 4)
    n_blk = S // Q_BLOCK
    q_lat = jnp.einsum('bshn,hnc->bshc', q_nope, w_uk)
    key_chunk = jnp.arange(S) // CHUNK
    scale = DSA_HEAD_DIM ** -0.5
    idx_scale = IDX_DIM ** -0.5
    gather = jax.vmap(lambda table, ids: table[ids])

    def to_blocks(a):
        return jnp.moveaxis(a.reshape((B, n_blk, Q_BLOCK) + a.shape[2:]), 1, 0)

    def block(args):
        blk, ql, qp, qi, wi = args
        t = blk * Q_BLOCK + jnp.arange(Q_BLOCK)
        valid = key_chunk[None, :] <= (t // CHUNK)[:, None]
        rel = jax.nn.relu(jnp.einsum('bthd,bsd->bths', qi, k_idx) * idx_scale)
        score = jnp.einsum('bth,bths->bts', wi, rel).astype(jnp.float32)
        score = jnp.where(valid[None], score, -jnp.inf)
        top_val, top_idx = lax.top_k(score, n_sel)
        sel_ok = jnp.isfinite(top_val)
        c_sel = gather(c_kv, top_idx)
        pe_sel = gather(k_pe, top_idx)
        logits = (jnp.einsum('bthc,btkc->bthk', ql, c_sel)
                  + jnp.einsum('bthr,btkr->bthk', qp, pe_sel)).astype(jnp.float32) * scale
        logits = jnp.where(sel_ok[:, :, None, :], logits, -jnp.inf)
        prob = jax.nn.softmax(logits, axis=-1).astype(c_kv.dtype)
        o_lat = jnp.einsum('bthk,btkc->bthc', prob, c_sel)
        return jnp.einsum('bthc,hcd->bthd', o_lat, w_uv)

    out = lax.map(block, (jnp.arange(n_blk), to_blocks(q_lat), to_blocks(q_pe),
                          to_blocks(q_idx), to_blocks(w_idx)))
    return jnp.moveaxis(out, 0, 1).reshape(B, S, DSA_HEADS, DSA_VDIM)


def setup_inputs(seed: int = 0) -> dict:
    key = jax.random.key(seed)
    ks = jax.random.split(key, 13)
    f32 = jnp.float32

    def normal(k, shape, scale):
        return jax.random.normal(k, shape, f32) * scale

    def gain(k, shape):
        return 1.0 + 0.01 * jax.random.normal(k, shape, f32)

    return {
        "x": normal(ks[0], (BATCH, SEQ, D_MODEL), 1.0),
        "p": normal(ks[1], (DEPTH, BATCH, SEQ, PLE_DIM), 1.0),
        "positions": jnp.arange(SEQ, dtype=jnp.int32),
        "norm_mix": gain(ks[2], (DEPTH, D_MODEL)),
        "w_in": normal(ks[3], (DEPTH, D_MODEL, IN_WIDTH), D_MODEL ** -0.5),
        "ret_norm": gain(ks[4], (DEPTH, RET_W)),
        "kv_norm": gain(ks[5], (DEPTH, DSA_LATENT)),
        "w_uk": normal(ks[6], (DEPTH, DSA_HEADS, DSA_NOPE, DSA_LATENT), DSA_NOPE ** -0.5),
        "w_uv": normal(ks[7], (DEPTH, DSA_HEADS, DSA_LATENT, DSA_VDIM), DSA_LATENT ** -0.5),
        "w_out": normal(ks[8], (DEPTH, MIX_W, D_MODEL), MIX_W ** -0.5),
        "norm_ple": gain(ks[9], (DEPTH, D_MODEL)),
        "w_ple_gate": normal(ks[10], (DEPTH, D_MODEL, D_MODEL), D_MODEL ** -0.5),
        "w_ple_proj": normal(ks[11], (DEPTH, PLE_DIM, D_MODEL), PLE_DIM ** -0.5),
        "norm_final": gain(ks[12], (D_MODEL,)),
    }


def reference(x, p, positions, norm_mix, w_in, ret_norm, kv_norm, w_uk, w_uv, w_out,
              norm_ple, w_ple_gate, w_ple_proj, norm_final):
    B, S, _ = x.shape
    split_at = np.cumsum(IN_SPLITS)[:-1].tolist()
    for i in range(DEPTH):
        h = rms_norm(x, norm_mix[i])
        proj = h @ w_in[i]
        (r_q, r_k, r_v, r_g, d_q, d_c, d_pe, d_g,
         i_q, i_k, i_w) = jnp.split(proj, split_at, axis=-1)

        r_q = rotary(r_q.reshape(B, S, RET_HEADS, RET_DK), positions, RET_THETA)
        r_k = rotary(r_k.reshape(B, S, RET_HEADS, RET_DK), positions, RET_THETA)
        r_v = r_v.reshape(B, S, RET_HEADS, RET_DV)
        ret = head_group_norm(retention(r_q, r_k, r_v), ret_norm[i]) * jax.nn.silu(r_g)

        d_q = d_q.reshape(B, S, DSA_HEADS, DSA_HEAD_DIM)
        q_pe = rotary(d_q[..., :DSA_ROPE], positions, ROPE_THETA)
        q_nope = d_q[..., DSA_ROPE:]
        c_kv = rms_norm(d_c, kv_norm[i])
        k_pe = rotary(d_pe, positions, ROPE_THETA)
        q_idx = partial_rotary(i_q.reshape(B, S, IDX_HEADS, IDX_DIM), positions, IDX_ROPE, ROPE_THETA)
        k_idx = partial_rotary(i_k, positions, IDX_ROPE, ROPE_THETA)
        w_idx = i_w * (IDX_HEADS ** -0.5)
        dsa = sparse_attention(q_nope, q_pe, c_kv, k_pe, q_idx, k_idx, w_idx,
                               w_uk[i], w_uv[i]).reshape(B, S, DSA_W) * jax.nn.silu(d_g)

        x = x + jnp.concatenate([ret, dsa], axis=-1) @ w_out[i]

        gate = jax.nn.sigmoid(rms_norm(x, norm_ple[i]) @ w_ple_gate[i])
        x = x + gate * (p[i] @ w_ple_proj[i])
    return rms_norm(x, norm_final)
```

```cpp
#include <hip/hip_runtime.h>
#include <stdint.h>

typedef _Float16 h16;
typedef h16 h16x8 __attribute__((ext_vector_type(8)));
typedef h16 h16x4 __attribute__((ext_vector_type(4)));
typedef h16 h16x2 __attribute__((ext_vector_type(2)));

constexpr int BATCH = 32, SEQ = 2048, DM = 1024, MTOK = BATCH * SEQ;
constexpr int NP = 3584;
constexpr int PLE = 256;
constexpr float EPS = 1e-6f;
constexpr int C_RQ = 0, C_RK = 512, C_RV = 1024, C_RG = 1536, C_QPE = 2048, C_QN = 2176, C_CKV = 2560, C_KPE = 2688, C_KI = 2704, C_IW = 2736,
              C_DG = 2752, C_IQ = 3264, C_END = 3520;
constexpr int NFREQ = 44;

constexpr size_t MiB = 1u << 20;
constexpr size_t WS_CTL = 0;
constexpr size_t CTL_BYTES = 1 * MiB;
constexpr size_t WS_TAB = 1 * MiB;
constexpr size_t WS_WIN = 2 * MiB;
constexpr size_t WS_WOUT = 10 * MiB;
constexpr size_t WS_WG = 12 * MiB;
constexpr size_t WS_WP = 14 * MiB;
constexpr size_t WS_A0 = 16 * MiB;
constexpr size_t WS_P16 = 144 * MiB;
constexpr size_t WS_PROJ = 176 * MiB;
constexpr size_t WS_MIX = 624 * MiB;
constexpr size_t WS_PP = 752 * MiB;
constexpr size_t WS_IDX = 880 * MiB;
constexpr size_t WS_END = 912 * MiB;

__host__ __device__ inline int orig_col(int n) {
    if (n < 1024) { int h = (n & 511) >> 6, j = n & 63, i = j >> 1, b = j & 1; return (n & 512) + 64 * h + i + 32 * b; }
    if (n < 2048) return n;
    if (n < 2176) { int j = n - 2048, h = j >> 4, jj = j & 15, i = jj >> 1, b = jj & 1; return 2048 + 64 * h + i + 8 * b; }
    if (n < 2560) { int j = n - 2176, h = j / 48, jj = j % 48; return 2048 + 64 * h + 16 + jj; }
    if (n < 2688) return n;
    if (n < 2704) { int j = n - 2688, i = j >> 1, b = j & 1; return 2688 + i + 8 * b; }
    if (n < 2736) { int j = n - 2704; if (j < 8) { int i = j >> 1, b = j & 1; return 3472 + i + 4 * b; } return 3472 + j; }
    if (n < 2744) return 3504 + (n - 2736);
    if (n < 2752) return -1;
    if (n < 3264) return 2704 + (n - 2752);
    if (n < 3520) { int j = n - 3264, h = j >> 5, jj = j & 31; if (jj < 8) { int i = jj >> 1, b = jj & 1; return 3216 + 32 * h + i + 4 * b; } return 3216 + 32 * h + jj; }
    return -1;
}
__host__ __device__ inline float col_scale(int n) {
    if (n < 512) return 0.125f;
    if (n >= 2048 && n < 2560) return 0.125f;
    if (n >= 2736 && n < 2744) return 0.0625f;
    return 1.0f;
}
__device__ inline int freq_idx(int n) {
    if (n < 1024) return (n & 63) >> 1;
    if (n >= 2048 && n < 2176) return 32 + ((n & 15) >> 1);
    if (n >= 2688 && n < 2704) return 32 + ((n - 2688) >> 1);
    if (n >= 2704 && n < 2712) return 40 + ((n - 2704) >> 1);
    if (n >= 3264 && n < 3520) { int jj = (n - 3264) & 31; if (jj < 8) return 40 + (jj >> 1); }
    return -1;
}
__device__ inline bool is_silu_col(int n) { return (n >= 1536 && n < 2048) || (n >= 2752 && n < 3264); }
__device__ inline float silu_f(float v) { return v / (1.0f + __expf(-v)); }
__device__ inline float sigmoid_f(float v) { return 1.0f / (1.0f + __expf(-v)); }

__device__ inline float wave_sum(float v) {
#pragma unroll
    for (int o = 1; o < 64; o <<= 1) v += __shfl_xor(v, o);
    return v;
}

__global__ void k_tab(const int* __restrict__ pos, float2* __restrict__ tab) {
    int i = blockIdx.x * blockDim.x + threadIdx.x; if (i >= SEQ * NFREQ) return;
    int s = i / NFREQ, f = i % NFREQ;
    float inv;
    if (f < 32) inv = powf(10000.0f, -(float)(2 * f) / 64.0f);
    else if (f < 40) inv = powf(500000.0f, -(float)(2 * (f - 32)) / 16.0f);
    else inv = powf(500000.0f, -(float)(2 * (f - 40)) / 8.0f);
    float ang = (float)pos[s] * inv;
    tab[i] = make_float2(cosf(ang), sinf(ang));
}
__global__ void k_prep_win(const float* __restrict__ w_in, h16* __restrict__ WinT) {
    int n = blockIdx.x; int oc = orig_col(n); float sc = col_scale(n);
    for (int k = threadIdx.x; k < DM; k += blockDim.x) {
        float v = (oc >= 0) ? w_in[(size_t)k * 3512 + oc] * sc : 0.0f;
        WinT[(size_t)n * DM + k] = (h16)v;
    }
}
__global__ void k_prep_wT(const float* __restrict__ in, const float* __restrict__ gk, h16* __restrict__ out, int K, int N) {
    int n = blockIdx.x;
    for (int k = threadIdx.x; k < K; k += blockDim.x) {
        float v = in[(size_t)k * N + n]; if (gk) v *= gk[k];
        out[(size_t)n * K + k] = (h16)v;
    }
}
__global__ void k_prep_rows(const float* __restrict__ x, const float* __restrict__ g, h16* __restrict__ A0) {
    int row = blockIdx.x * 4 + (threadIdx.x >> 6), lane = threadIdx.x & 63;
    const float4* xr = (const float4*)(x + (size_t)row * DM);
    float4 v[4]; float ss = 0.f;
#pragma unroll
    for (int j = 0; j < 4; ++j) { v[j] = xr[lane + 64 * j]; ss += v[j].x * v[j].x + v[j].y * v[j].y + v[j].z * v[j].z + v[j].w * v[j].w; }
    ss = wave_sum(ss);
    float rstd = rsqrtf(ss * (1.0f / DM) + EPS);
    const float4* gr = (const float4*)g;
#pragma unroll
    for (int j = 0; j < 4; ++j) {
        float4 gg = gr[lane + 64 * j];
        h16x4 o; o[0] = (h16)(v[j].x * rstd * gg.x); o[1] = (h16)(v[j].y * rstd * gg.y); o[2] = (h16)(v[j].z * rstd * gg.z); o[3] = (h16)(v[j].w * rstd * gg.w);
        *(h16x4*)(A0 + (size_t)row * DM + (lane + 64 * j) * 4) = o;
    }
}
__global__ void k_cvt_p(const float* __restrict__ p, h16* __restrict__ P16, size_t n4) {
    size_t i = (size_t)blockIdx.x * blockDim.x + threadIdx.x; if (i >= n4) return;
    float4 v = ((const float4*)p)[i]; h16x4 o; o[0] = (h16)v.x; o[1] = (h16)v.y; o[2] = (h16)v.z; o[3] = (h16)v.w;
    ((h16x4*)P16)[i] = o;
}

struct EpiProj {
    h16* proj; const float2* tab;
    __device__ void operator()(int row, int col0, const float (&acc)[4]) const {
        int s = row & (SEQ - 1);
        h16x4 o;
#pragma unroll
        for (int pr = 0; pr < 2; ++pr) {
            int n = col0 + 2 * pr; float v0 = acc[2 * pr], v1 = acc[2 * pr + 1], o0, o1;
            int f = freq_idx(n);
            if (f >= 0) { float2 cs = tab[s * NFREQ + f]; o0 = v0 * cs.x - v1 * cs.y; o1 = v1 * cs.x + v0 * cs.y; }
            else if (is_silu_col(n)) { o0 = silu_f(v0); o1 = silu_f(v1); }
            else { o0 = v0; o1 = v1; }
            o[2 * pr] = (h16)o0; o[2 * pr + 1] = (h16)o1;
        }
        *(h16x4*)(proj + (size_t)row * NP + col0) = o;
    }
};
struct EpiOut {
    const float* x; h16* x1h; float* ssq1;
    __device__ void operator()(int row, int col0, const float (&acc)[4]) const {
        float4 xv = *(const float4*)(x + (size_t)row * DM + col0);
        float a = xv.x + acc[0], b = xv.y + acc[1], c = xv.z + acc[2], d = xv.w + acc[3];
        h16x4 o; o[0] = (h16)a; o[1] = (h16)b; o[2] = (h16)c; o[3] = (h16)d;
        *(h16x4*)(x1h + (size_t)row * DM + col0) = o;
        float ss = a * a + b * b + c * c + d * d;
#pragma unroll
        for (int of = 1; of < 32; of <<= 1) ss += __shfl_xor(ss, of);
        if ((threadIdx.x & 31) == 0) atomicAdd(ssq1 + row, ss);
    }
};
struct EpiPle {
    h16* pp;
    __device__ void operator()(int row, int col0, const float (&acc)[4]) const {
        h16x4 o; o[0] = (h16)acc[0]; o[1] = (h16)acc[1]; o[2] = (h16)acc[2]; o[3] = (h16)acc[3];
        *(h16x4*)(pp + (size_t)row * DM + col0) = o;
    }
};
struct EpiGate {
    const h16* x1h; const h16* pp; const float* ssq1; float* out; float* ssq2;
    __device__ void operator()(int row, int col0, const float (&acc)[4]) const {
        float rstd = rsqrtf(ssq1[row] * (1.0f / DM) + EPS);
        h16x4 xv = *(const h16x4*)(x1h + (size_t)row * DM + col0);
        h16x4 pv = *(const h16x4*)(pp + (size_t)row * DM + col0);
        float4 o; float ss = 0.f;
        float r[4];
#pragma unroll
        for (int i = 0; i < 4; ++i) { r[i] = (float)xv[i] + sigmoid_f(acc[i] * rstd) * (float)pv[i]; ss += r[i] * r[i]; }
        o.x = r[0]; o.y = r[1]; o.z = r[2]; o.w = r[3];
        *(float4*)(out + (size_t)row * DM + col0) = o;
#pragma unroll
        for (int of = 1; of < 32; of <<= 1) ss += __shfl_xor(ss, of);
        if ((threadIdx.x & 31) == 0) atomicAdd(ssq2 + row, ss);
    }
};

template <class Epi>
__global__ void __launch_bounds__(512) k_gemm_nt(const h16* __restrict__ A, const h16* __restrict__ Bt, int K, Epi E) {
    __shared__ float As[32][132];
    __shared__ float Bs[32][132];
    const int tid = threadIdx.x, tx = tid & 31, ty = tid >> 5;
    const int m0 = blockIdx.y * 128, n0 = blockIdx.x * 128;
    const int lr = tid >> 2, lk = (tid & 3) * 8;
    float acc[8][4];
#pragma unroll
    for (int i = 0; i < 8; ++i)
#pragma unroll
        for (int j = 0; j < 4; ++j) acc[i][j] = 0.f;
    for (int k0 = 0; k0 < K; k0 += 32) {
        h16x8 av = *(const h16x8*)(A + (size_t)(m0 + lr) * K + k0 + lk);
        h16x8 bv = *(const h16x8*)(Bt + (size_t)(n0 + lr) * K + k0 + lk);
        __syncthreads();
#pragma unroll
        for (int j = 0; j < 8; ++j) { As[lk + j][lr] = (float)av[j]; Bs[lk + j][lr] = (float)bv[j]; }
        __syncthreads();
#pragma unroll 8
        for (int k = 0; k < 32; ++k) {
            float4 a0 = *(const float4*)&As[k][ty * 8], a1 = *(const float4*)&As[k][ty * 8 + 4];
            float4 b = *(const float4*)&Bs[k][tx * 4];
            float a[8] = {a0.x, a0.y, a0.z, a0.w, a1.x, a1.y, a1.z, a1.w};
            float bb[4] = {b.x, b.y, b.z, b.w};
#pragma unroll
            for (int i = 0; i < 8; ++i)
#pragma unroll
                for (int j = 0; j < 4; ++j) acc[i][j] += a[i] * bb[j];
        }
    }
#pragma unroll
    for (int i = 0; i < 8; ++i) E(m0 + ty * 8 + i, n0 + tx * 4, acc[i]);
}

__global__ void k_fix_ckv(h16* __restrict__ proj, const float* __restrict__ kvn) {
    int row = blockIdx.x * 4 + (threadIdx.x >> 6), lane = threadIdx.x & 63;
    h16x2* pr = (h16x2*)(proj + (size_t)row * NP + C_CKV) + lane;
    h16x2 v = *pr; float a = (float)v[0], b = (float)v[1];
    float ss = wave_sum(a * a + b * b);
    float rstd = rsqrtf(ss * (1.0f / 128.0f) + EPS);
    h16x2 o; o[0] = (h16)(a * rstd * kvn[2 * lane]); o[1] = (h16)(b * rstd * kvn[2 * lane + 1]);
    *pr = o;
}

__global__ void __launch_bounds__(512) k_retention(const h16* __restrict__ proj, const float* __restrict__ ret_norm, h16* __restrict__ mix) {
    extern __shared__ float sm[];
    float* q = sm;
    float* k = q + 64 * 65;
    float* v = k + 64 * 65;
    float* sc = v + 64 * 65;
    float* S = sc + 64 * 65;
    const int b = blockIdx.x >> 3, h = blockIdx.x & 7, tid = threadIdx.x;
    const float log_g = log1pf(-exp2f(-5.0f - (float)h));
    const float cdecay = expf(log_g * 64.0f);
    for (int i = tid; i < 4096; i += 512) S[i] = 0.f;
    const int lt = tid >> 3, lc = (tid & 7) * 8;
    for (int c = 0; c < 32; ++c) {
        const size_t rowbase = (size_t)b * SEQ + c * 64;
        __syncthreads();
        {
            const h16* pr = proj + (rowbase + lt) * NP + h * 64 + lc;
            h16x8 qv = *(const h16x8*)(pr + C_RQ), kv = *(const h16x8*)(pr + C_RK), vv = *(const h16x8*)(pr + C_RV);
#pragma unroll
            for (int j = 0; j < 8; ++j) { q[lt * 65 + lc + j] = (float)qv[j]; k[lt * 65 + lc + j] = (float)kv[j]; v[lt * 65 + lc + j] = (float)vv[j]; }
        }
        __syncthreads();
        {
            float a[8];
#pragma unroll
            for (int j = 0; j < 8; ++j) a[j] = 0.f;
            for (int d = 0; d < 64; ++d) { float qq = q[lt * 65 + d];
#pragma unroll
                for (int j = 0; j < 8; ++j) a[j] += qq * k[(lc + j) * 65 + d]; }
#pragma unroll
            for (int j = 0; j < 8; ++j) { int dm = lt - (lc + j); if (dm < 0) dm = -dm; sc[lt * 65 + lc + j] = a[j] * expf(log_g * (float)dm); }
        }
        __syncthreads();
        float o[8];
        {
            float a[8], cr[8];
#pragma unroll
            for (int j = 0; j < 8; ++j) { a[j] = 0.f; cr[j] = 0.f; }
            for (int m = 0; m < 64; ++m) { float s_ = sc[lt * 65 + m], qq = q[lt * 65 + m];
#pragma unroll
                for (int j = 0; j < 8; ++j) { a[j] += s_ * v[m * 65 + lc + j]; cr[j] += qq * S[m * 64 + lc + j]; } }
            float xi = expf(log_g * (float)(lt + 1));
#pragma unroll
            for (int j = 0; j < 8; ++j) o[j] = a[j] + xi * cr[j];
        }
        {
            float s1 = 0.f;
#pragma unroll
            for (int j = 0; j < 8; ++j) s1 += o[j];
            s1 += __shfl_xor(s1, 1); s1 += __shfl_xor(s1, 2); s1 += __shfl_xor(s1, 4);
            float mu = s1 * (1.0f / 64.0f), s2 = 0.f;
#pragma unroll
            for (int j = 0; j < 8; ++j) { float dlt = o[j] - mu; s2 += dlt * dlt; }
            s2 += __shfl_xor(s2, 1); s2 += __shfl_xor(s2, 2); s2 += __shfl_xor(s2, 4);
            float rstd = rsqrtf(s2 * (1.0f / 64.0f) + EPS);
            h16x8 gate = *(const h16x8*)(proj + (rowbase + lt) * NP + C_RG + h * 64 + lc);
            h16x8 ov;
#pragma unroll
            for (int j = 0; j < 8; ++j) ov[j] = (h16)((o[j] - mu) * rstd * ret_norm[h * 64 + lc + j] * (float)gate[j]);
            *(h16x8*)(mix + (rowbase + lt) * DM + h * 64 + lc) = ov;
        }
        __syncthreads();
        {
            float a[8];
#pragma unroll
            for (int j = 0; j < 8; ++j) a[j] = 0.f;
            for (int m = 0; m < 64; ++m) { float kk = k[m * 65 + lt] * expf(log_g * (float)(63 - m));
#pragma unroll
                for (int j = 0; j < 8; ++j) a[j] += kk * v[m * 65 + lc + j]; }
#pragma unroll
            for (int j = 0; j < 8; ++j) S[lt * 64 + lc + j] = cdecay * S[lt * 64 + lc + j] + a[j];
        }
    }
}

__device__ inline unsigned ord_key(float f) { unsigned u = __float_as_uint(f); return (u & 0x80000000u) ? ~u : (u | 0x80000000u); }

__global__ void __launch_bounds__(512) k_dsa(const h16* __restrict__ proj, const float* __restrict__ w_uk, const float* __restrict__ w_uv, h16* __restrict__ mix) {
    __shared__ unsigned keys[2048];
    __shared__ unsigned short list[256];
    __shared__ float qidx[8][32];
    __shared__ float widx[8];
    __shared__ float qlat[8][128];
    __shared__ float qpe[8][16];
    __shared__ float qn[8][48];
    __shared__ float pbuf[8][256];
    __shared__ float olat[8][128];
    __shared__ int wcnt[2][8];
    __shared__ int wtot[8];
    const int tid = threadIdx.x, lane = tid & 63, wave = tid >> 6;
    const int m = blockIdx.x, b = m >> 11, s = m & (SEQ - 1), c = s >> 6, N = (c + 1) * 64;
    const h16* prow = proj + (size_t)m * NP;
    const h16* pb = proj + (size_t)b * SEQ * NP;
    if (tid < 256) qidx[tid >> 5][tid & 31] = (float)prow[C_IQ + tid];
    if (tid < 8) widx[tid] = (float)prow[C_IW + tid];
    if (tid < 128) qpe[tid >> 4][tid & 15] = (float)prow[C_QPE + tid];
    if (tid < 384) qn[tid / 48][tid % 48] = (float)prow[C_QN + tid];
    __syncthreads();
    for (int o = tid; o < 1024; o += 512) { int h = o >> 7, cc = o & 127; float a = 0.f;
        for (int j = 0; j < 48; ++j) a += qn[h][j] * w_uk[(h * 48 + j) * 128 + cc];
        qlat[h][cc] = a; }
    int L;
    if (N <= 256) {
        L = N;
        if (tid < N) list[tid] = (unsigned short)tid;
    } else {
        L = 256;
        for (int j = tid; j < N; j += 512) {
            const h16* kr = pb + (size_t)j * NP + C_KI;
            float kk[32];
#pragma unroll
            for (int q4 = 0; q4 < 4; ++q4) { h16x8 t8 = *(const h16x8*)(kr + q4 * 8);
#pragma unroll
                for (int e = 0; e < 8; ++e) kk[q4 * 8 + e] = (float)t8[e]; }
            float scv = 0.f;
#pragma unroll 1
            for (int h = 0; h < 8; ++h) { float d = 0.f;
#pragma unroll
                for (int e = 0; e < 32; ++e) d += qidx[h][e] * kk[e];
                scv += widx[h] * fmaxf(d, 0.f); }
            keys[j] = ord_key(scv);
        }
        __syncthreads();
        unsigned mk[4];
#pragma unroll
        for (int i = 0; i < 4; ++i) { int j = 4 * tid + i; mk[i] = (j < N) ? keys[j] : 0u; }
        unsigned T = 0u;
        for (int bit = 31; bit >= 0; --bit) {
            unsigned cand = T | (1u << bit);
            int cnt = 0;
#pragma unroll
            for (int i = 0; i < 4; ++i) cnt += (4 * tid + i < N && mk[i] >= cand) ? 1 : 0;
#pragma unroll
            for (int o = 1; o < 64; o <<= 1) cnt += __shfl_xor(cnt, o);
            if (lane == 0) wcnt[bit & 1][wave] = cnt;
            __syncthreads();
            int tot = 0;
#pragma unroll
            for (int w = 0; w < 8; ++w) tot += wcnt[bit & 1][w];
            if (tot >= 256) T = cand;
        }
        int cg = 0, ce = 0;
#pragma unroll
        for (int i = 0; i < 4; ++i) { bool val = 4 * tid + i < N; cg += (val && mk[i] > T) ? 1 : 0; ce += (val && mk[i] == T) ? 1 : 0; }
        int pk = cg | (ce << 16);
        int inc = pk;
#pragma unroll
        for (int o = 1; o < 64; o <<= 1) { int t2 = __shfl_up(inc, o); if (lane >= o) inc += t2; }
        if (lane == 63) wtot[wave] = inc;
        __syncthreads();
        int off = 0, total = 0;
#pragma unroll
        for (int w = 0; w < 8; ++w) { int t2 = wtot[w]; if (w < wave) off += t2; total += t2; }
        int exc = off + inc - pk;
        int gbef = exc & 0xffff, ebef = exc >> 16;
        int need = 256 - (total & 0xffff);
#pragma unroll
        for (int i = 0; i < 4; ++i) {
            int j = 4 * tid + i; if (j >= N) break;
            if (mk[i] > T) { int pos = gbef + (ebef < need ? ebef : need); list[pos] = (unsigned short)j; ++gbef; }
            else if (mk[i] == T) { if (ebef < need) { int pos = gbef + ebef; list[pos] = (unsigned short)j; } ++ebef; }
        }
    }
    __syncthreads();
    {
        const int h = wave;
        float lg[4]; float mx = -INFINITY;
#pragma unroll
        for (int i = 0; i < 4; ++i) {
            int kx = lane + 64 * i; lg[i] = -INFINITY;
            if (kx < L) {
                const h16* kr = pb + (size_t)list[kx] * NP + C_CKV;
                float a = 0.f;
#pragma unroll 2
                for (int q8 = 0; q8 < 16; ++q8) { h16x8 t8 = *(const h16x8*)(kr + q8 * 8);
#pragma unroll
                    for (int e = 0; e < 8; ++e) a += qlat[h][q8 * 8 + e] * (float)t8[e]; }
                for (int q8 = 0; q8 < 2; ++q8) { h16x8 t8 = *(const h16x8*)(kr + 128 + q8 * 8);
#pragma unroll
                    for (int e = 0; e < 8; ++e) a += qpe[h][q8 * 8 + e] * (float)t8[e]; }
                lg[i] = a; mx = fmaxf(mx, a);
            }
        }
#pragma unroll
        for (int o = 1; o < 64; o <<= 1) mx = fmaxf(mx, __shfl_xor(mx, o));
        float sum = 0.f;
#pragma unroll
        for (int i = 0; i < 4; ++i) { lg[i] = (lane + 64 * i < L) ? __expf(lg[i] - mx) : 0.f; sum += lg[i]; }
        sum = wave_sum(sum);
        float inv = 1.0f / sum;
#pragma unroll
        for (int i = 0; i < 4; ++i) pbuf[h][lane + 64 * i] = lg[i] * inv;
    }
    __syncthreads();
    {
        const int h = wave; float a0 = 0.f, a1 = 0.f;
        for (int kx = 0; kx < L; ++kx) {
            const h16* kr = pb + (size_t)list[kx] * NP + C_CKV; float p = pbuf[h][kx];
            a0 += p * (float)kr[lane]; a1 += p * (float)kr[lane + 64];
        }
        olat[h][lane] = a0; olat[h][lane + 64] = a1;
    }
    __syncthreads();
    {
        const int h = wave, d = lane; float a = 0.f;
        for (int cc = 0; cc < 128; ++cc) a += olat[h][cc] * w_uv[(h * 128 + cc) * 64 + d];
        float gate = (float)prow[C_DG + h * 64 + d];
        mix[(size_t)m * DM + 512 + h * 64 + d] = (h16)(a * gate);
    }
}

__global__ void k_final(float* __restrict__ out, const float* __restrict__ ssq2, const float* __restrict__ g) {
    size_t i = (size_t)blockIdx.x * blockDim.x + threadIdx.x;
    size_t row = i >> 8; int c4 = (int)(i & 255);
    float rstd = rsqrtf(ssq2[row] * (1.0f / DM) + EPS);
    float4 v = ((float4*)out)[i]; float4 gg = ((const float4*)g)[c4];
    v.x *= rstd * gg.x; v.y *= rstd * gg.y; v.z *= rstd * gg.z; v.w *= rstd * gg.w;
    ((float4*)out)[i] = v;
}

extern "C" void kernel_launch(void* const* d_in, const int* in_sizes, int n_in, void* d_out, int out_size, void* d_ws, size_t ws_size, hipStream_t stream) {
    const float* x = (const float*)d_in[0];
    const float* p = (const float*)d_in[1];
    const int* positions = (const int*)d_in[2];
    const float* norm_mix = (const float*)d_in[3];
    const float* w_in = (const float*)d_in[4];
    const float* ret_norm = (const float*)d_in[5];
    const float* kv_norm = (const float*)d_in[6];
    const float* w_uk = (const float*)d_in[7];
    const float* w_uv = (const float*)d_in[8];
    const float* w_out = (const float*)d_in[9];
    const float* norm_ple = (const float*)d_in[10];
    const float* w_ple_gate = (const float*)d_in[11];
    const float* w_ple_proj = (const float*)d_in[12];
    const float* norm_final = (const float*)d_in[13];
    float* out = (float*)d_out;
    unsigned char* ws = (unsigned char*)d_ws;
    if (ws_size < WS_END) return;
    float* ssq1 = (float*)(ws + WS_CTL); float* ssq2 = ssq1 + MTOK;
    float2* tab = (float2*)(ws + WS_TAB);
    h16* WinT = (h16*)(ws + WS_WIN); h16* WoutT = (h16*)(ws + WS_WOUT); h16* WgT = (h16*)(ws + WS_WG); h16* WpT = (h16*)(ws + WS_WP);
    h16* A0 = (h16*)(ws + WS_A0); h16* P16 = (h16*)(ws + WS_P16); h16* proj = (h16*)(ws + WS_PROJ); h16* mix = (h16*)(ws + WS_MIX); h16* pp = (h16*)(ws + WS_PP);
    h16* x1h = A0;

    (void)hipMemsetAsync(ws + WS_CTL, 0, CTL_BYTES, stream);
    k_tab<<<(SEQ * NFREQ + 255) / 256, 256, 0, stream>>>(positions, tab);
    k_prep_win<<<NP, 256, 0, stream>>>(w_in, WinT);
    k_prep_wT<<<DM, 256, 0, stream>>>(w_out, nullptr, WoutT, DM, DM);
    k_prep_wT<<<DM, 256, 0, stream>>>(w_ple_gate, norm_ple, WgT, DM, DM);
    k_prep_wT<<<DM, 256, 0, stream>>>(w_ple_proj, nullptr, WpT, PLE, DM);
    k_prep_rows<<<MTOK / 4, 256, 0, stream>>>(x, norm_mix, A0);
    k_cvt_p<<<(MTOK * PLE / 4 + 255) / 256, 256, 0, stream>>>(p, P16, (size_t)MTOK * PLE / 4);
    k_gemm_nt<EpiProj><<<dim3(NP / 128, MTOK / 128), 512, 0, stream>>>(A0, WinT, DM, EpiProj{proj, tab});
    k_fix_ckv<<<MTOK / 4, 256, 0, stream>>>(proj, kv_norm);
    static bool attr_done = false;
    if (!attr_done) { (void)hipFuncSetAttribute((const void*)k_retention, hipFuncAttributeMaxDynamicSharedMemorySize, 96 * 1024); attr_done = true; }
    k_retention<<<BATCH * 8, 512, (4 * 64 * 65 + 64 * 64) * 4, stream>>>(proj, ret_norm, mix);
    k_dsa<<<MTOK, 512, 0, stream>>>(proj, w_uk, w_uv, mix);
    k_gemm_nt<EpiOut><<<dim3(DM / 128, MTOK / 128), 512, 0, stream>>>(mix, WoutT, DM, EpiOut{x, x1h, ssq1});
    k_gemm_nt<EpiPle><<<dim3(DM / 128, MTOK / 128), 512, 0, stream>>>(P16, WpT, PLE, EpiPle{pp});
    k_gemm_nt<EpiGate><<<dim3(DM / 128, MTOK / 128), 512, 0, stream>>>(x1h, WgT, DM, EpiGate{x1h, pp, ssq1, out, ssq2});
    k_final<<<MTOK * (DM / 4) / 256, 256, 0, stream>>>(out, ssq2, norm_final);
}
```

```cpp
#include <hip/hip_runtime.h>
#include <cstdio>
#include <cstdint>

typedef _Float16 h16;
typedef h16 h16x8 __attribute__((ext_vector_type(8)));
typedef h16 h16x4 __attribute__((ext_vector_type(4)));
typedef h16 h16x2 __attribute__((ext_vector_type(2)));

constexpr int BATCH = 32, SEQ = 2048, DM = 1024, MTOK = BATCH * SEQ;
constexpr int NP = 3584;
constexpr int PLE = 256;
constexpr float EPS = 1e-6f;
constexpr int C_RQ = 0, C_RK = 512, C_RV = 1024, C_RG = 1536, C_QPE = 2048, C_QN = 2176, C_CKV = 2560, C_KPE = 2688, C_KI = 2704, C_IW = 2736,
              C_DG = 2752, C_IQ = 3264, C_END = 3520;
constexpr int NFREQ = 44;

constexpr size_t MiB = 1u << 20;
constexpr size_t WS_CTL = 0;
constexpr size_t CTL_BYTES = 1 * MiB;
constexpr size_t WS_TAB = 1 * MiB;
constexpr size_t WS_WIN = 2 * MiB;
constexpr size_t WS_WOUT = 10 * MiB;
constexpr size_t WS_WG = 12 * MiB;
constexpr size_t WS_WP = 14 * MiB;
constexpr size_t WS_A0 = 16 * MiB;
constexpr size_t WS_P16 = 144 * MiB;
constexpr size_t WS_PROJ = 176 * MiB;
constexpr size_t WS_MIX = 624 * MiB;
constexpr size_t WS_PP = 752 * MiB;
constexpr size_t WS_SCR = 880 * MiB;
constexpr size_t WS_WUK = 944 * MiB;
constexpr size_t WS_WUV = 945 * MiB;
constexpr size_t WS_MASK = 946 * MiB;
constexpr size_t WS_END = 962 * MiB;
constexpr int CW_BAR = 131072;

__host__ __device__ inline int orig_col(int n) {
    if (n < 1024) { int h = (n & 511) >> 6, j = n & 63, i = j >> 1, b = j & 1; return (n & 512) + 64 * h + i + 32 * b; }
    if (n < 2048) return n;
    if (n < 2176) { int j = n - 2048, h = j >> 4, jj = j & 15, i = jj >> 1, b = jj & 1; return 2048 + 64 * h + i + 8 * b; }
    if (n < 2560) { int j = n - 2176, h = j / 48, jj = j % 48; return 2048 + 64 * h + 16 + jj; }
    if (n < 2688) { int p = n - 2560, g = (p >> 2) & 3; if (g == 1) p += 4; else if (g == 2) p -= 4; return 2560 + p; }
    if (n < 2704) { int j = n - 2688, i = j >> 1, b = j & 1; return 2688 + i + 8 * b; }
    if (n < 2736) { int j = n - 2704; if (j < 8) { int i = j >> 1, b = j & 1; return 3472 + i + 4 * b; } return 3472 + j; }
    if (n < 2744) return 3504 + (n - 2736);
    if (n < 2752) return -1;
    if (n < 3264) return 2704 + (n - 2752);
    if (n < 3520) { int j = n - 3264, h = j >> 5, jj = j & 31; if (jj < 8) { int i = jj >> 1, b = jj & 1; return 3216 + 32 * h + i + 4 * b; } return 3216 + 32 * h + jj; }
    return -1;
}
__host__ __device__ inline float col_scale(int n) {
    if (n < 512) return 0.125f;
    if (n >= 2048 && n < 2560) return 0.125f * 1.4426950408889634f;
    if (n >= 2736 && n < 2744) return 0.0625f;
    return 1.0f;
}
__device__ __forceinline__ int freq_idx(int n) {
    if (n < 1024) return (n & 63) >> 1;
    if (n >= 2048 && n < 2176) return 32 + ((n & 15) >> 1);
    if (n >= 2688 && n < 2704) return 32 + ((n - 2688) >> 1);
    if (n >= 2704 && n < 2712) return 40 + ((n - 2704) >> 1);
    if (n >= 3264 && n < 3520) { int jj = (n - 3264) & 31; if (jj < 8) return 40 + (jj >> 1); }
    return -1;
}
__device__ __forceinline__ float silu_f(float v) { return v / (1.0f + __expf(-v)); }
__device__ __forceinline__ float sigmoid_f(float v) { return 1.0f / (1.0f + __expf(-v)); }
__device__ __forceinline__ float wave_sum(float v) {
#pragma unroll
    for (int o = 1; o < 64; o <<= 1) v += __shfl_xor(v, o);
    return v;
}
#define LAS __attribute__((address_space(3)))
#define GAS __attribute__((address_space(1)))

namespace pg8 {
#define PG8_LAS __attribute__((address_space(3)))
typedef unsigned short bf16_t;
typedef _Float16 bf16x8 __attribute__((ext_vector_type(8)));
typedef float f32x4 __attribute__((ext_vector_type(4)));
typedef unsigned u32x4 __attribute__((ext_vector_type(4)));
constexpr int BM = 256, BK = 64, HALF = 128, HTB = HALF * BK * 2  , STAGE_BYTES = 8 * HTB, NXCD = 8, WGM = 8;

__host__ __device__ __forceinline__ int lds_byte(int r, int c) { const int st = (r >> 4) * 2 + (c >> 5), rr = r & 15, cc = c & 31, ob = rr * 64 + cc * 2; return st * 1024 + (ob ^ (((ob >> 9) & 1) << 5)); }
__host__ __device__ __forceinline__ void stage_rc(int b, int& R, int& C) { const int st = b / 1024, sb = b % 1024, swz = sb ^ (((sb >> 9) & 1) << 5); R = (st >> 1) * 16 + swz / 64; C = (st & 1) * 32 + (swz % 64) / 2; }
__host__ __device__ __forceinline__ int perm32(int rho) { const int n = rho >> 4, i = rho & 15; return 8 * (i >> 2) + 4 * n + (i & 3); }

struct Unit { int pm, pn; };
struct Gemm { const bf16_t* A; const bf16_t* Bt; int M, N, K; };

struct StaticOrder {
    int nM, nN, nwg, G, c;
    __host__ __device__ void init(int M, int N, int G_, int c_) { nM = M / BM; nN = N / BM; nwg = nM * nN; G = G_; c = c_; }
    __host__ __device__ bool next(int i, Unit& u) const {
        const long L = (long)i * G + c; if (L >= nwg) return false;
        int wgid = (int)L; { const int q = nwg / NXCD, r = nwg % NXCD, xcd = wgid % NXCD, off = wgid / NXCD; wgid = (xcd < r ? xcd * (q + 1) : r * (q + 1) + (xcd - r) * q) + off; }
        const int nig = WGM * nN, gid = wgid / nig, fm = gid * WGM, gsz = (nM - fm) < WGM ? (nM - fm) : WGM;
        u.pm = fm + ((wgid % nig) % gsz); u.pn = (wgid % nig) / gsz; return true;
    }
    __device__ __forceinline__ void a_ready(const Unit&) const {}
    __device__ __forceinline__ void done(const Unit&) const {}
};

__device__ __forceinline__ h16x8 pack8(const f32x4& a, const f32x4& b) {
    h16x8 o; o[0] = (h16)a[0]; o[1] = (h16)a[1]; o[2] = (h16)a[2]; o[3] = (h16)a[3]; o[4] = (h16)b[0]; o[5] = (h16)b[1]; o[6] = (h16)b[2]; o[7] = (h16)b[3]; return o;
}
struct EpiProj {
    static constexpr bool PERM = true, AFTER_DRAIN = false;
    h16* proj; const float2* tab;
    __device__ __forceinline__ void operator()(const f32x4 (&acc)[2][2][4][2], const Unit& u, int wr, int wc, int fr, int fq) const {
#pragma unroll
        for (int bj = 0; bj < 2; ++bj) {
            const int cb = u.pn * BM + bj * HALF + wc * 32;
            const int c0 = cb + 8 * fq;
            const bool rot = (cb < 1024) || (cb >= 2048 && cb < 2176) || (cb == 2688) || (cb >= 3264 && cb < 3520);
            const bool sil = (cb >= 1536 && cb < 2048) || (cb >= 2752 && cb < 3264);
            const int f0 = freq_idx(c0);
#pragma unroll
            for (int ai = 0; ai < 2; ++ai)
#pragma unroll
                for (int m = 0; m < 4; ++m) {
                    const int row = u.pm * BM + ai * HALF + wr * 64 + m * 16 + fr;
                    f32x4 a = acc[ai][bj][m][0], b = acc[ai][bj][m][1];
                    if (rot) {
                        f32x4 t0 = (f32x4){1.f, 0.f, 1.f, 0.f}, t1 = t0;
                        if (f0 >= 0) { const f32x4* tp = (const f32x4*)(tab + (size_t)(row & (SEQ - 1)) * NFREQ + f0); t0 = tp[0]; t1 = tp[1]; }
                        f32x4 ra, rb;
                        ra[0] = a[0] * t0[0] - a[1] * t0[1]; ra[1] = a[1] * t0[0] + a[0] * t0[1];
                        ra[2] = a[2] * t0[2] - a[3] * t0[3]; ra[3] = a[3] * t0[2] + a[2] * t0[3];
                        rb[0] = b[0] * t1[0] - b[1] * t1[1]; rb[1] = b[1] * t1[0] + b[0] * t1[1];
                        rb[2] = b[2] * t1[2] - b[3] * t1[3]; rb[3] = b[3] * t1[2] + b[2] * t1[3];
                        a = ra; b = rb;
                    } else if (sil) {
#pragma unroll
                        for (int e = 0; e < 4; ++e) { a[e] = silu_f(a[e]); b[e] = silu_f(b[e]); }
                    }
                    *(h16x8*)(proj + (size_t)row * NP + c0) = pack8(a, b);
                    asm volatile("" ::: "memory");
                }
        }
    }
};
struct EpiOut {
    static constexpr bool PERM = true, AFTER_DRAIN = false;
    const float* x; h16* x1h; float* ssq1;
    __device__ __forceinline__ void operator()(const f32x4 (&acc)[2][2][4][2], const Unit& u, int wr, int wc, int fr, int fq) const {
#pragma unroll
        for (int ai = 0; ai < 2; ++ai)
#pragma unroll
            for (int m = 0; m < 4; ++m) {
                const int row = u.pm * BM + ai * HALF + wr * 64 + m * 16 + fr; float ss = 0.f;
#pragma unroll
                for (int bj = 0; bj < 2; ++bj) {
                    const int c0 = u.pn * BM + bj * HALF + wc * 32 + 8 * fq;
                    const f32x4* xp = (const f32x4*)(x + (size_t)row * DM + c0);
                    f32x4 a = acc[ai][bj][m][0] + xp[0], b = acc[ai][bj][m][1] + xp[1];
                    ss += (a[0] * a[0] + a[1] * a[1]) + (a[2] * a[2] + a[3] * a[3]) + (b[0] * b[0] + b[1] * b[1]) + (b[2] * b[2] + b[3] * b[3]);
                    *(h16x8*)(x1h + (size_t)row * DM + c0) = pack8(a, b);
                }
                ss += __shfl_xor(ss, 16); ss += __shfl_xor(ss, 32);
                if (fq == 0) atomicAdd(ssq1 + row, ss);
                asm volatile("" ::: "memory");
            }
    }
};
struct EpiPle {
    static constexpr bool PERM = true, AFTER_DRAIN = false;
    h16* pp;
    __device__ __forceinline__ void operator()(const f32x4 (&acc)[2][2][4][2], const Unit& u, int wr, int wc, int fr, int fq) const {
#pragma unroll
        for (int ai = 0; ai < 2; ++ai)
#pragma unroll
            for (int m = 0; m < 4; ++m) {
                const int row = u.pm * BM + ai * HALF + wr * 64 + m * 16 + fr;
#pragma unroll
                for (int bj = 0; bj < 2; ++bj) {
                    const int c0 = u.pn * BM + bj * HALF + wc * 32 + 8 * fq;
                    *(h16x8*)(pp + (size_t)row * DM + c0) = pack8(acc[ai][bj][m][0], acc[ai][bj][m][1]);
                }
            }
    }
};
struct EpiGate {
    static constexpr bool PERM = true, AFTER_DRAIN = false;
    const h16* x1h; const h16* pp; const float* ssq1; float* out; float* ssq2;
    __device__ __forceinline__ void operator()(const f32x4 (&acc)[2][2][4][2], const Unit& u, int wr, int wc, int fr, int fq) const {
#pragma unroll
        for (int ai = 0; ai < 2; ++ai)
#pragma unroll
            for (int m = 0; m < 4; ++m) {
                const int row = u.pm * BM + ai * HALF + wr * 64 + m * 16 + fr; float ss = 0.f;
                const float rstd = rsqrtf(ssq1[row] * (1.0f / DM) + EPS);
#pragma unroll
                for (int bj = 0; bj < 2; ++bj) {
                    const int c0 = u.pn * BM + bj * HALF + wc * 32 + 8 * fq;
                    const h16x8 xv = *(const h16x8*)(x1h + (size_t)row * DM + c0);
                    const h16x8 pv = *(const h16x8*)(pp + (size_t)row * DM + c0);
                    f32x4 a = acc[ai][bj][m][0], b = acc[ai][bj][m][1], ra, rb;
#pragma unroll
                    for (int e = 0; e < 4; ++e) {
                        ra[e] = (float)xv[e] + sigmoid_f(a[e] * rstd) * (float)pv[e];
                        rb[e] = (float)xv[4 + e] + sigmoid_f(b[e] * rstd) * (float)pv[4 + e];
                        ss += ra[e] * ra[e] + rb[e] * rb[e];
                    }
                    f32x4* op = (f32x4*)(out + (size_t)row * DM + c0);
                    op[0] = ra; op[1] = rb;
                }
                ss += __shfl_xor(ss, 16); ss += __shfl_xor(ss, 32);
                if (fq == 0) atomicAdd(ssq2 + row, ss);
                asm volatile("" ::: "memory");
            }
    }
};
template <class Epi, class Sched, bool ALIGN_EPI = false, bool SP2 = false>
__device__ __forceinline__ void gemm_phase(PG8_LAS unsigned char* lds, const Gemm g, const Sched& S, const Epi& E, int wave_in) {
    int lane_o = (int)__builtin_amdgcn_mbcnt_hi(~0u, __builtin_amdgcn_mbcnt_lo(~0u, 0u)); asm volatile("" : "+v"(lane_o));
    const int wid = __builtin_amdgcn_readfirstlane(wave_in), lane = lane_o, tid = wid * 64 + lane, wr = wid >> 2, wc = wid & 3, fr = lane & 15, fq = lane >> 4;
    const int K = g.K, nt = K / BK;
    unsigned voffA[2], voffB[2];
#pragma unroll
    for (int i = 0; i < 2; ++i) { int R, C; stage_rc(tid * 16 + i * 8192, R, C); const int Rb = Epi::PERM ? ((R & ~31) + perm32(R & 31)) : R;
        voffA[i] = (unsigned)(R * K + C) * 2u; voffB[i] = (unsigned)(Rb * K + C) * 2u; }
    const size_t kstep = (size_t)(BK * 2);
    const size_t hstep = (size_t)HALF * K * 2;
    const size_t tstep = 2 * hstep;
    const unsigned ldsw = (unsigned)wid * 1024u;
    const int aoff = lds_byte(wr * 64 + fr, fq * 8), boff = lds_byte(wc * 32 + fr, fq * 8);
#define PG8_SA(b, h) (((b) * 2 + (h)) * HTB)
#define PG8_SB(b, h) ((4 + (b) * 2 + (h)) * HTB)
#define PG8_STAGE(bufoff, gbase, voff) do { _Pragma("unroll") for (int _i = 0; _i < 2; ++_i) \
        __builtin_amdgcn_global_load_lds((const unsigned*)((const char*)(gbase) + (voff)[_i]), (PG8_LAS unsigned*)(lds + (bufoff) + ldsw + _i * 8192), 16, 0, 0); } while (0)
#define PG8_LDA(dst, b, h) do { _Pragma("unroll") for (int m = 0; m < 4; ++m) _Pragma("unroll") for (int k = 0; k < 2; ++k) dst[m][k] = *(const PG8_LAS bf16x8*)(lds + PG8_SA(b, h) + aoff + m * 2048 + k * 1024); } while (0)
#define PG8_LDB(dst, b, h) do { _Pragma("unroll") for (int n = 0; n < 2; ++n) _Pragma("unroll") for (int k = 0; k < 2; ++k) dst[n][k] = *(const PG8_LAS bf16x8*)(lds + PG8_SB(b, h) + boff + n * 2048 + k * 1024); } while (0)
#define PG8_MMA(ai, bj, At, Bt) do { __builtin_amdgcn_s_setprio(1); _Pragma("unroll") for (int m = 0; m < 4; ++m) _Pragma("unroll") for (int n = 0; n < 2; ++n) _Pragma("unroll") for (int k = 0; k < 2; ++k) \
        acc[ai][bj][m][n] = __builtin_amdgcn_mfma_f32_16x16x32_f16(Bt[n][k], At[m][k], acc[ai][bj][m][n], 0, 0, 0); __builtin_amdgcn_s_setprio(0); } while (0)
#define PG8_WAIT_V(n) asm volatile("s_waitcnt vmcnt(" #n ")" ::: "memory")
#define PG8_WAIT_L(n) asm volatile("s_waitcnt lgkmcnt(" #n ")" ::: "memory")
#define PG8_BAR __builtin_amdgcn_s_barrier()
#define PG8_SCHED __builtin_amdgcn_sched_barrier(0)
    Unit cur, nxt; int ui = 0;
    if (!S.next(0, cur)) return;
    f32x4 acc[2][2][4][2];
#pragma unroll
    for (int a = 0; a < 2; ++a)
#pragma unroll
        for (int b = 0; b < 2; ++b)
#pragma unroll
            for (int m = 0; m < 4; ++m)
#pragma unroll
                for (int n = 0; n < 2; ++n) acc[a][b][m][n] = (f32x4){0.f, 0.f, 0.f, 0.f};
    bf16x8 At[4][2], B0[2][2], B1[2][2];
    const char* cA = (const char*)g.A + (size_t)cur.pm * tstep; const char* cB = (const char*)g.Bt + (size_t)cur.pn * tstep;
    S.a_ready(cur);
    if constexpr (SP2) {
        PG8_STAGE(PG8_SB(0, 0), cB, voffB); PG8_STAGE(PG8_SB(0, 1), cB + hstep, voffB); PG8_STAGE(PG8_SA(0, 0), cA, voffA); PG8_STAGE(PG8_SA(0, 1), cA + hstep, voffA);
        if (wr == 1) PG8_BAR;
        PG8_WAIT_V(2); PG8_BAR;
        PG8_STAGE(PG8_SB(1, 0), cB + kstep, voffB); PG8_STAGE(PG8_SA(1, 0), cA + kstep, voffA); PG8_STAGE(PG8_SB(1, 1), cB + hstep + kstep, voffB);
        PG8_WAIT_V(6); PG8_BAR;
    } else {
        PG8_STAGE(PG8_SB(0, 0), cB, voffB); PG8_STAGE(PG8_SA(0, 0), cA, voffA); PG8_STAGE(PG8_SB(0, 1), cB + hstep, voffB); PG8_STAGE(PG8_SA(0, 1), cA + hstep, voffA);
        if (wr == 1) PG8_BAR;
        PG8_WAIT_V(4); PG8_BAR;
        PG8_STAGE(PG8_SB(1, 0), cB + kstep, voffB); PG8_STAGE(PG8_SA(1, 0), cA + kstep, voffA); PG8_STAGE(PG8_SB(1, 1), cB + hstep + kstep, voffB);
        PG8_WAIT_V(6); PG8_BAR;
    }
    for (;;) {
        const bool has_next = S.next(ui + 1, nxt);
        const char* nA = has_next ? (const char*)g.A + (size_t)nxt.pm * tstep : cA; const char* nB = has_next ? (const char*)g.Bt + (size_t)nxt.pn * tstep : cB;
        for (int t = 0; t < nt; t += 2) {
            const bool last = (t == nt - 2);
            const char* a1 = cA + (size_t)(t + 1) * kstep;
            const char* a2 = last ? nA : cA + (size_t)(t + 2) * kstep; const char* b2 = last ? nB : cB + (size_t)(t + 2) * kstep;
            const char* a3 = a2 + kstep; const char* b3 = b2 + kstep;
            if (last && has_next) S.a_ready(nxt);
            if constexpr (SP2) {
            PG8_LDB(B0, 0, 0); PG8_LDB(B1, 0, 1); PG8_SCHED; PG8_LDA(At, 0, 0); PG8_STAGE(PG8_SA(1, 1), a1 + hstep, voffA);
            PG8_WAIT_V(8); PG8_WAIT_L(0); PG8_BAR; PG8_MMA(0, 0, At, B0); PG8_MMA(0, 1, At, B1); PG8_BAR; PG8_SCHED;
            PG8_LDA(At, 0, 1); PG8_STAGE(PG8_SB(0, 0), b2, voffB); PG8_STAGE(PG8_SB(0, 1), b2 + hstep, voffB); PG8_STAGE(PG8_SA(0, 0), a2, voffA);
            PG8_WAIT_V(8); PG8_WAIT_L(0); PG8_BAR; PG8_MMA(1, 0, At, B0); PG8_MMA(1, 1, At, B1); PG8_BAR; PG8_SCHED;
            PG8_LDB(B0, 1, 0); PG8_LDB(B1, 1, 1); PG8_SCHED; PG8_LDA(At, 1, 0); PG8_STAGE(PG8_SA(0, 1), a2 + hstep, voffA);
            PG8_WAIT_V(8); PG8_WAIT_L(0); PG8_BAR; PG8_MMA(0, 0, At, B0); PG8_MMA(0, 1, At, B1); PG8_BAR; PG8_SCHED;
            PG8_LDA(At, 1, 1); PG8_STAGE(PG8_SB(1, 0), b3, voffB); PG8_STAGE(PG8_SB(1, 1), b3 + hstep, voffB); PG8_STAGE(PG8_SA(1, 0), a3, voffA);
            PG8_WAIT_V(8); PG8_WAIT_L(0); PG8_BAR; PG8_MMA(1, 0, At, B0); PG8_MMA(1, 1, At, B1); PG8_BAR; PG8_SCHED;
            } else {
            PG8_LDB(B0, 0, 0); PG8_SCHED; PG8_LDA(At, 0, 0); PG8_STAGE(PG8_SA(1, 1), a1 + hstep, voffA);
            PG8_WAIT_L(8); PG8_BAR; PG8_WAIT_L(0); PG8_MMA(0, 0, At, B0); PG8_BAR; PG8_SCHED;
            PG8_LDB(B1, 0, 1); PG8_STAGE(PG8_SB(0, 0), b2, voffB);
            PG8_BAR; PG8_WAIT_L(0); PG8_MMA(0, 1, At, B1); PG8_BAR;
            PG8_LDA(At, 0, 1); PG8_STAGE(PG8_SA(0, 0), a2, voffA);
            PG8_BAR; PG8_WAIT_L(0); PG8_MMA(1, 0, At, B0); PG8_BAR; PG8_SCHED;
            PG8_STAGE(PG8_SB(0, 1), b2 + hstep, voffB);
            PG8_WAIT_V(6); PG8_BAR; PG8_MMA(1, 1, At, B1); PG8_BAR;
            PG8_LDB(B0, 1, 0); PG8_SCHED; PG8_LDA(At, 1, 0); PG8_STAGE(PG8_SA(0, 1), a2 + hstep, voffA);
            PG8_WAIT_L(8); PG8_BAR; PG8_WAIT_L(0); PG8_MMA(0, 0, At, B0); PG8_BAR; PG8_SCHED;
            PG8_LDB(B1, 1, 1); PG8_STAGE(PG8_SB(1, 0), b3, voffB);
            PG8_BAR; PG8_WAIT_L(0); PG8_MMA(0, 1, At, B1); PG8_BAR;
            PG8_LDA(At, 1, 1); PG8_STAGE(PG8_SA(1, 0), a3, voffA);
            PG8_BAR; PG8_WAIT_L(0); PG8_MMA(1, 0, At, B0); PG8_BAR; PG8_SCHED;
            PG8_STAGE(PG8_SB(1, 1), b3 + hstep, voffB);
            PG8_WAIT_V(6); PG8_BAR; PG8_MMA(1, 1, At, B1); PG8_BAR;
            }
        }
        if constexpr (ALIGN_EPI) { if (wr == 0) PG8_BAR; }
        if constexpr (!Epi::AFTER_DRAIN) { E(acc, cur, wr, wc, fr, fq); S.done(cur); }
        if (!has_next) break;
#pragma unroll
        for (int a = 0; a < 2; ++a)
#pragma unroll
            for (int b = 0; b < 2; ++b)
#pragma unroll
                for (int m = 0; m < 4; ++m)
#pragma unroll
                    for (int n = 0; n < 2; ++n) acc[a][b][m][n] = (f32x4){0.f, 0.f, 0.f, 0.f};
        cur = nxt; cA = nA; cB = nB; ++ui;
        if constexpr (ALIGN_EPI) { if (wr == 1) PG8_BAR; }
    }
    PG8_WAIT_V(0);
    if constexpr (!ALIGN_EPI) { if (wr == 0) PG8_BAR; }
    PG8_BAR;
    if constexpr (Epi::AFTER_DRAIN) { E.fused(acc, cur, wr, wc, fr, fq, lds, wid, lane); S.done(cur); }
#undef PG8_SA
#undef PG8_SB
#undef PG8_STAGE
#undef PG8_LDA
#undef PG8_LDB
#undef PG8_MMA
#undef PG8_WAIT_V
#undef PG8_WAIT_L
#undef PG8_BAR
#undef PG8_SCHED
}
}
#define XB_TMO      128
#define XB_XCNT(j)  (256  + 64 * (j))
#define XB_XSUB(j)  (1280 + 64 * (j))
#define XB_XGEN(j)  (2304 + 64 * (j))
#define XB_TOP      3328
#define XB_TOPGEN   3392
#define XCD_BAR_WORDS 3456
#define XB_SPIN_CAP (1u << 18)

__device__ __forceinline__ unsigned xb_ld(unsigned* p)              { return __hip_atomic_load(p, __ATOMIC_RELAXED, __HIP_MEMORY_SCOPE_AGENT); }
__device__ __forceinline__ unsigned xb_add(unsigned* p, unsigned v) { return __hip_atomic_fetch_add(p, v, __ATOMIC_RELAXED, __HIP_MEMORY_SCOPE_AGENT); }
__device__ __forceinline__ unsigned xb_xcc_id() { return (unsigned)__builtin_amdgcn_s_getreg((3 << 11) | 20) & 0xFu; }
#define XB_SPIN(cond, bar) do { unsigned _sp = 0; while (cond) { __builtin_amdgcn_s_sleep(1); \
    if ((++_sp & 255u) == 0u) { if (xb_ld(&(bar)[XB_TMO])) break; if (_sp > XB_SPIN_CAP) { atomicAdd(&(bar)[XB_TMO], 1u); break; } } } } while (0)

struct XcdBarrier {
    unsigned* bar; unsigned x;
    volatile LAS unsigned* st;
};

__device__ __forceinline__ XcdBarrier xcd_barrier_post(unsigned* bar, volatile LAS unsigned* st) {
    XcdBarrier b; b.bar = bar; b.x = xb_xcc_id(); b.st = st;
    if (threadIdx.x == 0) (void)xb_add(&bar[XB_XCNT(b.x)], 1u);
    return b;
}
__device__ __forceinline__ void xcd_barrier_complete(unsigned* bar, unsigned x, unsigned& nloc, unsigned& nx) {
    const unsigned G = gridDim.x * gridDim.y * gridDim.z;
    unsigned sum, cnt, mine, sp = 0u;
    for (;;) {
        sum = 0u; cnt = 0u; mine = 0u;
#pragma unroll
        for (unsigned j = 0; j < 16; ++j) { const unsigned c = xb_ld(&bar[XB_XCNT(j)]); sum += c; cnt += (c > 0u) ? 1u : 0u; mine = (j == x) ? c : mine; }
        if (sum == G) break;
        __builtin_amdgcn_s_sleep(1);
        if ((++sp & 255u) == 0u) { if (xb_ld(&bar[XB_TMO])) break; if (sp > XB_SPIN_CAP) { atomicAdd(&bar[XB_TMO], 1u); break; } }
    }
    nloc = mine > 0u ? mine : 1u; nx = cnt > 0u ? cnt : 1u;
}

__device__ __forceinline__ void xcd_barrier(const XcdBarrier& b) {
    asm volatile("s_waitcnt vmcnt(0)" ::: "memory");
    __syncthreads();
    if (threadIdx.x == 0) {
        unsigned* bar = b.bar;
        __builtin_amdgcn_s_waitcnt(0);
        unsigned nloc = b.st[0], nx = b.st[1];
        if (nloc == 0u) { xcd_barrier_complete(bar, b.x, nloc, nx); b.st[0] = nloc; b.st[1] = nx; }
        const unsigned old = xb_add(&bar[XB_XSUB(b.x)], 1u);
        const unsigned gen = old / nloc;
        if (old + 1u == (gen + 1u) * nloc) {
            __builtin_amdgcn_fence(__ATOMIC_RELEASE, "agent");
            asm volatile("s_waitcnt vmcnt(0)" ::: "memory");
            const unsigned og = xb_add(&bar[XB_TOP], 1u);
            const unsigned tg = og / nx;
            if (og + 1u == (tg + 1u) * nx) xb_add(&bar[XB_TOPGEN], 1u);
            else XB_SPIN(xb_ld(&bar[XB_TOPGEN]) == tg, bar);
            __builtin_amdgcn_fence(__ATOMIC_ACQUIRE, "agent");
            xb_add(&bar[XB_XGEN(b.x)], 1u);
            asm volatile("s_waitcnt vmcnt(0)" ::: "memory");
        } else {
            XB_SPIN(xb_ld(&bar[XB_XGEN(b.x)]) == gen, bar);
            __builtin_amdgcn_fence(__ATOMIC_ACQUIRE, "agent");
            asm volatile("s_waitcnt vmcnt(0)" ::: "memory");
        }
    }
    __syncthreads();
}

constexpr int NWAVES = 8, NTHR = 512;
constexpr int RING_BYTES = 131072, LDSCTL_OFF = RING_BYTES, MISC_OFF = LDSCTL_OFF + 320, LDS_BYTES = 147456;
typedef float f32x4 __attribute__((ext_vector_type(4)));

struct Args {
    const float* x; const float* p; const int* pos; const float* norm_mix; const float* w_in; const float* ret_norm; const float* kv_norm;
    const float* w_uk; const float* w_uv; const float* w_out; const float* norm_ple; const float* w_ple_gate; const float* w_ple_proj; const float* norm_final;
    float* out; unsigned char* ws;
};

__device__ __forceinline__ void p0_transpose_item(const float* __restrict__ W, int ldw, h16* __restrict__ WT, int K, int n0, int k0, bool perm, const float* __restrict__ gk,
                                                  LAS float* scr, int lane) {
    const int nn = n0 + (lane & 31);
    const int oc = perm ? orig_col(nn) : nn;
    const float sc = perm ? col_scale(nn) : 1.0f;
#pragma unroll 8
    for (int i = 0; i < 32; ++i) {
        const int kk = 2 * i + (lane >> 5);
        float v = (oc >= 0) ? W[(size_t)(k0 + kk) * ldw + oc] * sc : 0.f;
        if (gk) v *= gk[k0 + kk];
        scr[kk * 33 + (lane & 31)] = v;
    }
    asm volatile("s_waitcnt lgkmcnt(0)" ::: "memory");
    const int c = lane & 7;
#pragma unroll
    for (int j = 0; j < 4; ++j) {
        const int n = (lane >> 3) + 8 * j; const LAS float* s = scr + (8 * c) * 33 + n;
        h16x8 o;
#pragma unroll
        for (int e = 0; e < 8; ++e) o[e] = (h16)s[e * 33];
        *(h16x8*)(WT + (size_t)(n0 + n) * K + k0 + 8 * c) = o;
    }
    asm volatile("s_waitcnt lgkmcnt(0)" ::: "memory");
}
__device__ __forceinline__ void p0_prologue(const Args& a, LAS unsigned char* lds, int G, int bx, int tid, int lane, int wave) {
    unsigned char* ws = a.ws;
    float2* tab = (float2*)(ws + WS_TAB);
    h16* WinT = (h16*)(ws + WS_WIN); h16* WoutT = (h16*)(ws + WS_WOUT); h16* WgT = (h16*)(ws + WS_WG); h16* WpT = (h16*)(ws + WS_WP);
    h16* A0 = (h16*)(ws + WS_A0); h16* P16 = (h16*)(ws + WS_P16);
    const int gw = bx * NWAVES + wave, NGW = G * NWAVES;
    for (int i = bx * NTHR + tid; i < SEQ * NFREQ; i += G * NTHR) {
        const int s = i / NFREQ, f = i % NFREQ; float inv;
        if (f < 32) inv = powf(10000.0f, -(float)(2 * f) / 64.0f);
        else if (f < 40) inv = powf(500000.0f, -(float)(2 * (f - 32)) / 16.0f);
        else inv = powf(500000.0f, -(float)(2 * (f - 40)) / 8.0f);
        const float ang = (float)a.pos[s] * inv;
        tab[i] = make_float2(cosf(ang), sinf(ang));
    }
    LAS float* scr = (LAS float*)(lds + wave * 16384);
    constexpr int I_IN = 16 * (NP / 32), I_O = 16 * 32, I_G = 16 * 32, I_P = 4 * 32;
    for (int it = gw; it < I_IN + I_O + I_G + I_P; it += NGW) {
        int r = it;
        if (r < I_IN) { p0_transpose_item(a.w_in, 3512, WinT, DM, (r % (NP / 32)) * 32, (r / (NP / 32)) * 64, true, nullptr, scr, lane); continue; } r -= I_IN;
        if (r < I_O) { p0_transpose_item(a.w_out, DM, WoutT, DM, (r % 32) * 32, (r / 32) * 64, false, nullptr, scr, lane); continue; } r -= I_O;
        if (r < I_G) { p0_transpose_item(a.w_ple_gate, DM, WgT, DM, (r % 32) * 32, (r / 32) * 64, false, a.norm_ple, scr, lane); continue; } r -= I_G;
        p0_transpose_item(a.w_ple_proj, DM, WpT, PLE, (r % 32) * 32, (r / 32) * 64, false, nullptr, scr, lane);
    }
    {
        h16* WukT = (h16*)(ws + WS_WUK); h16* WuvT = (h16*)(ws + WS_WUV);
        for (int i = bx * NTHR + tid; i < 8 * 128 * 48; i += G * NTHR) { const int hh = i / (128 * 48), r = i % (128 * 48), c = r / 48, j = r % 48; WukT[i] = (h16)a.w_uk[(hh * 48 + j) * 128 + c]; }
        for (int i = bx * NTHR + tid; i < 8 * 64 * 128; i += G * NTHR) { const int hh = i / (64 * 128), r = i % (64 * 128), d = r / 128, c = r % 128; WuvT[i] = (h16)a.w_uv[(hh * 128 + c) * 64 + d]; }
    }
    for (int row = gw; row < MTOK; row += NGW) {
        const f32x4* xr = (const f32x4*)(a.x + (size_t)row * DM);
        f32x4 v[4]; float ss = 0.f;
#pragma unroll
        for (int j = 0; j < 4; ++j) { v[j] = xr[lane + 64 * j]; ss += (v[j][0] * v[j][0] + v[j][1] * v[j][1]) + (v[j][2] * v[j][2] + v[j][3] * v[j][3]); }
        ss = wave_sum(ss);
        const float rstd = rsqrtf(ss * (1.0f / DM) + EPS);
        const f32x4* gr = (const f32x4*)a.norm_mix;
#pragma unroll
        for (int j = 0; j < 4; ++j) {
            const f32x4 gg = gr[lane + 64 * j];
            h16x4 o; o[0] = (h16)(v[j][0] * rstd * gg[0]); o[1] = (h16)(v[j][1] * rstd * gg[1]); o[2] = (h16)(v[j][2] * rstd * gg[2]); o[3] = (h16)(v[j][3] * rstd * gg[3]);
            *(h16x4*)(A0 + (size_t)row * DM + (lane + 64 * j) * 4) = o;
        }
    }
    for (size_t i = (size_t)bx * NTHR + tid; i < (size_t)MTOK * PLE / 4; i += (size_t)G * NTHR) {
        const f32x4 v = ((const f32x4*)a.p)[i]; h16x4 o; o[0] = (h16)v[0]; o[1] = (h16)v[1]; o[2] = (h16)v[2]; o[3] = (h16)v[3];
        ((h16x4*)P16)[i] = o;
    }
}

__device__ __forceinline__ void fix_ckv(h16* proj, const float* kvn, int G, int bx, int lane, int wave) {
    const int gw = bx * NWAVES + wave, NGW = G * NWAVES;
    int p0 = 2 * lane; { const int g = (p0 >> 2) & 3; if (g == 1) p0 += 4; else if (g == 2) p0 -= 4; }
    const float g0 = kvn[p0], g1 = kvn[p0 + 1];
    for (int row = gw; row < MTOK; row += NGW) {
        h16x2* pr = (h16x2*)(proj + (size_t)row * NP + C_CKV) + lane;
        const h16x2 v = *pr; const float a = (float)v[0], b = (float)v[1];
        const float ss = wave_sum(a * a + b * b);
        const float rstd = rsqrtf(ss * (1.0f / 128.0f) + EPS);
        h16x2 o; o[0] = (h16)(a * rstd * g0); o[1] = (h16)(b * rstd * g1);
        *pr = o;
    }
}

__device__ __forceinline__ void retention_unit(LAS float* sm, int b, int h, const h16* __restrict__ proj, const float* __restrict__ ret_norm, h16* __restrict__ mix, int tid) {
    LAS float* q = sm;
    LAS float* k = q + 64 * 65;
    LAS float* v = k + 64 * 65;
    LAS float* sc = v + 64 * 65;
    LAS float* S = sc + 64 * 65;
    const float log_g = log1pf(-exp2f(-5.0f - (float)h));
    const float cdecay = expf(log_g * 64.0f);
    for (int i = tid; i < 4096; i += NTHR) S[i] = 0.f;
    const int lt = tid >> 3, lc = (tid & 7) * 8;
    for (int c = 0; c < 32; ++c) {
        const size_t rowbase = (size_t)b * SEQ + c * 64;
        __syncthreads();
        {
            const h16* pr = proj + (rowbase + lt) * NP + h * 64 + lc;
            const h16x8 qv = *(const h16x8*)(pr + C_RQ), kv = *(const h16x8*)(pr + C_RK), vv = *(const h16x8*)(pr + C_RV);
#pragma unroll
            for (int j = 0; j < 8; ++j) { q[lt * 65 + lc + j] = (float)qv[j]; k[lt * 65 + lc + j] = (float)kv[j]; v[lt * 65 + lc + j] = (float)vv[j]; }
        }
        __syncthreads();
        {
            float a[8];
#pragma unroll
            for (int j = 0; j < 8; ++j) a[j] = 0.f;
            for (int d = 0; d < 64; ++d) { const float qq = q[lt * 65 + d];
#pragma unroll
                for (int j = 0; j < 8; ++j) a[j] += qq * k[(lc + j) * 65 + d]; }
#pragma unroll
            for (int j = 0; j < 8; ++j) { int dm = lt - (lc + j); if (dm < 0) dm = -dm; sc[lt * 65 + lc + j] = a[j] * expf(log_g * (float)dm); }
        }
        __syncthreads();
        float o[8];
        {
            float a[8], cr[8];
#pragma unroll
            for (int j = 0; j < 8; ++j) { a[j] = 0.f; cr[j] = 0.f; }
            for (int m = 0; m < 64; ++m) { const float s_ = sc[lt * 65 + m], qq = q[lt * 65 + m];
#pragma unroll
                for (int j = 0; j < 8; ++j) { a[j] += s_ * v[m * 65 + lc + j]; cr[j] += qq * S[m * 64 + lc + j]; } }
            const float xi = expf(log_g * (float)(lt + 1));
#pragma unroll
            for (int j = 0; j < 8; ++j) o[j] = a[j] + xi * cr[j];
        }
        {
            float s1 = 0.f;
#pragma unroll
            for (int j = 0; j < 8; ++j) s1 += o[j];
            s1 += __shfl_xor(s1, 1); s1 += __shfl_xor(s1, 2); s1 += __shfl_xor(s1, 4);
            const float mu = s1 * (1.0f / 64.0f); float s2 = 0.f;
#pragma unroll
            for (int j = 0; j < 8; ++j) { const float dlt = o[j] - mu; s2 += dlt * dlt; }
            s2 += __shfl_xor(s2, 1); s2 += __shfl_xor(s2, 2); s2 += __shfl_xor(s2, 4);
            const float rstd = rsqrtf(s2 * (1.0f / 64.0f) + EPS);
            const h16x8 gate = *(const h16x8*)(proj + (rowbase + lt) * NP + C_RG + h * 64 + lc);
            h16x8 ov;
#pragma unroll
            for (int j = 0; j < 8; ++j) ov[j] = (h16)((o[j] - mu) * rstd * ret_norm[h * 64 + lc + j] * (float)gate[j]);
            *(h16x8*)(mix + (rowbase + lt) * DM + h * 64 + lc) = ov;
        }
        __syncthreads();
        {
            float a[8];
#pragma unroll
            for (int j = 0; j < 8; ++j) a[j] = 0.f;
            for (int m = 0; m < 64; ++m) { const float kk = k[m * 65 + lt] * expf(log_g * (float)(63 - m));
#pragma unroll
                for (int j = 0; j < 8; ++j) a[j] += kk * v[m * 65 + lc + j]; }
#pragma unroll
            for (int j = 0; j < 8; ++j) S[lt * 64 + lc + j] = cdecay * S[lt * 64 + lc + j] + a[j];
        }
    }
    __syncthreads();
}

namespace dsa {
typedef _Float16 f16x8 __attribute__((ext_vector_type(8)));
typedef _Float16 f16x4 __attribute__((ext_vector_type(4)));
typedef float f32x16 __attribute__((ext_vector_type(16)));
typedef float f32x4 __attribute__((ext_vector_type(4)));
typedef short v4i16_t __attribute__((ext_vector_type(4)));
constexpr int L_KT = 0;
constexpr int L_KR = 32768;
constexpr int L_MASK = 36864;
constexpr float NEG = -3.0e38f;

__device__ __forceinline__ unsigned off_b(unsigned row, unsigned ch) { return 256u * row + 16u * (ch ^ (((row & 3) << 2) | ((row >> 2) & 3))); }
__device__ __forceinline__ f16x4 vtr(const LAS unsigned char* p) { return __builtin_bit_cast(f16x4, __builtin_amdgcn_ds_read_tr16_b64_v4i16((LAS v4i16_t*)p)); }
__device__ __forceinline__ unsigned ord_key(float f) { const unsigned u = __float_as_uint(f); return (u & 0x80000000u) ? ~u : (u | 0x80000000u); }
__device__ __forceinline__ f32x16 mfma32(f16x8 a, f16x8 b, f32x16 c) { return __builtin_amdgcn_mfma_f32_32x32x16_f16(a, b, c, 0, 0, 0); }
__device__ __forceinline__ float xhalf(float v) { return __shfl_xor(v, 32); }

__device__ __forceinline__ void kstage_dma(LAS unsigned char* lds, int buf, const h16* pb, int key0, int lane, int wave) {
    const int row = 4 * wave + (lane >> 4), chp = lane & 15;
    const int ch = chp ^ (((row & 3) << 2) | ((row >> 2) & 3));
#pragma unroll
    for (int im = 0; im < 2; ++im) {
        const h16* src = pb + (size_t)(key0 + 32 * im + row) * NP + C_CKV + 8 * ch;
        __builtin_amdgcn_global_load_lds((const unsigned*)src, (LAS unsigned*)(lds + L_KT + buf * 16384 + im * 8192 + wave * 1024), 16, 0, 0);
    }
    if (wave < 2) {
        const int slot = 64 * wave + lane;
        const h16* src = pb + (size_t)(key0 + (slot >> 1)) * NP + C_KPE + 8 * (slot & 1);
        __builtin_amdgcn_global_load_lds((const unsigned*)src, (LAS unsigned*)(lds + L_KR + buf * 2048 + wave * 1024), 16, 0, 0);
    }
}

__device__ __forceinline__ void dsa_select_unit(LAS unsigned char* lds, int b, int qb, const h16* __restrict__ proj, float* __restrict__ scr, unsigned* __restrict__ maskg,
                                                int tid, int lane, int wave) {
    const int c = qb >> 1, N = 64 * (c + 1);
    const h16* pb = proj + (size_t)b * SEQ * NP;
    const size_t m = (size_t)b * SEQ + 32 * qb + (lane & 31);
    const h16* prow = proj + m * NP;
    LAS unsigned* maskw = (LAS unsigned*)(lds + L_MASK);
    if (N > 256) {
        const int q = lane & 31, h = lane >> 5;
        for (int i = tid; i < 2048; i += NTHR) maskw[i] = 0u;
        {
            for (int kt = wave; kt < N / 32; kt += 8) {
                const h16* krow = pb + (size_t)(32 * kt + q) * NP + C_KI + 8 * h;
                const f16x8 ka0 = *(const f16x8*)krow, ka1 = *(const f16x8*)(krow + 16);
                f32x16 sc;
#pragma unroll
                for (int r = 0; r < 16; ++r) sc[r] = 0.f;
#pragma unroll 1
                for (int hh = 0; hh < 8; ++hh) {
                    const f16x8 q0 = *(const f16x8*)(prow + C_IQ + 32 * hh + 8 * h), q1 = *(const f16x8*)(prow + C_IQ + 32 * hh + 16 + 8 * h);
                    const float wq = (float)prow[C_IW + hh];
                    f32x16 x;
#pragma unroll
                    for (int r = 0; r < 16; ++r) x[r] = 0.f;
                    x = mfma32(ka0, q0, x); x = mfma32(ka1, q1, x);
#pragma unroll
                    for (int r = 0; r < 16; ++r) sc[r] += wq * fmaxf(x[r], 0.f);
                }
#pragma unroll
                for (int r4 = 0; r4 < 4; ++r4) {
                    const int kg = 8 * kt + 2 * r4 + h;
                    *(f32x4*)(scr + ((size_t)kg * 32 + q) * 4) = (f32x4){sc[4 * r4], sc[4 * r4 + 1], sc[4 * r4 + 2], sc[4 * r4 + 3]};
                }
            }
        }
        __syncthreads();
        const int NG = N >> 2;
        for (int i = 0; i < 4; ++i) {
            const int qq = 4 * wave + i;
            unsigned kk[32];
#pragma unroll
            for (int ip = 0; ip < 8; ++ip) {
                const int kg = lane + 64 * ip;
                f32x4 v = (f32x4){0.f, 0.f, 0.f, 0.f};
                const bool ok = kg < NG;
                if (ok) v = *(const f32x4*)(scr + ((size_t)kg * 32 + qq) * 4);
#pragma unroll
                for (int e = 0; e < 4; ++e) kk[4 * ip + e] = ok ? ord_key(v[e]) : 0u;
            }
            unsigned T = 0u; bool exact = false;
            for (int bit = 31; bit >= 0; --bit) {
                const unsigned cand = T | (1u << bit);
                int cnt = 0;
#pragma unroll
                for (int r0 = 0; r0 < 32; r0 += 4) {
#pragma unroll
                    for (int r = r0; r < r0 + 4; ++r) cnt += __builtin_popcountll(__ballot(kk[r] >= cand));
                    __builtin_amdgcn_sched_barrier(0);
                }
                if (cnt >= 256) T = cand;
                if (cnt == 256) { exact = true; break; }
            }
            unsigned selbits = 0u;
            if (exact) {
#pragma unroll
                for (int r0 = 0; r0 < 32; r0 += 4) {
#pragma unroll
                    for (int r = r0; r < r0 + 4; ++r) selbits |= (kk[r] >= T) ? (1u << r) : 0u;
                    __builtin_amdgcn_sched_barrier(0);
                }
            } else {
                int ngt = 0;
#pragma unroll
                for (int r0 = 0; r0 < 32; r0 += 4) {
#pragma unroll
                    for (int r = r0; r < r0 + 4; ++r) ngt += __builtin_popcountll(__ballot(kk[r] > T));
                    __builtin_amdgcn_sched_barrier(0);
                }
                const int need = 256 - ngt;
                const int lane4 = 4 * lane;
                int J = 0;
                for (int bit = 10; bit >= 0; --bit) {
                    const int cj = J | (1 << bit);
                    unsigned Tv = T; asm volatile("" : "+v"(Tv));
                    int cnt = 0;
#pragma unroll
                    for (int r0 = 0; r0 < 32; r0 += 4) {
#pragma unroll
                        for (int r = r0; r < r0 + 4; ++r) cnt += __builtin_popcountll(__ballot(kk[r] == Tv && lane4 < cj - (256 * (r >> 2) + (r & 3))));
                        __builtin_amdgcn_sched_barrier(0);
                    }
                    if (cnt < need) J = cj;
                }
#pragma unroll
                for (int r0 = 0; r0 < 32; r0 += 2) {
#pragma unroll
                    for (int r = r0; r < r0 + 2; ++r) selbits |= (kk[r] > T || (kk[r] == T && lane4 <= J - (256 * (r >> 2) + (r & 3)))) ? (1u << r) : 0u;
                    __builtin_amdgcn_sched_barrier(0);
                }
            }
#pragma unroll
            for (int ip = 0; ip < 8; ++ip) {
                const int kg = lane + 64 * ip;
                if (kg < NG) {
                    const unsigned nib = (selbits >> (4 * ip)) & 15u;
                    const int tile = (lane >> 4) + 4 * ip;
                    __hip_atomic_fetch_or(maskw + ((qq * 32 + tile) * 2 + ((lane & 15) >> 3)), nib << (4 * (lane & 7)), __ATOMIC_RELAXED, __HIP_MEMORY_SCOPE_WORKGROUP);
                }
            }
        }
    } else {
        for (int i = tid; i < 2048; i += NTHR) maskw[i] = 0xffffffffu;
    }

    __syncthreads();
    { unsigned* dst = maskg + ((size_t)b * SEQ + 32 * qb) * 64;
      for (int i = tid; i < 2048; i += NTHR) dst[i] = maskw[i]; }
    __syncthreads();
}

__device__ __forceinline__ void dsa_attn_unit(LAS unsigned char* lds, int b, int qb, const h16* __restrict__ proj, const unsigned* __restrict__ maskg,
                                              const h16* __restrict__ WukT, const h16* __restrict__ WuvT, h16* __restrict__ mix, int tid, int lane, int wave) {
    const int c = qb >> 1;
    const h16* pb = proj + (size_t)b * SEQ * NP;
    const size_t m = (size_t)b * SEQ + 32 * qb + (lane & 31);
    const h16* prow = proj + m * NP;
    const unsigned* maskq = maskg + m * 64;
    kstage_dma(lds, 0, pb, 0, lane, wave);
    const int q = lane & 31, h = lane >> 5;
    const int hd = wave;
    f16x8 qbf[8]; f16x8 qpe;
    {
        f16x8 qn[3];
#pragma unroll
        for (int s = 0; s < 3; ++s) qn[s] = *(const f16x8*)(prow + C_QN + 48 * hd + 16 * s + 8 * h);
        qpe = *(const f16x8*)(prow + C_QPE + 16 * hd + 8 * h);
#pragma unroll
        for (int ct = 0; ct < 4; ++ct) {
            f32x16 acc;
#pragma unroll
            for (int r = 0; r < 16; ++r) acc[r] = 0.f;
#pragma unroll
            for (int s = 0; s < 3; ++s) {
                const f16x8 wa = *(const f16x8*)(WukT + (size_t)(hd * 128 + 32 * ct + q) * 48 + 16 * s + 8 * h);
                acc = mfma32(wa, qn[s], acc);
            }
#pragma unroll
            for (int k2 = 0; k2 < 2; ++k2) {
                f16x8 t;
#pragma unroll
                for (int j = 0; j < 8; ++j) t[j] = (_Float16)acc[8 * k2 + j];
                qbf[2 * ct + k2] = t;
            }
        }
    }
    f32x16 O[4];
#pragma unroll
    for (int ct = 0; ct < 4; ++ct)
#pragma unroll
        for (int r = 0; r < 16; ++r) O[ct][r] = 0.f;
    float mrun = NEG, lrun = 0.f;
    const int qq4 = (lane & 15) >> 2, p4 = lane & 3, b16 = (lane >> 4) & 1;

    __syncthreads();
    for (int t = 0; t <= c; ++t) {
        const int buf = t & 1;
        if (t < c) kstage_dma(lds, buf ^ 1, pb, 64 * (t + 1), lane, wave);
        const LAS unsigned char* kt0 = lds + L_KT + buf * 16384;
        const LAS unsigned char* kr0 = lds + L_KR + buf * 2048;
#pragma unroll 1
        for (int blk = 0; blk < 2; ++blk) {
            const LAS unsigned char* img = kt0 + blk * 8192;
            f32x16 S;
#pragma unroll
            for (int r = 0; r < 16; ++r) S[r] = 0.f;
#pragma unroll
            for (int ks = 0; ks < 8; ++ks) {
                const f16x8 ka = *(const LAS f16x8*)(img + off_b(q, 2 * ks + h));
                S = mfma32(ka, qbf[ks], S);
                if ((ks & 3) == 3) __builtin_amdgcn_sched_barrier(0);
            }
            {
                const f16x8 kr = *(const LAS f16x8*)(kr0 + (32 * blk + q) * 32 + 16 * h);
                S = mfma32(kr, qpe, S);
            }
            const unsigned mw = (c < 4 ? 0xffffffffu : maskq[2 * t + blk]) >> (4 * h);
            float mt = NEG;
#pragma unroll
            for (int r = 0; r < 16; ++r) {
                const bool on = (mw >> ((r & 3) + 8 * (r >> 2))) & 1u;
                const float v = on ? S[r] : NEG;
                S[r] = v; mt = fmaxf(mt, v);
            }
            mt = fmaxf(mt, xhalf(mt));
            const float mnew = fmaxf(mrun, mt);
            const float alpha = __builtin_amdgcn_exp2f(mrun - mnew);
            mrun = mnew;
            if (__any(alpha != 1.0f)) {
#pragma unroll
                for (int ct = 0; ct < 4; ++ct)
#pragma unroll
                    for (int r = 0; r < 16; ++r) O[ct][r] *= alpha;
            }
            float ps = 0.f;
#pragma unroll
            for (int r = 0; r < 16; ++r) {
                const float v = S[r];
                float e = __builtin_amdgcn_exp2f(v - mnew);
                e = (v > -1.0e38f) ? e : 0.f;
                S[r] = e; ps += e;
            }
            lrun = lrun * alpha + ps;
            f16x8 pk[2];
#pragma unroll
            for (int s2 = 0; s2 < 2; ++s2)
#pragma unroll
                for (int j = 0; j < 8; ++j) pk[s2][j] = (_Float16)S[8 * s2 + j];
#pragma unroll
            for (int s2 = 0; s2 < 2; ++s2)
#pragma unroll
                for (int ct = 0; ct < 4; ++ct) {
                    const f16x4 v0 = vtr(img + off_b(16 * s2 + 4 * h + qq4, 4 * ct + 2 * b16 + (p4 >> 1)) + 8 * (p4 & 1));
                    const f16x4 v1 = vtr(img + off_b(16 * s2 + 8 + 4 * h + qq4, 4 * ct + 2 * b16 + (p4 >> 1)) + 8 * (p4 & 1));
                    const f16x8 va = (f16x8){v0[0], v0[1], v0[2], v0[3], v1[0], v1[1], v1[2], v1[3]};
                    O[ct] = mfma32(va, pk[s2], O[ct]);
                    if (ct & 1) __builtin_amdgcn_sched_barrier(0);
                }
        }
        __syncthreads();
    }
    {
        const float ltot = lrun + xhalf(lrun);
        const float inv = 1.0f / ltot;
        f16x8 ob[8];
#pragma unroll
        for (int ks = 0; ks < 8; ++ks)
#pragma unroll
            for (int j = 0; j < 8; ++j) ob[ks][j] = (_Float16)(O[ks >> 1][8 * (ks & 1) + j] * inv);
#pragma unroll
        for (int dt = 0; dt < 2; ++dt) {
            f32x16 acc;
#pragma unroll
            for (int r = 0; r < 16; ++r) acc[r] = 0.f;
#pragma unroll
            for (int ks = 0; ks < 8; ++ks) {
                const f16x8 wa = *(const f16x8*)(WuvT + (size_t)(hd * 64 + 32 * dt + q) * 128 + 16 * ks + 8 * h);
                acc = mfma32(wa, ob[ks], acc);
            }
#pragma unroll
            for (int r4 = 0; r4 < 4; ++r4) {
                const int d0 = 32 * dt + 8 * r4 + 4 * h;
                const f16x4 g4 = *(const f16x4*)(prow + C_DG + 64 * hd + d0);
                f16x4 o4;
#pragma unroll
                for (int e = 0; e < 4; ++e) o4[e] = (_Float16)(acc[4 * r4 + e] * (float)g4[e]);
                *(f16x4*)(mix + m * DM + 512 + 64 * hd + d0) = o4;
            }
        }
    }
}
}
__device__ __forceinline__ void final_norm(float* out, const float* ssq2, const float* g, int G, int bx, int lane, int wave) {
    const int gw = bx * NWAVES + wave, NGW = G * NWAVES;
    f32x4 gg[4];
#pragma unroll
    for (int j = 0; j < 4; ++j) gg[j] = ((const f32x4*)g)[lane + 64 * j];
    for (int row = gw; row < MTOK; row += NGW) {
        const float rstd = rsqrtf(ssq2[row] * (1.0f / DM) + EPS);
        f32x4* orow = (f32x4*)(out + (size_t)row * DM);
#pragma unroll
        for (int j = 0; j < 4; ++j) { f32x4 v = orow[lane + 64 * j]; v = v * gg[j] * rstd; orow[lane + 64 * j] = v; }
    }
}

#ifndef EN_P0
#define EN_P0 1
#endif
#ifndef EN_P1
#define EN_P1 1
#endif
#ifndef EN_P1B
#define EN_P1B 1
#endif
#ifndef EN_RET
#define EN_RET 1
#endif
#ifndef EN_DSA
#define EN_DSA 1
#endif
#ifndef EN_P3A
#define EN_P3A 1
#endif
#ifndef EN_P3B
#define EN_P3B 1
#endif
#ifndef EN_P4
#define EN_P4 1
#endif
#ifndef EN_P5
#define EN_P5 1
#endif
__global__ void __launch_bounds__(NTHR, 2) mega_fwd(Args a) {
    extern __shared__ __attribute__((aligned(16))) unsigned char lds_raw[];
    LAS unsigned char* lds = (LAS unsigned char*)lds_raw;
    volatile LAS unsigned* MISC = (volatile LAS unsigned*)(lds + MISC_OFF);
    const int wave = __builtin_amdgcn_readfirstlane((int)threadIdx.x >> 6);
    const int G = gridDim.x, bx = blockIdx.x;
#define PHASE_IDS() int lane = (int)__builtin_amdgcn_mbcnt_hi(~0u, __builtin_amdgcn_mbcnt_lo(~0u, 0u)); asm volatile("" : "+v"(lane)); const int tid = wave * 64 + lane; (void)tid
    { PHASE_IDS();
    for (int u = tid; u < (LDS_BYTES - LDSCTL_OFF) / 4; u += NTHR) ((LAS unsigned*)(lds + LDSCTL_OFF))[u] = 0u; }
    __syncthreads();
    unsigned char* ws = a.ws;
    unsigned* ctl = (unsigned*)(ws + WS_CTL);
    float* ssq1 = (float*)(ws + WS_CTL); float* ssq2 = ssq1 + MTOK;
    const float2* tab = (const float2*)(ws + WS_TAB);
    h16* WinT = (h16*)(ws + WS_WIN); h16* WoutT = (h16*)(ws + WS_WOUT); h16* WgT = (h16*)(ws + WS_WG); h16* WpT = (h16*)(ws + WS_WP);
    h16* A0 = (h16*)(ws + WS_A0); h16* P16 = (h16*)(ws + WS_P16); h16* proj = (h16*)(ws + WS_PROJ); h16* mix = (h16*)(ws + WS_MIX); h16* pp = (h16*)(ws + WS_PP);
    h16* x1h = A0;
    XcdBarrier bar = xcd_barrier_post(ctl + CW_BAR, MISC + 8);

#if EN_P0
    { PHASE_IDS(); p0_prologue(a, lds, G, bx, tid, lane, wave); }
#endif
    xcd_barrier(bar);

#if EN_P1
    {
        pg8::Gemm g{(const pg8::bf16_t*)A0, (const pg8::bf16_t*)WinT, MTOK, NP, DM}; pg8::StaticOrder S; S.init(MTOK, NP, G, bx);
        pg8::EpiProj E{proj, tab};
        pg8::gemm_phase<pg8::EpiProj, pg8::StaticOrder, true, true>(lds, g, S, E, wave);
    }
#endif
    xcd_barrier(bar);

#if EN_P1B
    { PHASE_IDS(); fix_ckv(proj, a.kv_norm, G, bx, lane, wave); }
#endif
    xcd_barrier(bar);

#if EN_RET
    { PHASE_IDS(); for (int u = bx; u < BATCH * 8; u += G) retention_unit((LAS float*)lds, u >> 3, u & 7, proj, a.ret_norm, mix, tid); }
#endif
#if EN_DSA
    { PHASE_IDS();
    unsigned* maskg = (unsigned*)(ws + WS_MASK);
    for (int j = 0; j < 8; ++j) {
        const int b = (bx >> 6) + 4 * j, qb = (j & 1) ? 63 - (bx & 63) : (bx & 63);
        if (qb >= 8) dsa::dsa_select_unit(lds, b, qb, proj, (float*)(ws + WS_SCR) + (size_t)bx * (32 * 2048), maskg, tid, lane, wave);
    } }
    __syncthreads();
    { PHASE_IDS();
    const unsigned* maskg = (const unsigned*)(ws + WS_MASK);
    for (int j = 0; j < 8; ++j) {
        const int b = (bx >> 6) + 4 * j, qb = (j & 1) ? 63 - (bx & 63) : (bx & 63);
        dsa::dsa_attn_unit(lds, b, qb, proj, maskg, (const h16*)(ws + WS_WUK), (const h16*)(ws + WS_WUV), mix, tid, lane, wave);
    } }
#endif
    xcd_barrier(bar);

#if EN_P3A
    {
        pg8::Gemm g{(const pg8::bf16_t*)mix, (const pg8::bf16_t*)WoutT, MTOK, DM, DM}; pg8::StaticOrder S; S.init(MTOK, DM, G, bx);
        pg8::EpiOut E{a.x, x1h, ssq1};
        pg8::gemm_phase<pg8::EpiOut, pg8::StaticOrder, true, true>(lds, g, S, E, wave);
    }
#endif
    __syncthreads();
#if EN_P3B
    {
        int kp = PLE; asm volatile("" : "+s"(kp));
        pg8::Gemm g{(const pg8::bf16_t*)P16, (const pg8::bf16_t*)WpT, MTOK, DM, kp}; pg8::StaticOrder S; S.init(MTOK, DM, G, bx);
        pg8::EpiPle E{pp};
        pg8::gemm_phase<pg8::EpiPle, pg8::StaticOrder, true, true>(lds, g, S, E, wave);
    }
#endif
    xcd_barrier(bar);

#if EN_P4
    {
        pg8::Gemm g{(const pg8::bf16_t*)x1h, (const pg8::bf16_t*)WgT, MTOK, DM, DM}; pg8::StaticOrder S; S.init(MTOK, DM, G, bx);
        pg8::EpiGate E{x1h, pp, ssq1, a.out, ssq2};
        pg8::gemm_phase<pg8::EpiGate, pg8::StaticOrder, true, true>(lds, g, S, E, wave);
    }
#endif
    xcd_barrier(bar);

#if EN_P5
    { PHASE_IDS(); final_norm(a.out, ssq2, a.norm_final, G, bx, lane, wave); }
#endif
}

extern "C" void kernel_launch(void* const* d_in, const int* in_sizes, int n_in, void* d_out, int out_size, void* d_ws, size_t ws_size, hipStream_t stream) {
    static int grid = 0;
    if (grid == 0) {
        if (n_in != 14 || ws_size < WS_END) { fprintf(stderr, "kernel_launch: unexpected inputs (n_in %d, ws %zu)\n", n_in, ws_size); grid = -1; return; }
        int dev = 0, cus = 0;
        if (hipGetDevice(&dev) != hipSuccess || hipDeviceGetAttribute(&cus, hipDeviceAttributeMultiprocessorCount, dev) != hipSuccess) { grid = -1; return; }
        if (hipFuncSetAttribute((const void*)mega_fwd, hipFuncAttributeMaxDynamicSharedMemorySize, LDS_BYTES) != hipSuccess) { fprintf(stderr, "kernel_launch: hipFuncSetAttribute failed\n"); grid = -1; return; }
        grid = cus;
    }
    if (grid < 0) return;
    if (hipMemsetAsync((char*)d_ws + WS_CTL, 0, CTL_BYTES, stream) != hipSuccess) return;
    Args a{};
    a.x = (const float*)d_in[0]; a.p = (const float*)d_in[1]; a.pos = (const int*)d_in[2]; a.norm_mix = (const float*)d_in[3]; a.w_in = (const float*)d_in[4];
    a.ret_norm = (const float*)d_in[5]; a.kv_norm = (const float*)d_in[6]; a.w_uk = (const float*)d_in[7]; a.w_uv = (const float*)d_in[8]; a.w_out = (const float*)d_in[9];
    a.norm_ple = (const float*)d_in[10]; a.w_ple_gate = (const float*)d_in[11]; a.w_ple_proj = (const float*)d_in[12]; a.norm_final = (const float*)d_in[13];
    a.out = (float*)d_out; a.ws = (unsigned char*)d_ws;
    hipLaunchKernelGGL(mega_fwd, dim3(grid), dim3(NTHR), LDS_BYTES, stream, a);
}
```

```cpp
#include <hip/hip_runtime.h>
#ifndef FUSE_CKV
#define FUSE_CKV 1
#endif
#ifndef RET_DYN
#define RET_DYN 1
#endif
#ifndef DYN_NS
#define DYN_NS 4
#endif
#ifndef DYN_TAIL
#define DYN_TAIL 0
#endif
#include <cstdio>
#include <cstdint>

typedef _Float16 h16;
typedef h16 h16x8 __attribute__((ext_vector_type(8)));
typedef h16 h16x4 __attribute__((ext_vector_type(4)));
typedef h16 h16x2 __attribute__((ext_vector_type(2)));

constexpr int BATCH = 32, SEQ = 2048, DM = 1024, MTOK = BATCH * SEQ;
constexpr int NP = 3584;
constexpr int PLE = 256;
constexpr float EPS = 1e-6f;
constexpr int C_RQ = 0, C_RK = 512, C_RV = 1024, C_RG = 1536, C_QPE = 2048, C_QN = 2176, C_CKV = 2560, C_KPE = 2688, C_KI = 2704, C_IW = 2736,
              C_DG = 2752, C_IQ = 3264, C_END = 3520;
constexpr int NFREQ = 44;

constexpr size_t MiB = 1u << 20;
constexpr size_t WS_CTL = 0;
constexpr size_t CTL_BYTES = 1 * MiB;
constexpr size_t WS_TAB = 1 * MiB;
constexpr size_t WS_WIN = 2 * MiB;
constexpr size_t WS_WOUT = 10 * MiB;
constexpr size_t WS_WG = 12 * MiB;
constexpr size_t WS_WP = 14 * MiB;
constexpr size_t WS_A0 = 16 * MiB;
constexpr size_t WS_P16 = 144 * MiB;
constexpr size_t WS_PROJ = 176 * MiB;
constexpr size_t WS_MIX = 624 * MiB;
constexpr size_t WS_PP = 752 * MiB;
constexpr size_t WS_SCR = 880 * MiB;
constexpr size_t WS_WUK = 944 * MiB;
constexpr size_t WS_WUV = 945 * MiB;
constexpr size_t WS_MASK = 946 * MiB;
constexpr size_t WS_END = 962 * MiB;
constexpr int CW_BAR = 131072;
constexpr int CW_QUEUE = 139008;

__host__ __device__ inline int orig_col(int n) {
    if (n < 1024) { int h = (n & 511) >> 6, j = n & 63, i = j >> 1, b = j & 1; return (n & 512) + 64 * h + i + 32 * b; }
    if (n < 2048) return n;
    if (n < 2176) { int j = n - 2048, h = j >> 4, jj = j & 15, i = jj >> 1, b = jj & 1; return 2048 + 64 * h + i + 8 * b; }
    if (n < 2560) { int j = n - 2176, h = j / 48, jj = j % 48; return 2048 + 64 * h + 16 + jj; }
    if (n < 2688) { int p = n - 2560, g = (p >> 2) & 3; if (g == 1) p += 4; else if (g == 2) p -= 4; return 2560 + p; }
    if (n < 2704) { int j = n - 2688, i = j >> 1, b = j & 1; return 2688 + i + 8 * b; }
    if (n < 2736) { int j = n - 2704; if (j < 8) { int i = j >> 1, b = j & 1; return 3472 + i + 4 * b; } return 3472 + j; }
    if (n < 2744) return 3504 + (n - 2736);
    if (n < 2752) return -1;
    if (n < 3264) return 2704 + (n - 2752);
    if (n < 3520) { int j = n - 3264, h = j >> 5, jj = j & 31; if (jj < 8) { int i = jj >> 1, b = jj & 1; return 3216 + 32 * h + i + 4 * b; } return 3216 + 32 * h + jj; }
    return -1;
}
__host__ __device__ inline float col_scale(int n) {
    if (n < 512) return 0.125f;
    if (n >= 2048 && n < 2560) return 0.125f * 1.4426950408889634f;
    if (n >= 2736 && n < 2744) return 0.0625f;
    return 1.0f;
}
__device__ __forceinline__ int freq_idx(int n) {
    if (n < 1024) return (n & 63) >> 1;
    if (n >= 2048 && n < 2176) return 32 + ((n & 15) >> 1);
    if (n >= 2688 && n < 2704) return 32 + ((n - 2688) >> 1);
    if (n >= 2704 && n < 2712) return 40 + ((n - 2704) >> 1);
    if (n >= 3264 && n < 3520) { int jj = (n - 3264) & 31; if (jj < 8) return 40 + (jj >> 1); }
    return -1;
}
__device__ __forceinline__ float silu_f(float v) { return v * __builtin_amdgcn_rcpf(1.0f + __builtin_amdgcn_exp2f(-1.4426950408889634f * v)); }
__device__ __forceinline__ float sigmoid_f(float v) { return __builtin_amdgcn_rcpf(1.0f + __builtin_amdgcn_exp2f(-1.4426950408889634f * v)); }
__device__ __forceinline__ float wave_sum(float v) {
#pragma unroll
    for (int o = 1; o < 64; o <<= 1) v += __shfl_xor(v, o);
    return v;
}
__host__ __device__ __forceinline__ size_t tix(int row, int col, int K) { return ((size_t)(row >> 7) * (K >> 6) + (col >> 6)) * 8192 + (size_t)((row & 127) * 64 + (col & 63)); }
#define LAS __attribute__((address_space(3)))
#define GAS __attribute__((address_space(1)))

namespace pg8 {
#define PG8_LAS __attribute__((address_space(3)))
typedef unsigned short bf16_t;
typedef _Float16 bf16x8 __attribute__((ext_vector_type(8)));
typedef float f32x4 __attribute__((ext_vector_type(4)));
typedef unsigned u32x4 __attribute__((ext_vector_type(4)));
constexpr int BM = 256, BK = 64, HALF = 128, HTB = HALF * BK * 2  , STAGE_BYTES = 8 * HTB, NXCD = 8, WGM = 4;

__host__ __device__ __forceinline__ int lds_byte(int r, int c) { const int st = (r >> 4) * 2 + (c >> 5), rr = r & 15, cc = c & 31, ob = rr * 64 + cc * 2; return st * 1024 + (ob ^ (((ob >> 9) & 1) << 5)); }
__host__ __device__ __forceinline__ void stage_rc(int b, int& R, int& C) { const int st = b / 1024, sb = b % 1024, swz = sb ^ (((sb >> 9) & 1) << 5); R = (st >> 1) * 16 + swz / 64; C = (st & 1) * 32 + (swz % 64) / 2; }
__host__ __device__ __forceinline__ int perm32(int rho) { const int n = rho >> 4, i = rho & 15; return 8 * (i >> 2) + 4 * n + (i & 3); }

struct Unit { int pm, pn; };
struct Gemm { const bf16_t* A; const bf16_t* Bt; int M, N, K; bool tiledA; float* dbg = nullptr; };

struct StaticOrder {
    int nM, nN, nwg, G, c;
    __host__ __device__ void init(int M, int N, int G_, int c_) { nM = M / BM; nN = N / BM; nwg = nM * nN; G = G_; c = c_; }
    __host__ __device__ bool next(int i, Unit& u) const {
        const long L = (long)i * G + c; if (L >= nwg) return false;
        int wgid = (int)L; { const int q = nwg / NXCD, r = nwg % NXCD, xcd = wgid % NXCD, off = wgid / NXCD; wgid = (xcd < r ? xcd * (q + 1) : r * (q + 1) + (xcd - r) * q) + off; }
        const int nig = WGM * nN, gid = wgid / nig, fm = gid * WGM, gsz = (nM - fm) < WGM ? (nM - fm) : WGM;
        u.pm = fm + ((wgid % nig) % gsz); u.pn = (wgid % nig) / gsz; return true;
    }
    __device__ __forceinline__ void a_ready(const Unit&) const {}
    __device__ __forceinline__ void done(const Unit&) const {}
};

typedef short s16x8 __attribute__((ext_vector_type(8)));
template <bool BF> __device__ __forceinline__ f32x4 mma16(bf16x8 a, bf16x8 b, f32x4 c) {
    if constexpr (BF) return __builtin_amdgcn_mfma_f32_16x16x32_bf16(__builtin_bit_cast(s16x8, a), __builtin_bit_cast(s16x8, b), c, 0, 0, 0);
    else return __builtin_amdgcn_mfma_f32_16x16x32_f16(a, b, c, 0, 0, 0);
}
__device__ __forceinline__ unsigned short f2bf(float f) { const unsigned u = __builtin_bit_cast(unsigned, f); return (unsigned short)((u + 0x7fffu + ((u >> 16) & 1u)) >> 16); }
__device__ __forceinline__ float bf2f(unsigned short b) { return __builtin_bit_cast(float, (unsigned)b << 16); }
typedef unsigned short u16x8 __attribute__((ext_vector_type(8)));
__device__ __forceinline__ u16x8 pack8bf(const f32x4& a, const f32x4& b) {
    u16x8 o; o[0] = f2bf(a[0]); o[1] = f2bf(a[1]); o[2] = f2bf(a[2]); o[3] = f2bf(a[3]); o[4] = f2bf(b[0]); o[5] = f2bf(b[1]); o[6] = f2bf(b[2]); o[7] = f2bf(b[3]); return o;
}
__device__ __forceinline__ h16x8 pack8(const f32x4& a, const f32x4& b) {
    h16x8 o; o[0] = (h16)a[0]; o[1] = (h16)a[1]; o[2] = (h16)a[2]; o[3] = (h16)a[3]; o[4] = (h16)b[0]; o[5] = (h16)b[1]; o[6] = (h16)b[2]; o[7] = (h16)b[3]; return o;
}
struct EpiProj {
    static constexpr bool PERM = true, AFTER_DRAIN = false;
    h16* proj; const float2* tab; const float* kvn; PG8_LAS float* ssx;
    __device__ __forceinline__ void operator()(const f32x4 (&acc)[2][2][4][2], const Unit& u, int wr, int wc, int fr, int fq) const {
        const bool ck = (u.pn == C_CKV / BM);
        float rs[2][4]; f32x4 kw0 = (f32x4){1.f, 1.f, 1.f, 1.f}, kw1 = kw0;
#pragma unroll
        for (int ai = 0; ai < 2; ++ai)
#pragma unroll
            for (int m = 0; m < 4; ++m) rs[ai][m] = 1.f;
        if (ck) {
#pragma unroll
            for (int ai = 0; ai < 2; ++ai)
#pragma unroll
                for (int m = 0; m < 4; ++m) {
                    const f32x4 a = acc[ai][0][m][0], b = acc[ai][0][m][1];
                    float s_ = (a[0] * a[0] + a[1] * a[1]) + (a[2] * a[2] + a[3] * a[3]) + (b[0] * b[0] + b[1] * b[1]) + (b[2] * b[2] + b[3] * b[3]);
                    s_ += __shfl_xor(s_, 16); s_ += __shfl_xor(s_, 32);
                    if (fq == 0) ssx[(ai * HALF + wr * 64 + m * 16 + fr) * 4 + wc] = s_;
                }
            { int p0 = 32 * wc + 8 * fq, p1 = p0 + 4; if (fq & 1) p0 -= 4; else p1 += 4;
              kw0 = *(const f32x4*)(kvn + p0); kw1 = *(const f32x4*)(kvn + p1); }
            asm volatile("s_waitcnt lgkmcnt(0)" ::: "memory"); __builtin_amdgcn_s_barrier();
#pragma unroll
            for (int ai = 0; ai < 2; ++ai)
#pragma unroll
                for (int m = 0; m < 4; ++m) { const f32x4 t = *(const PG8_LAS f32x4*)(ssx + (ai * HALF + wr * 64 + m * 16 + fr) * 4); rs[ai][m] = rsqrtf(((t[0] + t[1]) + (t[2] + t[3])) * (1.0f / 128.0f) + EPS); }
        }
#pragma unroll
        for (int bj = 0; bj < 2; ++bj) {
            const int cb = u.pn * BM + bj * HALF + wc * 32;
            const int c0 = cb + 8 * fq;
            const bool rot = (cb < 1024) || (cb >= 2048 && cb < 2176) || (cb == 2688) || (cb >= 3264 && cb < 3520);
            const bool sil = (cb >= 1536 && cb < 2048) || (cb >= 2752 && cb < 3264);
            const int f0 = freq_idx(c0);
#pragma unroll
            for (int ai = 0; ai < 2; ++ai)
#pragma unroll
                for (int m = 0; m < 4; ++m) {
                    const int row = u.pm * BM + ai * HALF + wr * 64 + m * 16 + fr;
                    f32x4 a = acc[ai][bj][m][0], b = acc[ai][bj][m][1];
                    if (rot) {
                        f32x4 t0 = (f32x4){1.f, 0.f, 1.f, 0.f}, t1 = t0;
                        if (f0 >= 0) { const f32x4* tp = (const f32x4*)(tab + (size_t)(row & (SEQ - 1)) * NFREQ + f0); t0 = tp[0]; t1 = tp[1]; }
                        f32x4 ra, rb;
                        ra[0] = a[0] * t0[0] - a[1] * t0[1]; ra[1] = a[1] * t0[0] + a[0] * t0[1];
                        ra[2] = a[2] * t0[2] - a[3] * t0[3]; ra[3] = a[3] * t0[2] + a[2] * t0[3];
                        rb[0] = b[0] * t1[0] - b[1] * t1[1]; rb[1] = b[1] * t1[0] + b[0] * t1[1];
                        rb[2] = b[2] * t1[2] - b[3] * t1[3]; rb[3] = b[3] * t1[2] + b[2] * t1[3];
                        a = ra; b = rb;
                    } else if (sil) {
#pragma unroll
                        for (int e = 0; e < 4; ++e) { a[e] = silu_f(a[e]); b[e] = silu_f(b[e]); }
                    }
                    if (ck && bj == 0) { const float r_ = rs[ai][m];
#pragma unroll
                        for (int e = 0; e < 4; ++e) { a[e] *= r_ * kw0[e]; b[e] *= r_ * kw1[e]; } }
                    *(h16x8*)(proj + (size_t)row * NP + c0) = pack8(a, b);
                    if (m == 3) asm volatile("" ::: "memory");
                }
        }
    }
};
struct EpiOut {
    static constexpr bool PERM = true, AFTER_DRAIN = false;
    const h16* a0; const float* rnorm; const float* g; h16* x1h; float* ssq1;
    __device__ __forceinline__ void operator()(const f32x4 (&acc)[2][2][4][2], const Unit& u, int wr, int wc, int fr, int fq) const {
        f32x4 gi[2][2];
#pragma unroll
        for (int bj = 0; bj < 2; ++bj) {
            const int c0 = u.pn * BM + bj * HALF + wc * 32 + 8 * fq;
            const f32x4* gp = (const f32x4*)(g + c0);
#pragma unroll
            for (int n = 0; n < 2; ++n) { const f32x4 gv = gp[n]; gi[bj][n] = (f32x4){__builtin_amdgcn_rcpf(gv[0]), __builtin_amdgcn_rcpf(gv[1]), __builtin_amdgcn_rcpf(gv[2]), __builtin_amdgcn_rcpf(gv[3])}; }
        }
#pragma unroll
        for (int ai = 0; ai < 2; ++ai)
#pragma unroll
            for (int m = 0; m < 4; ++m) {
                const int row = u.pm * BM + ai * HALF + wr * 64 + m * 16 + fr; float ss = 0.f;
                const float rn = rnorm[row];
#pragma unroll
                for (int bj = 0; bj < 2; ++bj) {
                    const int c0 = u.pn * BM + bj * HALF + wc * 32 + 8 * fq;
                    const h16x8 xv = *(const h16x8*)(a0 + tix(row, c0, DM));
                    f32x4 a = acc[ai][bj][m][0], b = acc[ai][bj][m][1];
#pragma unroll
                    for (int e2 = 0; e2 < 4; ++e2) { a[e2] += (float)xv[e2] * rn * gi[bj][0][e2]; b[e2] += (float)xv[4 + e2] * rn * gi[bj][1][e2]; }
                    ss += (a[0] * a[0] + a[1] * a[1]) + (a[2] * a[2] + a[3] * a[3]) + (b[0] * b[0] + b[1] * b[1]) + (b[2] * b[2] + b[3] * b[3]);
                    *(h16x8*)(x1h + (size_t)row * DM + c0) = pack8(a, b);
                }
                ss += __shfl_xor(ss, 16); ss += __shfl_xor(ss, 32);
                if (fq == 0) atomicAdd(ssq1 + row, ss);
                if (m == 3) asm volatile("" ::: "memory");
            }
    }
};
struct EpiPle {
    static constexpr bool PERM = true, AFTER_DRAIN = false;
    h16* pp;
    __device__ __forceinline__ void operator()(const f32x4 (&acc)[2][2][4][2], const Unit& u, int wr, int wc, int fr, int fq) const {
#pragma unroll
        for (int ai = 0; ai < 2; ++ai)
#pragma unroll
            for (int m = 0; m < 4; ++m) {
                const int row = u.pm * BM + ai * HALF + wr * 64 + m * 16 + fr;
#pragma unroll
                for (int bj = 0; bj < 2; ++bj) {
                    const int c0 = u.pn * BM + bj * HALF + wc * 32 + 8 * fq;
                    *(h16x8*)(pp + (size_t)row * DM + c0) = pack8(acc[ai][bj][m][0], acc[ai][bj][m][1]);
                }
            }
    }
};
struct EpiGate {
    static constexpr bool PERM = true, AFTER_DRAIN = false;
    const h16* x1h; const h16* pp; const float* ssq1; h16* x2h; float* ssq2;
    __device__ __forceinline__ void operator()(const f32x4 (&acc)[2][2][4][2], const Unit& u, int wr, int wc, int fr, int fq) const {
#pragma unroll
        for (int ai = 0; ai < 2; ++ai)
#pragma unroll
            for (int m = 0; m < 4; ++m) {
                const int row = u.pm * BM + ai * HALF + wr * 64 + m * 16 + fr; float ss = 0.f;
                const float rstd = rsqrtf(ssq1[row] * (1.0f / DM) + EPS);
#pragma unroll
                for (int bj = 0; bj < 2; ++bj) {
                    const int c0 = u.pn * BM + bj * HALF + wc * 32 + 8 * fq;
                    const h16x8 xv = *(const h16x8*)(x1h + (size_t)row * DM + c0);
                    const h16x8 pv = *(const h16x8*)(pp + (size_t)row * DM + c0);
                    f32x4 a = acc[ai][bj][m][0], b = acc[ai][bj][m][1], ra, rb;
#pragma unroll
                    for (int e = 0; e < 4; ++e) {
                        ra[e] = (float)xv[e] + sigmoid_f(a[e] * rstd) * (float)pv[e];
                        rb[e] = (float)xv[4 + e] + sigmoid_f(b[e] * rstd) * (float)pv[4 + e];
                        ss += ra[e] * ra[e] + rb[e] * rb[e];
                    }
                    *(h16x8*)(x2h + (size_t)row * DM + c0) = pack8(ra, rb);
                }
                ss += __shfl_xor(ss, 16); ss += __shfl_xor(ss, 32);
                if (fq == 0) atomicAdd(ssq2 + row, ss);
                if (m == 3) asm volatile("" ::: "memory");
            }
    }
};
template <class Epi, class Sched, bool ALIGN_EPI = false, bool SP2 = false, bool BF = false>
__device__ __forceinline__ void gemm_phase(PG8_LAS unsigned char* lds, const Gemm g, const Sched& S, const Epi& E, int wave_in) {
    unsigned lz_ = 0u; asm volatile("" : "+v"(lz_)); int lane_o = (int)__builtin_amdgcn_mbcnt_hi(~0u, __builtin_amdgcn_mbcnt_lo(~0u, lz_)); asm volatile("" : "+v"(lane_o));
    const int wid = __builtin_amdgcn_readfirstlane(wave_in), lane = lane_o, tid = wid * 64 + lane, wr = wid >> 2, wc = wid & 3, fr = lane & 15, fq = lane >> 4;
    const int K = g.K, nt = K / BK;
    unsigned voffA[2], voffB[2];
#pragma unroll
    for (int i = 0; i < 2; ++i) { int R, C; stage_rc(tid * 16 + i * 8192, R, C); const int Rb = Epi::PERM ? ((R & ~31) + perm32(R & 31)) : R;
        voffA[i] = g.tiledA ? (unsigned)(R * BK + C) * 2u : (unsigned)(R * K + C) * 2u; voffB[i] = (unsigned)(Rb * K + C) * 2u; }
    const size_t kstep = (size_t)(BK * 2);
    const size_t kstepA = g.tiledA ? (size_t)(HALF * BK * 2) : kstep;
    const size_t hstep = (size_t)HALF * K * 2;
    const size_t tstep = 2 * hstep;
    const unsigned ldsw = (unsigned)wid * 1024u;
    const int aoff = lds_byte(wr * 64 + fr, fq * 8), boff = lds_byte(wc * 32 + fr, fq * 8);
#define PG8_SA(b, h) (((b) * 2 + (h)) * HTB)
#define PG8_SB(b, h) ((4 + (b) * 2 + (h)) * HTB)
#if defined(PROBE_GEMMWAIT) && PROBE_GEMMWAIT == 4
#define PG8_STAGE(bufoff, gbase, voff) do { const unsigned long long s0_ = __builtin_amdgcn_s_memtime(); _Pragma("unroll") for (int _i = 0; _i < 2; ++_i) \
        __builtin_amdgcn_global_load_lds((const unsigned*)((const char*)(gbase) + (voff)[_i]), (PG8_LAS unsigned*)(lds + (bufoff) + ldsw + _i * 8192), 16, 0, 0); pg_tm += __builtin_amdgcn_s_memtime() - s0_; } while (0)
#else
#define PG8_STAGE(bufoff, gbase, voff) do { _Pragma("unroll") for (int _i = 0; _i < 2; ++_i) \
        __builtin_amdgcn_global_load_lds((const unsigned*)((const char*)(gbase) + (voff)[_i]), (PG8_LAS unsigned*)(lds + (bufoff) + ldsw + _i * 8192), 16, 0, 0); } while (0)
#endif
#define PG8_LDA(dst, b, h) do { _Pragma("unroll") for (int m = 0; m < 4; ++m) _Pragma("unroll") for (int k = 0; k < 2; ++k) dst[m][k] = *(const PG8_LAS bf16x8*)(lds + PG8_SA(b, h) + aoff + m * 2048 + k * 1024); } while (0)
#define PG8_LDB(dst, b, h) do { _Pragma("unroll") for (int n = 0; n < 2; ++n) _Pragma("unroll") for (int k = 0; k < 2; ++k) dst[n][k] = *(const PG8_LAS bf16x8*)(lds + PG8_SB(b, h) + boff + n * 2048 + k * 1024); } while (0)
#define PG8_MMA(ai, bj, At, Bt) do { __builtin_amdgcn_s_setprio(1); _Pragma("unroll") for (int m = 0; m < 4; ++m) _Pragma("unroll") for (int n = 0; n < 2; ++n) _Pragma("unroll") for (int k = 0; k < 2; ++k) \
        acc[ai][bj][m][n] = mma16<BF>(Bt[n][k], At[m][k], acc[ai][bj][m][n]); __builtin_amdgcn_s_setprio(0); } while (0)
#define PG8_WAIT_V(n) asm volatile("s_waitcnt vmcnt(" #n ")" ::: "memory")
#define PG8_WAIT_L(n) asm volatile("s_waitcnt lgkmcnt(" #n ")" ::: "memory")
#define PG8_BAR __builtin_amdgcn_s_barrier()
#define PG8_SCHED __builtin_amdgcn_sched_barrier(0)
#if defined(PROBE_GEMMWAIT)
    unsigned long long pg_tw = 0, pg_tb = 0, pg_t0 = 0, pg_t1 = 0, pg_tm = 0; const unsigned long long pg_begin = __builtin_amdgcn_s_memtime();
#define PG8_TW0 pg_t0 = __builtin_amdgcn_s_memtime()
#define PG8_TW1 { const unsigned long long n_ = __builtin_amdgcn_s_memtime(); pg_tw += n_ - pg_t0; pg_t1 = n_; }
#if PROBE_GEMMWAIT >= 4
#define PG8_TB0 pg_t0 = __builtin_amdgcn_s_memtime()
#else
#define PG8_TB0 { pg_t0 = __builtin_amdgcn_s_memtime(); pg_tm += pg_t0 - pg_t1; }
#endif
#define PG8_TB1 pg_tb += __builtin_amdgcn_s_memtime() - pg_t0
#else
#define PG8_TW0
#define PG8_TW1
#define PG8_TB0
#define PG8_TB1
#endif
    Unit cur, nxt; int ui = 0;
    if (!S.next(0, cur)) return;
    f32x4 acc[2][2][4][2];
#pragma unroll
    for (int a = 0; a < 2; ++a)
#pragma unroll
        for (int b = 0; b < 2; ++b)
#pragma unroll
            for (int m = 0; m < 4; ++m)
#pragma unroll
                for (int n = 0; n < 2; ++n) acc[a][b][m][n] = (f32x4){0.f, 0.f, 0.f, 0.f};
    bf16x8 At[4][2], B0[2][2], B1[2][2];
    const char* cA = (const char*)g.A + (size_t)cur.pm * tstep; const char* cB = (const char*)g.Bt + (size_t)cur.pn * tstep;
    S.a_ready(cur);
    if constexpr (SP2) {
        PG8_STAGE(PG8_SB(0, 0), cB, voffB); PG8_STAGE(PG8_SB(0, 1), cB + hstep, voffB); PG8_STAGE(PG8_SA(0, 0), cA, voffA); PG8_STAGE(PG8_SA(0, 1), cA + hstep, voffA);
        if (wr == 1) PG8_BAR;
        PG8_WAIT_V(2); PG8_BAR;
        PG8_STAGE(PG8_SB(1, 0), cB + kstep, voffB); PG8_STAGE(PG8_SA(1, 0), cA + kstepA, voffA); PG8_STAGE(PG8_SB(1, 1), cB + hstep + kstep, voffB);
        PG8_WAIT_V(6); PG8_BAR;
    } else {
        PG8_STAGE(PG8_SB(0, 0), cB, voffB); PG8_STAGE(PG8_SA(0, 0), cA, voffA); PG8_STAGE(PG8_SB(0, 1), cB + hstep, voffB); PG8_STAGE(PG8_SA(0, 1), cA + hstep, voffA);
        if (wr == 1) PG8_BAR;
        PG8_WAIT_V(4); PG8_BAR;
        PG8_STAGE(PG8_SB(1, 0), cB + kstep, voffB); PG8_STAGE(PG8_SA(1, 0), cA + kstepA, voffA); PG8_STAGE(PG8_SB(1, 1), cB + hstep + kstep, voffB);
        PG8_WAIT_V(6); PG8_BAR;
    }
    for (;;) {
        const bool has_next = S.next(ui + 1, nxt);
        const char* nA = has_next ? (const char*)g.A + (size_t)nxt.pm * tstep : cA; const char* nB = has_next ? (const char*)g.Bt + (size_t)nxt.pn * tstep : cB;
        for (int t = 0; t < nt; t += 2) {
            const bool last = (t == nt - 2);
            const char* a1 = cA + (size_t)(t + 1) * kstepA;
            const char* a2 = last ? nA : cA + (size_t)(t + 2) * kstepA; const char* b2 = last ? nB : cB + (size_t)(t + 2) * kstep;
            const char* a3 = a2 + kstepA; const char* b3 = b2 + kstep;
            if (last && has_next) S.a_ready(nxt);
            if constexpr (SP2) {
            PG8_LDB(B0, 0, 0); PG8_LDB(B1, 0, 1); PG8_SCHED; PG8_LDA(At, 0, 0); PG8_STAGE(PG8_SA(1, 1), a1 + hstep, voffA);
            PG8_TW0; PG8_WAIT_V(8); PG8_WAIT_L(0); PG8_BAR; PG8_TW1; PG8_MMA(0, 0, At, B0); PG8_MMA(0, 1, At, B1); PG8_TB0; PG8_BAR; PG8_TB1; PG8_SCHED;
            PG8_LDA(At, 0, 1); PG8_STAGE(PG8_SB(0, 0), b2, voffB); PG8_STAGE(PG8_SB(0, 1), b2 + hstep, voffB); PG8_STAGE(PG8_SA(0, 0), a2, voffA);
            PG8_TW0; PG8_WAIT_V(8); PG8_WAIT_L(0); PG8_BAR; PG8_TW1; PG8_MMA(1, 0, At, B0); PG8_MMA(1, 1, At, B1); PG8_TB0; PG8_BAR; PG8_TB1; PG8_SCHED;
            PG8_LDB(B0, 1, 0); PG8_LDB(B1, 1, 1); PG8_SCHED; PG8_LDA(At, 1, 0); PG8_STAGE(PG8_SA(0, 1), a2 + hstep, voffA);
            PG8_TW0; PG8_WAIT_V(8); PG8_WAIT_L(0); PG8_BAR; PG8_TW1; PG8_MMA(0, 0, At, B0); PG8_MMA(0, 1, At, B1); PG8_TB0; PG8_BAR; PG8_TB1; PG8_SCHED;
            PG8_LDA(At, 1, 1); PG8_STAGE(PG8_SB(1, 0), b3, voffB); PG8_STAGE(PG8_SB(1, 1), b3 + hstep, voffB); PG8_STAGE(PG8_SA(1, 0), a3, voffA);
            PG8_TW0; PG8_WAIT_V(8); PG8_WAIT_L(0); PG8_BAR; PG8_TW1; PG8_MMA(1, 0, At, B0); PG8_MMA(1, 1, At, B1); PG8_TB0; PG8_BAR; PG8_TB1; PG8_SCHED;
            } else {
            PG8_LDB(B0, 0, 0); PG8_SCHED; PG8_LDA(At, 0, 0); PG8_STAGE(PG8_SA(1, 1), a1 + hstep, voffA);
            PG8_WAIT_L(8); PG8_BAR; PG8_WAIT_L(0); PG8_MMA(0, 0, At, B0); PG8_BAR; PG8_SCHED;
            PG8_LDB(B1, 0, 1); PG8_STAGE(PG8_SB(0, 0), b2, voffB);
            PG8_BAR; PG8_WAIT_L(0); PG8_MMA(0, 1, At, B1); PG8_BAR;
            PG8_LDA(At, 0, 1); PG8_STAGE(PG8_SA(0, 0), a2, voffA);
            PG8_BAR; PG8_WAIT_L(0); PG8_MMA(1, 0, At, B0); PG8_BAR; PG8_SCHED;
            PG8_STAGE(PG8_SB(0, 1), b2 + hstep, voffB);
            PG8_WAIT_V(6); PG8_BAR; PG8_MMA(1, 1, At, B1); PG8_BAR;
            PG8_LDB(B0, 1, 0); PG8_SCHED; PG8_LDA(At, 1, 0); PG8_STAGE(PG8_SA(0, 1), a2 + hstep, voffA);
            PG8_WAIT_L(8); PG8_BAR; PG8_WAIT_L(0); PG8_MMA(0, 0, At, B0); PG8_BAR; PG8_SCHED;
            PG8_LDB(B1, 1, 1); PG8_STAGE(PG8_SB(1, 0), b3, voffB);
            PG8_BAR; PG8_WAIT_L(0); PG8_MMA(0, 1, At, B1); PG8_BAR;
            PG8_LDA(At, 1, 1); PG8_STAGE(PG8_SA(1, 0), a3, voffA);
            PG8_BAR; PG8_WAIT_L(0); PG8_MMA(1, 0, At, B0); PG8_BAR; PG8_SCHED;
            PG8_STAGE(PG8_SB(1, 1), b3 + hstep, voffB);
            PG8_WAIT_V(6); PG8_BAR; PG8_MMA(1, 1, At, B1); PG8_BAR;
            }
        }
        if constexpr (ALIGN_EPI) { if (wr == 0) PG8_BAR; }
#if defined(PROBE_GEMMWAIT) && PROBE_GEMMWAIT == 5
        { const unsigned long long e0_ = __builtin_amdgcn_s_memtime(); if constexpr (!Epi::AFTER_DRAIN) { E(acc, cur, wr, wc, fr, fq); S.done(cur); } asm volatile("s_waitcnt vmcnt(0)" ::: "memory"); pg_tm += __builtin_amdgcn_s_memtime() - e0_; }
#elif defined(PROBE_GEMMWAIT) && PROBE_GEMMWAIT == 6
        { const unsigned long long e0_ = __builtin_amdgcn_s_memtime(); if constexpr (!Epi::AFTER_DRAIN) { E(acc, cur, wr, wc, fr, fq); S.done(cur); } asm volatile("" ::: "memory"); pg_tm += __builtin_amdgcn_s_memtime() - e0_; }
#else
        if constexpr (!Epi::AFTER_DRAIN) { E(acc, cur, wr, wc, fr, fq); S.done(cur); }
#endif
        if (!has_next) break;
#pragma unroll
        for (int a = 0; a < 2; ++a)
#pragma unroll
            for (int b = 0; b < 2; ++b)
#pragma unroll
                for (int m = 0; m < 4; ++m)
#pragma unroll
                    for (int n = 0; n < 2; ++n) acc[a][b][m][n] = (f32x4){0.f, 0.f, 0.f, 0.f};
        cur = nxt; cA = nA; cB = nB; ++ui;
        if constexpr (ALIGN_EPI) { if (wr == 1) PG8_BAR; }
    }
    PG8_WAIT_V(0);
    if constexpr (!ALIGN_EPI) { if (wr == 0) PG8_BAR; }
    PG8_BAR;
    if constexpr (Epi::AFTER_DRAIN) { E.fused(acc, cur, wr, wc, fr, fq, lds, wid, lane); S.done(cur); }
#if defined(PROBE_GEMMWAIT)
    if (blockIdx.x == 0 && wid == 0 && lane == 0 && g.dbg) { const float tot = (float)(__builtin_amdgcn_s_memtime() - pg_begin); g.dbg[0] = 50.0f * (float)(PROBE_GEMMWAIT == 1 ? pg_tw : (PROBE_GEMMWAIT == 2 ? pg_tb : pg_tm)) / tot; }
#endif
#undef PG8_TW0
#undef PG8_TW1
#undef PG8_TB0
#undef PG8_TB1
#undef PG8_SA
#undef PG8_SB
#undef PG8_STAGE
#undef PG8_LDA
#undef PG8_LDB
#undef PG8_MMA
#undef PG8_WAIT_V
#undef PG8_WAIT_L
#undef PG8_BAR
#undef PG8_SCHED
}
}
#define XB_TMO      128
#define XB_XCNT(j)  (256  + 64 * (j))
#define XB_XSUB(j)  (1280 + 64 * (j))
#define XB_XGEN(j)  (2304 + 64 * (j))
#define XB_TOP      3328
#define XB_TOPGEN   3392
#define XCD_BAR_WORDS 3456
#define XB_SPIN_CAP (1u << 18)

__device__ __forceinline__ unsigned xb_ld(unsigned* p)              { return __hip_atomic_load(p, __ATOMIC_RELAXED, __HIP_MEMORY_SCOPE_AGENT); }
__device__ __forceinline__ unsigned xb_add(unsigned* p, unsigned v) { return __hip_atomic_fetch_add(p, v, __ATOMIC_RELAXED, __HIP_MEMORY_SCOPE_AGENT); }
__device__ __forceinline__ unsigned xb_xcc_id() { return (unsigned)__builtin_amdgcn_s_getreg((3 << 11) | 20) & 0xFu; }
#define XB_SPIN(cond, bar) do { unsigned _sp = 0; while (cond) { __builtin_amdgcn_s_sleep(1); \
    if ((++_sp & 255u) == 0u) { if (xb_ld(&(bar)[XB_TMO])) break; if (_sp > XB_SPIN_CAP) { atomicAdd(&(bar)[XB_TMO], 1u); break; } } } } while (0)

struct XcdBarrier {
    unsigned* bar; unsigned x;
    volatile LAS unsigned* st;
};

__device__ __forceinline__ XcdBarrier xcd_barrier_post(unsigned* bar, volatile LAS unsigned* st) {
    XcdBarrier b; b.bar = bar; b.x = xb_xcc_id(); b.st = st;
    if (threadIdx.x == 0) (void)xb_add(&bar[XB_XCNT(b.x)], 1u);
    return b;
}
__device__ __forceinline__ void xcd_barrier_complete(unsigned* bar, unsigned x, unsigned& nloc, unsigned& nx) {
    const unsigned G = gridDim.x * gridDim.y * gridDim.z;
    unsigned sum, cnt, mine, sp = 0u;
    for (;;) {
        sum = 0u; cnt = 0u; mine = 0u;
#pragma unroll
        for (unsigned j = 0; j < 16; ++j) { const unsigned c = xb_ld(&bar[XB_XCNT(j)]); sum += c; cnt += (c > 0u) ? 1u : 0u; mine = (j == x) ? c : mine; }
        if (sum == G) break;
        __builtin_amdgcn_s_sleep(1);
        if ((++sp & 255u) == 0u) { if (xb_ld(&bar[XB_TMO])) break; if (sp > XB_SPIN_CAP) { atomicAdd(&bar[XB_TMO], 1u); break; } }
    }
    nloc = mine > 0u ? mine : 1u; nx = cnt > 0u ? cnt : 1u;
}

__device__ __forceinline__ void xcd_barrier(const XcdBarrier& b) {
    asm volatile("s_waitcnt vmcnt(0)" ::: "memory");
    __syncthreads();
    if (threadIdx.x == 0) {
        unsigned* bar = b.bar;
        __builtin_amdgcn_s_waitcnt(0);
        unsigned nloc = b.st[0], nx = b.st[1];
        if (nloc == 0u) { xcd_barrier_complete(bar, b.x, nloc, nx); b.st[0] = nloc; b.st[1] = nx; }
        const unsigned old = xb_add(&bar[XB_XSUB(b.x)], 1u);
        const unsigned gen = old / nloc;
        if (old + 1u == (gen + 1u) * nloc) {
            __builtin_amdgcn_fence(__ATOMIC_RELEASE, "agent");
            asm volatile("s_waitcnt vmcnt(0)" ::: "memory");
            const unsigned og = xb_add(&bar[XB_TOP], 1u);
            const unsigned tg = og / nx;
            if (og + 1u == (tg + 1u) * nx) xb_add(&bar[XB_TOPGEN], 1u);
            else XB_SPIN(xb_ld(&bar[XB_TOPGEN]) == tg, bar);
            __builtin_amdgcn_fence(__ATOMIC_ACQUIRE, "agent");
            xb_add(&bar[XB_XGEN(b.x)], 1u);
            asm volatile("s_waitcnt vmcnt(0)" ::: "memory");
        } else {
            XB_SPIN(xb_ld(&bar[XB_XGEN(b.x)]) == gen, bar);
            __builtin_amdgcn_fence(__ATOMIC_ACQUIRE, "agent");
            asm volatile("s_waitcnt vmcnt(0)" ::: "memory");
        }
    }
    __syncthreads();
}

constexpr int NWAVES = 8, NTHR = 512;
constexpr int RING_BYTES = 131072, LDSCTL_OFF = RING_BYTES, MISC_OFF = LDSCTL_OFF + 320, L_CKVSS = LDSCTL_OFF + 1024  , LDS_BYTES = 147456;
typedef float f32x4 __attribute__((ext_vector_type(4)));

struct Args {
    const float* x; const float* p; const int* pos; const float* norm_mix; const float* w_in; const float* ret_norm; const float* kv_norm;
    const float* w_uk; const float* w_uv; const float* w_out; const float* norm_ple; const float* w_ple_gate; const float* w_ple_proj; const float* norm_final;
    float* out; unsigned char* ws;
};

__device__ __forceinline__ void p0_transpose_item(const float* __restrict__ W, int ldw, h16* __restrict__ WT, int K, int n0, int k0, bool perm, const float* __restrict__ gk,
                                                  LAS float* scr, int lane, bool asbf = false) {
    const int nn = n0 + (lane & 31);
    const int oc = perm ? orig_col(nn) : nn;
    const float sc = perm ? col_scale(nn) : 1.0f;
#pragma unroll 8
    for (int i = 0; i < 32; ++i) {
        const int kk = 2 * i + (lane >> 5);
        float v = (oc >= 0) ? W[(size_t)(k0 + kk) * ldw + oc] * sc : 0.f;
        if (gk) v *= gk[k0 + kk];
        scr[kk * 33 + (lane & 31)] = v;
    }
    asm volatile("s_waitcnt lgkmcnt(0)" ::: "memory");
    const int c = lane & 7;
#pragma unroll
    for (int j = 0; j < 4; ++j) {
        const int n = (lane >> 3) + 8 * j; const LAS float* s = scr + (8 * c) * 33 + n;
        h16x8 o;
#pragma unroll
        for (int e = 0; e < 8; ++e) o[e] = asbf ? __builtin_bit_cast(h16, pg8::f2bf(s[e * 33])) : (h16)s[e * 33];
        *(h16x8*)(WT + (size_t)(n0 + n) * K + k0 + 8 * c) = o;
    }
    asm volatile("s_waitcnt lgkmcnt(0)" ::: "memory");
}
__device__ __forceinline__ void p0_prologue(const Args& a, LAS unsigned char* lds, int G, int bx, int tid, int lane, int wave) {
    unsigned char* ws = a.ws;
    float2* tab = (float2*)(ws + WS_TAB);
    h16* WinT = (h16*)(ws + WS_WIN); h16* WoutT = (h16*)(ws + WS_WOUT); h16* WgT = (h16*)(ws + WS_WG); h16* WpT = (h16*)(ws + WS_WP);
    h16* A0 = (h16*)(ws + WS_A0); h16* P16 = (h16*)(ws + WS_P16);
    const int gw = bx * NWAVES + wave, NGW = G * NWAVES;
    for (int i = bx * NTHR + tid; i < SEQ * NFREQ; i += G * NTHR) {
        const int s = i / NFREQ, f = i % NFREQ; float inv;
        if (f < 32) inv = powf(10000.0f, -(float)(2 * f) / 64.0f);
        else if (f < 40) inv = powf(500000.0f, -(float)(2 * (f - 32)) / 16.0f);
        else inv = powf(500000.0f, -(float)(2 * (f - 40)) / 8.0f);
        const float ang = (float)a.pos[s] * inv;
        tab[i] = make_float2(cosf(ang), sinf(ang));
    }
    LAS float* scr = (LAS float*)(lds + wave * 16384);
    constexpr int I_IN = 16 * (NP / 32), I_O = 16 * 32, I_G = 16 * 32, I_P = 4 * 32;
    for (int it = gw; it < I_IN + I_O + I_G + I_P; it += NGW) {
        int r = it;
        if (r < I_IN) { p0_transpose_item(a.w_in, 3512, WinT, DM, (r % (NP / 32)) * 32, (r / (NP / 32)) * 64, true, nullptr, scr, lane); continue; } r -= I_IN;
        if (r < I_O) { p0_transpose_item(a.w_out, DM, WoutT, DM, (r % 32) * 32, (r / 32) * 64, false, nullptr, scr, lane); continue; } r -= I_O;
        if (r < I_G) { p0_transpose_item(a.w_ple_gate, DM, WgT, DM, (r % 32) * 32, (r / 32) * 64, false, a.norm_ple, scr, lane); continue; } r -= I_G;
        p0_transpose_item(a.w_ple_proj, DM, WpT, PLE, (r % 32) * 32, (r / 32) * 64, false, nullptr, scr, lane);
    }
    {
        h16* WukT = (h16*)(ws + WS_WUK); h16* WuvT = (h16*)(ws + WS_WUV);
        for (int i = bx * NTHR + tid; i < 8 * 128 * 48; i += G * NTHR) { const int hh = i / (128 * 48), r = i % (128 * 48), c = r / 48, j = r % 48; WukT[i] = (h16)a.w_uk[(hh * 48 + j) * 128 + c]; }
        for (int i = bx * NTHR + tid; i < 8 * 64 * 128; i += G * NTHR) { const int hh = i / (64 * 128), r = i % (64 * 128), d = r / 128, c = r % 128; WuvT[i] = (h16)a.w_uv[(hh * 128 + c) * 64 + d]; }
    }
    {
        f32x4 gg[4];
#pragma unroll
        for (int j = 0; j < 4; ++j) gg[j] = ((const f32x4*)a.norm_mix)[lane + 64 * j];
        for (int row0 = 4 * gw; row0 < MTOK; row0 += 4 * NGW) {
            f32x4 v[4][4]; float ss[4];
#pragma unroll
            for (int rr = 0; rr < 4; ++rr) {
                const f32x4* xr = (const f32x4*)(a.x + (size_t)(row0 + rr) * DM);
#pragma unroll
                for (int j = 0; j < 4; ++j) v[rr][j] = xr[lane + 64 * j];
            }
#pragma unroll
            for (int rr = 0; rr < 4; ++rr) {
                float s_ = 0.f;
#pragma unroll
                for (int j = 0; j < 4; ++j) s_ += (v[rr][j][0] * v[rr][j][0] + v[rr][j][1] * v[rr][j][1]) + (v[rr][j][2] * v[rr][j][2] + v[rr][j][3] * v[rr][j][3]);
                ss[rr] = s_;
            }
#pragma unroll
            for (int o = 1; o < 64; o <<= 1) {
#pragma unroll
                for (int rr = 0; rr < 4; ++rr) ss[rr] += __shfl_xor(ss[rr], o);
            }
#pragma unroll
            for (int rr = 0; rr < 4; ++rr) {
                const int row = row0 + rr;
                const float rstd = rsqrtf(ss[rr] * (1.0f / DM) + EPS);
                if (lane == 0) ((float*)(ws + WS_CTL) + 3 * MTOK)[row] = 1.0f / rstd;
#pragma unroll
                for (int j = 0; j < 4; ++j) {
                    h16x4 o; o[0] = (h16)(v[rr][j][0] * rstd * gg[j][0]); o[1] = (h16)(v[rr][j][1] * rstd * gg[j][1]); o[2] = (h16)(v[rr][j][2] * rstd * gg[j][2]); o[3] = (h16)(v[rr][j][3] * rstd * gg[j][3]);
                    *(h16x4*)(A0 + tix(row, (lane + 64 * j) * 4, DM)) = o;
                }
            }
        }
    }
    for (size_t i = (size_t)bx * NTHR + tid; i < (size_t)MTOK * PLE / 4; i += (size_t)4 * G * NTHR) {
        f32x4 v[4];
#pragma unroll
        for (int u2 = 0; u2 < 4; ++u2) v[u2] = ((const f32x4*)a.p)[i + (size_t)u2 * G * NTHR];
#pragma unroll
        for (int u2 = 0; u2 < 4; ++u2) { h16x4 o; o[0] = (h16)v[u2][0]; o[1] = (h16)v[u2][1]; o[2] = (h16)v[u2][2]; o[3] = (h16)v[u2][3]; ((h16x4*)P16)[i + (size_t)u2 * G * NTHR] = o; }
    }
}

__device__ __forceinline__ void fix_ckv(h16* proj, const float* kvn, int G, int bx, int lane, int wave) {
    const int gw = bx * NWAVES + wave, NGW = G * NWAVES;
    int p0 = 2 * lane; { const int g = (p0 >> 2) & 3; if (g == 1) p0 += 4; else if (g == 2) p0 -= 4; }
    const float g0 = kvn[p0], g1 = kvn[p0 + 1];
    for (int row0 = 4 * gw; row0 < MTOK; row0 += 4 * NGW) {
        h16x2 v[4]; float ss[4];
#pragma unroll
        for (int rr = 0; rr < 4; ++rr) v[rr] = *((const h16x2*)(proj + (size_t)(row0 + rr) * NP + C_CKV) + lane);
#pragma unroll
        for (int rr = 0; rr < 4; ++rr) { const float a_ = (float)v[rr][0], b_ = (float)v[rr][1]; ss[rr] = a_ * a_ + b_ * b_; }
#pragma unroll
        for (int o = 1; o < 64; o <<= 1) {
#pragma unroll
            for (int rr = 0; rr < 4; ++rr) ss[rr] += __shfl_xor(ss[rr], o);
        }
#pragma unroll
        for (int rr = 0; rr < 4; ++rr) {
            const float rstd = rsqrtf(ss[rr] * (1.0f / 128.0f) + EPS);
            h16x2 o; o[0] = (h16)((float)v[rr][0] * rstd * g0); o[1] = (h16)((float)v[rr][1] * rstd * g1);
            *((h16x2*)(proj + (size_t)(row0 + rr) * NP + C_CKV) + lane) = o;
        }
    }
}

namespace dsa {
typedef _Float16 f16x8 __attribute__((ext_vector_type(8)));
typedef _Float16 f16x4 __attribute__((ext_vector_type(4)));
typedef float f32x16 __attribute__((ext_vector_type(16)));
typedef float f32x4 __attribute__((ext_vector_type(4)));
typedef short v4i16_t __attribute__((ext_vector_type(4)));
constexpr int L_KT = 0;
constexpr int L_KR = 49152;
constexpr int L_MASK = 55296;
constexpr int L_QI = 63488;
constexpr int L_BIAS = 63488;
#define DSA_WAIT_BAR(N) asm volatile("s_waitcnt vmcnt(" #N ") lgkmcnt(0)\n\ts_barrier" ::: "memory")
constexpr float NEG = -3.0e38f;

__device__ __forceinline__ unsigned off_b(unsigned row, unsigned ch) { return 256u * row + 16u * (ch ^ (((row & 3) << 2) | ((row >> 2) & 3))); }
__device__ __forceinline__ unsigned off_a(unsigned row, unsigned ch) { return 2048u * (row >> 3) + 512u * (ch >> 2) + 64u * (row & 7) + 16u * ((ch & 3) ^ ((row >> 2) & 3)); }
__device__ __forceinline__ float max3f(float a, float b, float c) { float r; asm("v_max3_f32 %0, %1, %2, %3" : "=v"(r) : "v"(a), "v"(b), "v"(c)); return r; }
__device__ __forceinline__ float relu_s(float a) { float r; asm("v_max_f32_e32 %0, 0, %1" : "=v"(r) : "v"(a)); return r; }
#define MFMA_ASM_FENCE(x) asm volatile("s_nop 15\n\ts_nop 7" : "+v"(x))
__device__ __forceinline__ int wave_isum(int v) {
    v += __builtin_amdgcn_update_dpp(0, v, 0xB1, 0xF, 0xF, false);
    v += __builtin_amdgcn_update_dpp(0, v, 0x4E, 0xF, 0xF, false);
    v += __builtin_amdgcn_update_dpp(0, v, 0x141, 0xF, 0xF, false);
    v += __builtin_amdgcn_update_dpp(0, v, 0x140, 0xF, 0xF, false);
    return __builtin_amdgcn_readlane(v, 0) + __builtin_amdgcn_readlane(v, 16) + __builtin_amdgcn_readlane(v, 32) + __builtin_amdgcn_readlane(v, 48);
}
__device__ __forceinline__ f16x4 vtr(const LAS unsigned char* p) { return __builtin_bit_cast(f16x4, __builtin_amdgcn_ds_read_tr16_b64_v4i16((LAS v4i16_t*)p)); }
__device__ __forceinline__ unsigned ord_key(float f) { const unsigned u = __float_as_uint(f); return (u & 0x80000000u) ? ~u : (u | 0x80000000u); }
__device__ __forceinline__ f32x16 mfma32(f16x8 a, f16x8 b, f32x16 c) { return __builtin_amdgcn_mfma_f32_32x32x16_f16(a, b, c, 0, 0, 0); }
__device__ __forceinline__ float xhalf(float v) { return __shfl_xor(v, 32); }

__device__ __forceinline__ void kstage_dma(LAS unsigned char* lds, int buf, const h16* pb, int key0, int lane, int wave) {
    const int row = 8 * (wave >> 1) + ((lane >> 2) & 7);
    const int ch = 4 * (2 * (wave & 1) + (lane >> 5)) + ((lane & 3) ^ ((row >> 2) & 3));
#pragma unroll
    for (int im = 0; im < 2; ++im) {
        const h16* src = pb + (size_t)(key0 + 32 * im + row) * NP + C_CKV + 8 * ch;
        __builtin_amdgcn_global_load_lds((const unsigned*)src, (LAS unsigned*)(lds + L_KT + buf * 16384 + im * 8192 + wave * 1024), 16, 0, 0);
    }
    {
        const int slot = 64 * (wave & 1) + lane;
        const h16* src = pb + (size_t)(key0 + (slot >> 1)) * NP + C_KPE + 8 * (slot & 1);
        __builtin_amdgcn_global_load_lds((const unsigned*)src, (LAS unsigned*)(lds + L_KR + buf * 2048 + (wave & 1) * 1024), 16, 0, 0);
    }
}

__device__ __forceinline__ void dsa_select_unit(LAS unsigned char* lds, int b, int qb, const h16* __restrict__ proj, float* __restrict__ scr, unsigned* __restrict__ maskg,
                                                int tid, int lane, int wave) {
    const int c = qb >> 1, N = 64 * (c + 1);
    const h16* pb = proj + (size_t)b * SEQ * NP;
    const h16* prow = pb + (unsigned)((32 * qb + (lane & 31)) * NP);
    LAS unsigned* maskw = (LAS unsigned*)(lds + L_MASK);
    if (N > 256) {
        const int q = lane & 31, h = lane >> 5;
        for (int i = tid; i < 2048; i += NTHR) maskw[i] = 0u;
        {
            LAS unsigned char* qil = lds + L_QI;
            { const h16* qsrc = pb + (unsigned)(32 * qb * NP + C_IQ);
#pragma unroll
              for (int i2 = 0; i2 < 2; ++i2) { const int id = tid + NTHR * i2, row = id >> 5, ch = id & 31;
                  *(LAS f16x8*)(qil + row * 528 + ch * 16) = *(const f16x8*)(qsrc + (unsigned)(row * NP + 8 * ch)); } }
            float wq[8];
            { const f16x8 w8 = *(const f16x8*)(prow + C_IW);
#pragma unroll
              for (int hh = 0; hh < 8; ++hh) wq[hh] = (float)w8[hh]; }
            __syncthreads();
            const LAS unsigned char* qfr = qil + q * 528 + 16 * h;
            const unsigned koff = (unsigned)(q * NP + C_KI + 8 * h);
            int kt = wave;
            f16x8 ka0, ka1;
            if (kt < N / 32) { ka0 = *(const f16x8*)(pb + (koff + (unsigned)(32 * kt * NP))); ka1 = *(const f16x8*)(pb + (koff + (unsigned)(32 * kt * NP + 16))); }
            for (; kt < N / 32; kt += 8) {
                const f16x8 a0 = ka0, a1 = ka1;
                if (kt + 8 < N / 32) { ka0 = *(const f16x8*)(pb + (koff + (unsigned)(32 * (kt + 8) * NP))); ka1 = *(const f16x8*)(pb + (koff + (unsigned)(32 * (kt + 8) * NP + 16))); }
                f32x16 sc;
#pragma unroll
                for (int r = 0; r < 16; ++r) sc[r] = 0.f;
#pragma unroll
                for (int hh = 0; hh < 8; ++hh) {
                    const f16x8 q0 = *(const LAS f16x8*)(qfr + 64 * hh), q1 = *(const LAS f16x8*)(qfr + 64 * hh + 32);
                    f32x16 x;
#pragma unroll
                    for (int r = 0; r < 16; ++r) x[r] = 0.f;
                    x = mfma32(a0, q0, x); x = mfma32(a1, q1, x);
                    MFMA_ASM_FENCE(x);
#pragma unroll
                    for (int r = 0; r < 16; ++r) sc[r] += wq[hh] * relu_s(x[r]);
                    if (hh & 1) __builtin_amdgcn_sched_barrier(0);
                }
#pragma unroll
                for (int r4 = 0; r4 < 4; ++r4) {
                    const int kg = 8 * kt + 2 * r4 + h;
                    *(f32x4*)(scr + (unsigned)((kg * 32 + q) * 4)) = (f32x4){sc[4 * r4], sc[4 * r4 + 1], sc[4 * r4 + 2], sc[4 * r4 + 3]};
                }
            }
        }
        __syncthreads();
        const int NG = N >> 2;
        const int nip = (NG + 63) >> 6;
        for (int i = 0; i < 4; ++i) {
            const int qq = 4 * wave + i;
            unsigned kk[32];
#pragma unroll
            for (int ip = 0; ip < 8; ++ip) {
                const int kg = lane + 64 * ip;
                f32x4 v = (f32x4){0.f, 0.f, 0.f, 0.f};
                const bool ok = kg < NG;
                if (ok) v = *(const f32x4*)(scr + (unsigned)((kg * 32 + qq) * 4));
#pragma unroll
                for (int e = 0; e < 4; ++e) kk[4 * ip + e] = ok ? ord_key(v[e]) : 0u;
            }
            unsigned T = 0u; bool exact = false;
            for (int bit = 31; bit >= 0; --bit) {
                const unsigned cand = T | (1u << bit);
                int lc0 = 0, lc1 = 0, lc2 = 0, lc3 = 0;
#pragma unroll
                for (int r0 = 0; r0 < 32; r0 += 4) {
                    if (r0 < 4 * nip) {
                        unsigned long long t0_, t1_, t2_, t3_;
                        asm volatile("v_cmp_le_u32_e64 %4, %12, %8\n\tv_cmp_le_u32_e64 %5, %12, %9\n\tv_cmp_le_u32_e64 %6, %12, %10\n\tv_cmp_le_u32_e64 %7, %12, %11\n\t"
                                     "v_addc_co_u32_e64 %0, %4, 0, %0, %4\n\tv_addc_co_u32_e64 %1, %5, 0, %1, %5\n\tv_addc_co_u32_e64 %2, %6, 0, %2, %6\n\tv_addc_co_u32_e64 %3, %7, 0, %3, %7"
                                     : "+v"(lc0), "+v"(lc1), "+v"(lc2), "+v"(lc3), "=&s"(t0_), "=&s"(t1_), "=&s"(t2_), "=&s"(t3_)
                                     : "v"(kk[r0]), "v"(kk[r0 + 1]), "v"(kk[r0 + 2]), "v"(kk[r0 + 3]), "s"(cand));
                    }
                }
                const int lc = (lc0 + lc1) + (lc2 + lc3);
                const int cnt = wave_isum(lc);
                if (cnt >= 256) T = cand;
                if (cnt == 256) { exact = true; break; }
            }
            asm volatile("" : "+v"(T));
            unsigned selbits = 0u;
            if (exact) {
#pragma unroll
                for (int r0 = 0; r0 < 32; r0 += 4) {
#pragma unroll
                    for (int r = r0; r < r0 + 4; ++r) selbits |= (kk[r] >= T) ? (1u << r) : 0u;
                    __builtin_amdgcn_sched_barrier(0);
                }
            } else {
                int lg = 0;
#pragma unroll
                for (int r = 0; r < 32; ++r) lg += (kk[r] > T) ? 1 : 0;
                const int ngt = wave_isum(lg);
                const int need = 256 - ngt;
                const int lane4 = 4 * lane;
                int J = 0;
                for (int bit = 10; bit >= 0; --bit) {
                    const int cj = J | (1 << bit);
                    unsigned Tv = T; asm volatile("" : "+v"(Tv));
                    int lcj = 0;
#pragma unroll
                    for (int r = 0; r < 32; ++r) lcj += (kk[r] == Tv && lane4 < cj - (256 * (r >> 2) + (r & 3))) ? 1 : 0;
                    const int cnt = wave_isum(lcj);
                    if (cnt < need) J = cj;
                }
#pragma unroll
                for (int r0 = 0; r0 < 32; r0 += 2) {
#pragma unroll
                    for (int r = r0; r < r0 + 2; ++r) selbits |= (kk[r] > T || (kk[r] == T && lane4 <= J - (256 * (r >> 2) + (r & 3)))) ? (1u << r) : 0u;
                    __builtin_amdgcn_sched_barrier(0);
                }
            }
#pragma unroll
            for (int ip = 0; ip < 8; ++ip) {
                const int kg = lane + 64 * ip;
                if (kg < NG) {
                    const unsigned nib = (selbits >> (4 * ip)) & 15u;
                    const int tile = (lane >> 4) + 4 * ip;
                    __hip_atomic_fetch_or(maskw + ((qq * 32 + tile) * 2 + ((lane & 15) >> 3)), nib << (4 * (lane & 7)), __ATOMIC_RELAXED, __HIP_MEMORY_SCOPE_WORKGROUP);
                }
            }
        }
    } else {
        for (int i = tid; i < 2048; i += NTHR) maskw[i] = 0xffffffffu;
    }

    __syncthreads();
    { unsigned* dst = maskg + ((size_t)b * SEQ + 32 * qb) * 64;
      for (int i = tid; i < 2048; i += NTHR) dst[i] = maskw[i]; }
    __syncthreads();
}

__device__ __forceinline__ void bias_tile(LAS unsigned char* lds, int bbuf, const LAS unsigned* maskw, bool allsel, int T, int lane, int wave) {
    const int q = lane & 31, h = lane >> 5, blk = wave >> 2, r4 = wave & 3;
    const unsigned mw = allsel ? 0xffffffffu : maskw[(q * 32 + T) * 2 + blk];
    const unsigned nib = ~(mw >> (8 * r4 + 4 * h));
    f32x4 bv;
#pragma unroll
    for (int e = 0; e < 4; ++e) bv[e] = __uint_as_float((unsigned)__builtin_amdgcn_sbfe((int)nib, e, 1) & 0xff61b1e6u);
    *(LAS f32x4*)(lds + L_BIAS + bbuf * 8192 + ((blk * 4 + r4) * 64 + lane) * 16) = bv;
}

__device__ __forceinline__ void dsa_attn_unit(LAS unsigned char* lds, int b, int qb, const h16* __restrict__ proj, const unsigned* __restrict__ maskg,
                                              const h16* __restrict__ WukT, const h16* __restrict__ WuvT, h16* __restrict__ mix, int tid, int lane, int wave, float* dbg) {
    const int c = qb >> 1;
    const h16* pb = proj + (size_t)b * SEQ * NP;
    const size_t m = (size_t)b * SEQ + 32 * qb + (lane & 31);
    const h16* prow = proj + m * NP;
    kstage_dma(lds, 0, pb, 0, lane, wave);
    if (c >= 1) kstage_dma(lds, 1, pb, 64, lane, wave);
    LAS unsigned* maskw = (LAS unsigned*)(lds + L_MASK);
    if (c >= 4) { const unsigned* src = maskg + ((size_t)b * SEQ + 32 * qb) * 64; for (int i = tid; i < 2048; i += NTHR) maskw[i] = src[i]; }
    __syncthreads();
    bias_tile(lds, 0, maskw, c < 4, 0, lane, wave);
    const int q = lane & 31, h = lane >> 5;
    const int hd = wave;
    f16x8 qbf[8]; f16x8 qpe;
    {
        f16x8 qn[3];
#pragma unroll
        for (int s = 0; s < 3; ++s) qn[s] = *(const f16x8*)(prow + C_QN + 48 * hd + 16 * s + 8 * h);
        qpe = *(const f16x8*)(prow + C_QPE + 16 * hd + 8 * h);
#pragma unroll
        for (int ct = 0; ct < 4; ++ct) {
            f32x16 acc;
#pragma unroll
            for (int r = 0; r < 16; ++r) acc[r] = 0.f;
#pragma unroll
            for (int s = 0; s < 3; ++s) {
                const f16x8 wa = *(const f16x8*)(WukT + (size_t)(hd * 128 + 32 * ct + q) * 48 + 16 * s + 8 * h);
                acc = mfma32(wa, qn[s], acc);
            }
#pragma unroll
            for (int k2 = 0; k2 < 2; ++k2) {
                f16x8 t;
#pragma unroll
                for (int j = 0; j < 8; ++j) t[j] = (_Float16)acc[8 * k2 + j];
                qbf[2 * ct + k2] = t;
            }
        }
    }
    f32x16 O[4];
#pragma unroll
    for (int ct = 0; ct < 4; ++ct)
#pragma unroll
        for (int r = 0; r < 16; ++r) O[ct][r] = 0.f;
    float mrun = -1.0e30f, lrun = 0.f;
#ifdef PROBE_ATTSEG
    unsigned long long segacc = 0;
#endif
    const int qq4 = (lane & 15) >> 2, p4 = lane & 3, b16 = (lane >> 4) & 1;
    const unsigned rbase0 = off_a(q, h), rbase1 = off_a(q, 2 + h);
    const unsigned tbase0 = off_a(4 * h + qq4, 2 * b16 + (p4 >> 1)) + 8 * (p4 & 1), tbase1 = off_a(8 + 4 * h + qq4, 2 * b16 + (p4 >> 1)) + 8 * (p4 & 1);

    __syncthreads();
#ifdef PROBE_ATTLOOP
    const unsigned long long tl0 = __builtin_amdgcn_s_memtime();
#endif
    int buf = 0;
    for (int t = 0; t <= c; ++t) {
        const int bufn = (buf >= 1) ? buf - 1 : 2;
        if (t + 2 <= c) kstage_dma(lds, bufn, pb, 64 * (t + 2), lane, wave);
        if (t + 1 <= c) bias_tile(lds, (t + 1) & 1, maskw, c < 4, t + 1, lane, wave);
        const LAS unsigned char* kt0 = lds + L_KT + buf * 16384;
        const LAS unsigned char* kr0 = lds + L_KR + buf * 2048;
        {
            const LAS unsigned char* img0 = kt0; const LAS unsigned char* img1 = kt0 + 8192;
            f32x16 S0, S1;
            {
                const LAS unsigned char* bp = lds + L_BIAS + (t & 1) * 8192 + lane * 16;
#pragma unroll
                for (int r4 = 0; r4 < 4; ++r4) { const f32x4 b0 = *(const LAS f32x4*)(bp + r4 * 1024), b1 = *(const LAS f32x4*)(bp + 4096 + r4 * 1024);
#pragma unroll
                    for (int e = 0; e < 4; ++e) { S0[4 * r4 + e] = b0[e]; S1[4 * r4 + e] = b1[e]; } }
            }
            f16x8 ka[8]; f16x8 kr;
#define ATT_KLOAD(img, blk) do { _Pragma("unroll") for (int ks = 0; ks < 8; ++ks) ka[ks] = *(const LAS f16x8*)((img) + ((ks & 1) ? rbase1 : rbase0) + 512 * (ks >> 1)); \
                                 kr = *(const LAS f16x8*)(kr0 + (32 * (blk) + q) * 32 + 16 * h); } while (0)
#define ATT_SM(c, S, pk, alpha, mnew, ps) do { \
            if ((c) == 0) { mnew = max3f(S[0], S[1], S[2]); mnew = max3f(mnew, S[3], S[4]); mnew = max3f(mnew, S[5], S[6]); mnew = max3f(mnew, S[7], S[8]); } \
            if ((c) == 1) { mnew = max3f(mnew, S[9], S[10]); mnew = max3f(mnew, S[11], S[12]); mnew = max3f(mnew, S[13], S[14]); mnew = max3f(mnew, S[15], S[15]); } \
            if ((c) == 2) { const float mo_ = xhalf(mnew); mnew = max3f(mnew, mo_, mo_); mnew = max3f(mrun, mnew, mnew); alpha = __builtin_amdgcn_exp2f(mrun - mnew); mrun = mnew; ps = 0.f; } \
            if ((c) >= 3 && (c) <= 6) { _Pragma("unroll") for (int r_ = 4 * ((c) - 3); r_ < 4 * ((c) - 3) + 4; ++r_) { const float e_ = __builtin_amdgcn_exp2f(S[r_] - mnew); S[r_] = e_; ps += e_; } } \
            if ((c) == 7) { _Pragma("unroll") for (int j_ = 0; j_ < 8; ++j_) pk[0][j_] = (_Float16)S[j_]; } \
            if ((c) == 8) { _Pragma("unroll") for (int j_ = 0; j_ < 8; ++j_) pk[1][j_] = (_Float16)S[8 + j_]; lrun = lrun * alpha + ps; } \
        } while (0)
            ATT_KLOAD(img0, 0);
#pragma unroll
            for (int ks = 0; ks < 8; ++ks) S0 = mfma32(ka[ks], qbf[ks], S0);
            S0 = mfma32(kr, qpe, S0);
            ATT_KLOAD(img1, 1);
            MFMA_ASM_FENCE(S0);
            f16x8 pk0[2], pk1[2]; float alpha0 = 1.f, alpha1 = 1.f, mn0 = 0.f, mn1 = 0.f, ps0 = 0.f, ps1 = 0.f;
            __builtin_amdgcn_sched_barrier(0);
#pragma unroll
            for (int ks = 0; ks < 9; ++ks) {
                if (ks < 8) S1 = mfma32(ka[ks], qbf[ks], S1); else S1 = mfma32(kr, qpe, S1);
                ATT_SM(ks, S0, pk0, alpha0, mn0, ps0);
                __builtin_amdgcn_sched_barrier(0);
            }
            if (__any(alpha0 != 1.0f)) {
#pragma unroll
                for (int ct = 0; ct < 4; ++ct)
#pragma unroll
                    for (int r = 0; r < 16; ++r) O[ct][r] *= alpha0;
            }
            f16x4 va0[8], va1[8];
#define ATT_VLOAD(img) do { _Pragma("unroll") for (int i2 = 0; i2 < 8; ++i2) { va0[i2] = vtr((img) + tbase0 + 4096 * (i2 >> 2) + 512 * (i2 & 3)); va1[i2] = vtr((img) + tbase1 + 4096 * (i2 >> 2) + 512 * (i2 & 3)); } } while (0)
#define ATT_VFRAG(i2) (f16x8){va0[i2][0], va0[i2][1], va0[i2][2], va0[i2][3], va1[i2][0], va1[i2][1], va1[i2][2], va1[i2][3]}
            ATT_VLOAD(img0);
            MFMA_ASM_FENCE(S1);
            __builtin_amdgcn_sched_barrier(0);
#pragma unroll
            for (int i2 = 0; i2 < 8; ++i2) {
                O[i2 & 3] = mfma32(ATT_VFRAG(i2), pk0[i2 >> 2], O[i2 & 3]);
                ATT_SM(i2, S1, pk1, alpha1, mn1, ps1);
                if (i2 == 7) ATT_SM(8, S1, pk1, alpha1, mn1, ps1);
                __builtin_amdgcn_sched_barrier(0);
            }
            if (__any(alpha1 != 1.0f)) {
#pragma unroll
                for (int ct = 0; ct < 4; ++ct)
#pragma unroll
                    for (int r = 0; r < 16; ++r) O[ct][r] *= alpha1;
            }
            ATT_VLOAD(img1);
#pragma unroll
            for (int i2 = 0; i2 < 8; ++i2) O[i2 & 3] = mfma32(ATT_VFRAG(i2), pk1[i2 >> 2], O[i2 & 3]);
#undef ATT_KLOAD
#undef ATT_SM
#undef ATT_VLOAD
#undef ATT_VFRAG
        }
#ifdef PROBE_ATTWAIT
        const unsigned long long tw0 = __builtin_amdgcn_s_memtime();
#endif
        if (t + 2 <= c) DSA_WAIT_BAR(3); else DSA_WAIT_BAR(0);
#ifdef PROBE_ATTWAIT
        if (blockIdx.x == 0 && wave == PROBE_ATTWAIT - 1 && lane == 0) dbg[2] += (float)(__builtin_amdgcn_s_memtime() - tw0);
#endif
        buf = (buf == 2) ? 0 : buf + 1;
    }
#ifdef PROBE_ATTLOOP
    if (blockIdx.x == 0 && wave == 0 && lane == 0) { dbg[1] += (float)(__builtin_amdgcn_s_memtime() - tl0); }
#endif
#ifdef PROBE_ATTSEG
    if (blockIdx.x == 0 && wave == 0 && lane == 0) { dbg[1] += (float)segacc; }
#endif
    {
        const float ltot = lrun + xhalf(lrun);
        const float inv = 1.0f / ltot;
        f16x8 ob[8];
#pragma unroll
        for (int ks = 0; ks < 8; ++ks)
#pragma unroll
            for (int j = 0; j < 8; ++j) ob[ks][j] = (_Float16)(O[ks >> 1][8 * (ks & 1) + j] * inv);
#pragma unroll
        for (int dt = 0; dt < 2; ++dt) {
            f32x16 acc;
#pragma unroll
            for (int r = 0; r < 16; ++r) acc[r] = 0.f;
#pragma unroll
            for (int ks = 0; ks < 8; ++ks) {
                const f16x8 wa = *(const f16x8*)(WuvT + (size_t)(hd * 64 + 32 * dt + q) * 128 + 16 * ks + 8 * h);
                acc = mfma32(wa, ob[ks], acc);
            }
#pragma unroll
            for (int r4 = 0; r4 < 4; ++r4) {
                const int d0 = 32 * dt + 8 * r4 + 4 * h;
                const f16x4 g4 = *(const f16x4*)(prow + C_DG + 64 * hd + d0);
                f16x4 o4;
#pragma unroll
                for (int e = 0; e < 4; ++e) o4[e] = (_Float16)(acc[4 * r4 + e] * (float)g4[e]);
                *(f16x4*)(mix + m * DM + 512 + 64 * hd + d0) = o4;
            }
        }
    }
}
}
namespace ret {
using dsa::f16x8; using dsa::f16x4; using dsa::f32x16; using dsa::off_b; using dsa::vtr; using dsa::mfma32; using dsa::xhalf;
constexpr int L_KV = 0;
constexpr int L_ST = 65536;
__device__ __forceinline__ void kv_dma(LAS unsigned char* lds, int boff, const h16* pb, int hd, int key0, int lane, int wave) {
    const int row = 4 * wave + (lane >> 4), chp = lane & 15;
    const int ch = chp ^ (((row & 3) << 2) | ((row >> 2) & 3));
    const int col = (ch < 8 ? C_RK + 8 * ch : C_RV + 8 * (ch - 8)) + 64 * hd;
#pragma unroll
    for (int im = 0; im < 2; ++im) {
        const h16* src = pb + (size_t)(key0 + 32 * im + row) * NP + col;
        __builtin_amdgcn_global_load_lds((const unsigned*)src, (LAS unsigned*)(lds + L_KV + boff + im * 8192 + wave * 1024), 16, 0, 0);
#ifdef PROBE_H4
        __builtin_amdgcn_global_load_lds((const unsigned*)src, (LAS unsigned*)(lds + L_KV + boff + im * 8192 + wave * 1024), 16, 0, 0);
#endif
    }
}
__device__ __forceinline__ void retention_unit(LAS unsigned char* lds, int b, int hd, const h16* __restrict__ proj, const float* __restrict__ ret_norm, h16* __restrict__ mix,
                                               int lane, int wave, float* dbg) {
    const int q = lane & 31, h = lane >> 5;
    const h16* pb = proj + (size_t)b * SEQ * NP;
#if defined(PROBE_RETWAIT) || defined(PROBE_RETFAST) || defined(PROBE_RETSEG)
    unsigned long long t_wait = 0, t_begin = __builtin_amdgcn_s_memtime();
#endif
    const float lg2 = log2f(1.0f - exp2f(-5.0f - (float)hd));
    const float g32 = exp2f(lg2 * 32.0f);
    float cf[16];
#pragma unroll
    for (int r = 0; r < 16; ++r) cf[r] = exp2f(lg2 * (float)(31 - 4 * h - ((r & 3) + 8 * (r >> 2))));
    const int qq4 = (lane & 15) >> 2, p4 = lane & 3, b16 = (lane >> 4) & 1;
    const int n = 32 * (wave & 1) + q;
    const float xi = exp2f(lg2 * (float)(n + 1));
    for (int g = 0; g < 8; ++g) {
        const int cq = 4 * g + (wave >> 1);
#if defined(PROBE_RETSEG)
        unsigned long long ts0 = __builtin_amdgcn_s_memtime();
#endif
        kv_dma(lds, 0, pb, hd, 0, lane, wave); kv_dma(lds, 16384, pb, hd, 64, lane, wave);
        LAS unsigned char* stg = lds + L_ST + wave * 4608;
        const unsigned grow0 = (unsigned)((256 * g + 32 * wave) * NP);
        const int srow = lane >> 3, sch = lane & 7;
#pragma unroll
        for (int i2 = 0; i2 < 4; ++i2)
            *(LAS f16x8*)(stg + (8 * i2 + srow) * 144 + 16 * sch) = *(const f16x8*)(pb + (grow0 + (unsigned)((8 * i2 + srow) * NP + C_RQ + 64 * hd + 8 * sch)));
        asm volatile("s_waitcnt lgkmcnt(0)" ::: "memory");
        f16x8 qf[4];
#pragma unroll
        for (int ks = 0; ks < 4; ++ks) qf[ks] = *(const LAS f16x8*)(stg + q * 144 + 32 * ks + 16 * h);
        asm volatile("" ::: "memory");
        f32x16 O[2];
#pragma unroll
        for (int dt = 0; dt < 2; ++dt)
#pragma unroll
            for (int r = 0; r < 16; ++r) O[dt][r] = 0.f;
        __syncthreads();
#if defined(PROBE_RETSEG)
        if (PROBE_RETSEG == 1) t_wait += __builtin_amdgcn_s_memtime() - ts0;
#endif
        const int nt = 4 * g + 4;
        int slot = 0;
        for (int kp = 0; kp < nt / 2; ++kp) {
            const int slotn = slot ^ 1;
            if (2 * kp + 2 < nt) { kv_dma(lds, slotn * 32768, pb, hd, 64 * (2 * kp + 2), lane, wave); kv_dma(lds, slotn * 32768 + 16384, pb, hd, 64 * (2 * kp + 3), lane, wave); }
#pragma unroll 1
            for (int sub = 0; sub < 2; ++sub) {
            const int kt = 2 * kp + sub;
            const LAS unsigned char* img0 = lds + L_KV + slot * 32768 + sub * 16384;
#ifdef PROBE_RETFAST
            const unsigned long long tf0 = __builtin_amdgcn_s_memtime();
#endif
            if (kt < cq) {
                const float tsc = xi * __builtin_amdgcn_exp2f(lg2 * 64.0f * (float)(cq - kt - 1));
                f32x16 S[2];
#pragma unroll
                for (int blk = 0; blk < 2; ++blk) {
#pragma unroll
                    for (int r2 = 0; r2 < 16; ++r2) S[blk][r2] = 0.f;
#pragma unroll
                    for (int ks = 0; ks < 4; ++ks) {
                        const f16x8 ka = *(const LAS f16x8*)(img0 + blk * 8192 + off_b(q, 2 * ks + h));
#ifdef PROBE_H1
                        { const f16x8 kd = *(const LAS f16x8*)(img0 + (blk ^ 1) * 8192 + off_b(q, 2 * ks + h)); asm volatile("" :: "v"(kd)); }
#endif
                        S[blk] = mfma32(ka, qf[ks], S[blk]);
                    }
                }
#pragma unroll
                for (int blk = 0; blk < 2; ++blk) {
                    const float f = tsc * (blk ? 1.0f : g32);
                    f16x8 pk[2];
#pragma unroll
                    for (int s2 = 0; s2 < 2; ++s2)
#pragma unroll
                        for (int j2 = 0; j2 < 8; ++j2) pk[s2][j2] = (_Float16)(S[blk][8 * s2 + j2] * (cf[8 * s2 + j2] * f));
#pragma unroll
                    for (int s2 = 0; s2 < 2; ++s2)
#pragma unroll
                        for (int dt = 0; dt < 2; ++dt) {
                            const int ct = 2 + dt;
                            const LAS unsigned char* img = img0 + blk * 8192;
                            const f16x4 v0 = vtr(img + off_b(16 * s2 + 4 * h + qq4, 4 * ct + 2 * b16 + (p4 >> 1)) + 8 * (p4 & 1));
                            const f16x4 v1 = vtr(img + off_b(16 * s2 + 8 + 4 * h + qq4, 4 * ct + 2 * b16 + (p4 >> 1)) + 8 * (p4 & 1));
                            const f16x8 va = (f16x8){v0[0], v0[1], v0[2], v0[3], v1[0], v1[1], v1[2], v1[3]};
#ifdef PROBE_H1
                            { const f16x4 d0 = vtr(img0 + (blk ^ 1) * 8192 + off_b(16 * s2 + 4 * h + qq4, 4 * ct + 2 * b16 + (p4 >> 1)) + 8 * (p4 & 1));
                              const f16x4 d1 = vtr(img0 + (blk ^ 1) * 8192 + off_b(16 * s2 + 8 + 4 * h + qq4, 4 * ct + 2 * b16 + (p4 >> 1)) + 8 * (p4 & 1)); asm volatile("" :: "v"(d0), "v"(d1)); }
#endif
#ifdef PROBE_H2
                            { f32x16 dmy = O[dt]; dmy = mfma32(va, pk[s2], dmy); asm volatile("" :: "v"(dmy)); }
#endif
                            O[dt] = mfma32(va, pk[s2], O[dt]);
                        }
                }
#ifdef PROBE_RETFAST
                asm volatile("s_nop 0" ::: "memory"); t_wait += __builtin_amdgcn_s_memtime() - tf0;
#endif
            } else if (kt == cq) {
#if defined(PROBE_RETSEG)
                ts0 = __builtin_amdgcn_s_memtime();
#endif
#pragma unroll 1
                for (int blk = 0; blk < 2; ++blk) {
                    const LAS unsigned char* img = img0 + blk * 8192;
                    f32x16 S;
#pragma unroll
                    for (int r2 = 0; r2 < 16; ++r2) S[r2] = 0.f;
#pragma unroll
                    for (int ks = 0; ks < 4; ++ks) {
                        const f16x8 ka = *(const LAS f16x8*)(img + off_b(q, 2 * ks + h));
                        S = mfma32(ka, qf[ks], S);
                    }
#pragma unroll
                    for (int r2 = 0; r2 < 16; ++r2) {
                        const int mk = 32 * blk + 4 * h + (r2 & 3) + 8 * (r2 >> 2);
                        S[r2] *= __builtin_amdgcn_exp2f(lg2 * fabsf((float)(n - mk)));
                    }
                    f16x8 pk[2];
#pragma unroll
                    for (int s2 = 0; s2 < 2; ++s2)
#pragma unroll
                        for (int j2 = 0; j2 < 8; ++j2) pk[s2][j2] = (_Float16)S[8 * s2 + j2];
#pragma unroll
                    for (int s2 = 0; s2 < 2; ++s2)
#pragma unroll
                        for (int dt = 0; dt < 2; ++dt) {
                            const int ct = 2 + dt;
                            const f16x4 v0 = vtr(img + off_b(16 * s2 + 4 * h + qq4, 4 * ct + 2 * b16 + (p4 >> 1)) + 8 * (p4 & 1));
                            const f16x4 v1 = vtr(img + off_b(16 * s2 + 8 + 4 * h + qq4, 4 * ct + 2 * b16 + (p4 >> 1)) + 8 * (p4 & 1));
                            const f16x8 va = (f16x8){v0[0], v0[1], v0[2], v0[3], v1[0], v1[1], v1[2], v1[3]};
                            O[dt] = mfma32(va, pk[s2], O[dt]);
                        }
                }
            }
#if defined(PROBE_RETSEG)
                if (PROBE_RETSEG == 2 && kt == cq) t_wait += __builtin_amdgcn_s_memtime() - ts0;
#endif
            }
            DSA_WAIT_BAR(0);
            slot ^= 1;
        }
#if defined(PROBE_RETSEG)
        ts0 = __builtin_amdgcn_s_memtime();
#endif
        float s1 = 0.f;
#pragma unroll
        for (int dt = 0; dt < 2; ++dt)
#pragma unroll
            for (int r = 0; r < 16; ++r) s1 += O[dt][r];
        s1 += xhalf(s1);
        const float mu = s1 * (1.0f / 64.0f);
        float s2v = 0.f;
#pragma unroll
        for (int dt = 0; dt < 2; ++dt)
#pragma unroll
            for (int r = 0; r < 16; ++r) { const float d = O[dt][r] - mu; s2v += d * d; }
        s2v += xhalf(s2v);
        const float rstd = rsqrtf(s2v * (1.0f / 64.0f) + EPS);
#pragma unroll
        for (int dt = 0; dt < 2; ++dt)
#pragma unroll
            for (int r4 = 0; r4 < 4; ++r4) {
                const int d0 = 32 * dt + 8 * r4 + 4 * h;
                f16x4 o4;
#pragma unroll
                for (int e = 0; e < 4; ++e) o4[e] = (_Float16)((O[dt][4 * r4 + e] - mu) * rstd);
                *(LAS f16x4*)(stg + q * 144 + 2 * d0) = o4;
            }
        asm volatile("s_waitcnt lgkmcnt(0)" ::: "memory");
        {
            const dsa::f32x4 rn0 = *(const dsa::f32x4*)(ret_norm + 64 * hd + 8 * sch), rn1 = *(const dsa::f32x4*)(ret_norm + 64 * hd + 8 * sch + 4);
#pragma unroll
            for (int i2 = 0; i2 < 4; ++i2) {
                const int row = 8 * i2 + srow;
                const f16x8 y = *(const LAS f16x8*)(stg + row * 144 + 16 * sch);
                const f16x8 gt = *(const f16x8*)(pb + (grow0 + (unsigned)(row * NP + C_RG + 64 * hd + 8 * sch)));
                f16x8 o8;
#pragma unroll
                for (int e = 0; e < 4; ++e) { o8[e] = (_Float16)((float)y[e] * rn0[e] * (float)gt[e]); o8[4 + e] = (_Float16)((float)y[4 + e] * rn1[e] * (float)gt[4 + e]); }
                *(f16x8*)(mix + ((size_t)b * SEQ + 256 * g + 32 * wave + row) * DM + 64 * hd + 8 * sch) = o8;
            }
        }
        asm volatile("s_waitcnt lgkmcnt(0)" ::: "memory");
#if defined(PROBE_RETSEG)
        if (PROBE_RETSEG == 3) { asm volatile("s_waitcnt vmcnt(0)" ::: "memory"); t_wait += __builtin_amdgcn_s_memtime() - ts0; }
#endif
    }
#if defined(PROBE_RETWAIT) || defined(PROBE_RETFAST) || defined(PROBE_RETSEG)
    if (blockIdx.x == 0 && wave == 7 && lane == 0) dbg[0] = 50.0f * (float)t_wait / (float)(__builtin_amdgcn_s_memtime() - t_begin);
#endif
}
}
namespace ret2 {
using dsa::f16x8; using dsa::f16x4; using dsa::f32x16; using dsa::off_b; using dsa::vtr; using dsa::mfma32; using dsa::xhalf;
using ret::L_KV; using ret::L_ST; using dsa::off_a;
__device__ __forceinline__ void kv_dma(LAS unsigned char* lds, int boff, const h16* pb, int hd, int key0, int lane, int wave) {
    const int row = 8 * (wave >> 1) + ((lane >> 2) & 7);
    const int ch = 4 * (2 * (wave & 1) + (lane >> 5)) + ((lane & 3) ^ ((row >> 2) & 3));
    const int col = (ch < 8 ? C_RK + 8 * ch : C_RV + 8 * (ch - 8)) + 64 * hd;
#pragma unroll
    for (int im = 0; im < 2; ++im) {
        const h16* src = pb + (size_t)(key0 + 32 * im + row) * NP + col;
        __builtin_amdgcn_global_load_lds((const unsigned*)src, (LAS unsigned*)(lds + L_KV + boff + im * 8192 + wave * 1024), 16, 0, 0);
    }
}
__device__ __forceinline__ void retention_unit(LAS unsigned char* lds, int b, int hd, const h16* __restrict__ proj, const float* __restrict__ ret_norm, h16* __restrict__ mix,
                                               int lane, int wave, int g0 = 0, int g1 = 4) {
    const int q = lane & 31, h = lane >> 5;
    const h16* pb = proj + (size_t)b * SEQ * NP;
    const float lg2 = log2f(1.0f - exp2f(-5.0f - (float)hd));
    const float g32 = exp2f(lg2 * 32.0f);
    float cf[16];
#pragma unroll
    for (int r = 0; r < 16; ++r) cf[r] = exp2f(lg2 * (float)(31 - 4 * h - ((r & 3) + 8 * (r >> 2))));
    const int qq4 = (lane & 15) >> 2, p4 = lane & 3, b16 = (lane >> 4) & 1;
    const unsigned rbase0 = off_a(q, h), rbase1 = off_a(q, 2 + h);
    const unsigned tbase0 = off_a(4 * h + qq4, 2 * b16 + (p4 >> 1)) + 8 * (p4 & 1), tbase1 = off_a(8 + 4 * h + qq4, 2 * b16 + (p4 >> 1)) + 8 * (p4 & 1);
    const float xiA = exp2f(lg2 * (float)(q + 1));
    LAS unsigned char* stg = lds + L_ST + wave * 4608;
    const int srow = lane >> 3, sch = lane & 7;
    for (int g = g0; g < g1; ++g) {
        const int cq = 8 * g + wave;
        kv_dma(lds, 0, pb, hd, 0, lane, wave); kv_dma(lds, 16384, pb, hd, 64, lane, wave);
        const unsigned grow0 = (unsigned)((64 * cq) * NP);
        f16x8 qf[2][4];
#pragma unroll
        for (int X = 0; X < 2; ++X) {
#pragma unroll
            for (int i2 = 0; i2 < 4; ++i2)
                *(LAS f16x8*)(stg + (8 * i2 + srow) * 144 + 16 * sch) = *(const f16x8*)(pb + (grow0 + (unsigned)((32 * X + 8 * i2 + srow) * NP + C_RQ + 64 * hd + 8 * sch)));
            asm volatile("s_waitcnt lgkmcnt(0)" ::: "memory");
#pragma unroll
            for (int ks = 0; ks < 4; ++ks) qf[X][ks] = *(const LAS f16x8*)(stg + q * 144 + 32 * ks + 16 * h);
            asm volatile("s_waitcnt lgkmcnt(0)" ::: "memory");
            __builtin_amdgcn_sched_barrier(0);
        }
        f32x16 O[2][2];
#pragma unroll
        for (int X = 0; X < 2; ++X)
#pragma unroll
            for (int dt = 0; dt < 2; ++dt)
#pragma unroll
                for (int r = 0; r < 16; ++r) O[X][dt][r] = 0.f;
        __syncthreads();
        const int nt = 8 * g + 8;
        int slot = 0;
        for (int kp = 0; kp < nt / 2; ++kp) {
            const int slotn = slot ^ 1;
            if (2 * kp + 2 < nt) { kv_dma(lds, slotn * 32768, pb, hd, 64 * (2 * kp + 2), lane, wave); kv_dma(lds, slotn * 32768 + 16384, pb, hd, 64 * (2 * kp + 3), lane, wave); }
#pragma unroll 1
            for (int sub = 0; sub < 2; ++sub) {
                const int kt = 2 * kp + sub;
                if (kt > cq) continue;
                const bool own = (kt == cq);
                const float tsc = xiA * __builtin_amdgcn_exp2f(lg2 * 64.0f * (float)(own ? 0 : cq - kt - 1));
#pragma unroll 1
                for (int blk = 0; blk < 2; ++blk) {
                    const LAS unsigned char* img = lds + L_KV + slot * 32768 + sub * 16384 + blk * 8192;
#pragma unroll
                    for (int X = 0; X < 2; ++X) {
                        f32x16 S;
#pragma unroll
                        for (int r2 = 0; r2 < 16; ++r2) S[r2] = 0.f;
#pragma unroll
                        for (int ks = 0; ks < 4; ++ks) {
                            const f16x8 ka = *(const LAS f16x8*)(img + ((ks & 1) ? rbase1 : rbase0) + 512 * (ks >> 1));
                            S = mfma32(ka, qf[X][ks], S);
                        }
                        if (!own) {
                            const float f = tsc * (blk ? 1.0f : g32) * (X ? g32 : 1.0f);
#pragma unroll
                            for (int r2 = 0; r2 < 16; ++r2) S[r2] *= cf[r2] * f;
                        } else {
                            asm volatile("" ::: "memory");
#pragma unroll
                            for (int r2 = 0; r2 < 16; ++r2) {
                                const int mk = 32 * blk + 4 * h + (r2 & 3) + 8 * (r2 >> 2);
                                S[r2] *= __builtin_amdgcn_exp2f(lg2 * fabsf((float)(32 * X + q - mk)));
                            }
                        }
                        f16x8 pk[2];
#pragma unroll
                        for (int s2 = 0; s2 < 2; ++s2)
#pragma unroll
                            for (int j2 = 0; j2 < 8; ++j2) pk[s2][j2] = (_Float16)S[8 * s2 + j2];
#pragma unroll
                        for (int s2 = 0; s2 < 2; ++s2)
#pragma unroll
                            for (int dt = 0; dt < 2; ++dt) {
                                const int ct = 2 + dt;
                                const f16x4 v0 = vtr(img + tbase0 + 4096 * s2 + 512 * ct);
                                const f16x4 v1 = vtr(img + tbase1 + 4096 * s2 + 512 * ct);
                                const f16x8 va = (f16x8){v0[0], v0[1], v0[2], v0[3], v1[0], v1[1], v1[2], v1[3]};
                                O[X][dt] = mfma32(va, pk[s2], O[X][dt]);
                            }
                        __builtin_amdgcn_sched_barrier(0);
                    }
                }
            }
            DSA_WAIT_BAR(0);
            slot ^= 1;
        }
        const dsa::f32x4 rn0 = *(const dsa::f32x4*)(ret_norm + 64 * hd + 8 * sch), rn1 = *(const dsa::f32x4*)(ret_norm + 64 * hd + 8 * sch + 4);
#pragma unroll
        for (int X = 0; X < 2; ++X) {
            float s1 = 0.f;
#pragma unroll
            for (int dt = 0; dt < 2; ++dt)
#pragma unroll
                for (int r = 0; r < 16; ++r) s1 += O[X][dt][r];
            s1 += xhalf(s1);
            const float mu = s1 * (1.0f / 64.0f);
            float s2v = 0.f;
#pragma unroll
            for (int dt = 0; dt < 2; ++dt)
#pragma unroll
                for (int r = 0; r < 16; ++r) { const float d = O[X][dt][r] - mu; s2v += d * d; }
            s2v += xhalf(s2v);
            const float rstd = rsqrtf(s2v * (1.0f / 64.0f) + EPS);
#pragma unroll
            for (int dt = 0; dt < 2; ++dt)
#pragma unroll
                for (int r4 = 0; r4 < 4; ++r4) {
                    const int d0 = 32 * dt + 8 * r4 + 4 * h;
                    f16x4 o4;
#pragma unroll
                    for (int e = 0; e < 4; ++e) o4[e] = (_Float16)((O[X][dt][4 * r4 + e] - mu) * rstd);
                    *(LAS f16x4*)(stg + q * 144 + 2 * d0) = o4;
                }
            asm volatile("s_waitcnt lgkmcnt(0)" ::: "memory");
#pragma unroll
            for (int i2 = 0; i2 < 4; ++i2) {
                const int row = 32 * X + 8 * i2 + srow;
                const f16x8 y = *(const LAS f16x8*)(stg + (8 * i2 + srow) * 144 + 16 * sch);
                const f16x8 gt = *(const f16x8*)(pb + (grow0 + (unsigned)(row * NP + C_RG + 64 * hd + 8 * sch)));
                f16x8 o8;
#pragma unroll
                for (int e = 0; e < 4; ++e) { o8[e] = (_Float16)((float)y[e] * rn0[e] * (float)gt[e]); o8[4 + e] = (_Float16)((float)y[4 + e] * rn1[e] * (float)gt[4 + e]); }
                *(f16x8*)(mix + ((size_t)b * SEQ + 64 * cq + row) * DM + 64 * hd + 8 * sch) = o8;
            }
            asm volatile("s_waitcnt lgkmcnt(0)" ::: "memory");
            __builtin_amdgcn_sched_barrier(0);
        }
    }
}
}
__device__ __forceinline__ void final_norm(float* out, const h16* x2h, const float* ssq2, const float* g, int G, int bx, int lane, int wave, const float* dbgleak) {
    const int gw = bx * NWAVES + wave, NGW = G * NWAVES;
    f32x4 gg[4];
#pragma unroll
    for (int j = 0; j < 4; ++j) gg[j] = ((const f32x4*)g)[2 * lane + 128 * (j >> 1) + (j & 1)];
    for (int row0 = 4 * gw; row0 < MTOK; row0 += 4 * NGW) {
        h16x8 v[4][2]; float rs[4];
#pragma unroll
        for (int rr = 0; rr < 4; ++rr) {
            const h16x8* xr = (const h16x8*)(x2h + (size_t)(row0 + rr) * DM);
            v[rr][0] = xr[lane]; v[rr][1] = xr[lane + 64]; rs[rr] = ssq2[row0 + rr];
        }
#pragma unroll
        for (int rr = 0; rr < 4; ++rr) {
            const int row = row0 + rr;
            const float rstd = rsqrtf(rs[rr] * (1.0f / DM) + EPS);
            f32x4* orow = (f32x4*)(out + (size_t)row * DM);
#pragma unroll
            for (int k = 0; k < 2; ++k) {
                f32x4 o0, o1;
#pragma unroll
                for (int e2 = 0; e2 < 4; ++e2) { o0[e2] = (float)v[rr][k][e2] * gg[2 * k][e2] * rstd; o1[e2] = (float)v[rr][k][4 + e2] * gg[2 * k + 1][e2] * rstd; }
#ifdef PROBE_LEAK
                if (row == 0 && lane == 0 && k == 0) o0[0] += dbgleak[0];
#endif
                orow[2 * lane + 128 * k] = o0; orow[2 * lane + 128 * k + 1] = o1;
            }
        }
    }
}

#ifndef EN_P0
#define EN_P0 1
#endif
#ifndef EN_P1
#define EN_P1 1
#endif
#ifndef EN_P1B
#define EN_P1B 1
#endif
#ifndef EN_RET
#define EN_RET 1
#endif
#ifndef EN_DSA
#define EN_DSA 1
#endif
#ifndef EN_P3A
#define EN_P3A 1
#endif
#ifndef EN_P3B
#define EN_P3B 1
#endif
#ifndef EN_P4
#define EN_P4 1
#endif
#ifndef EN_P5
#define EN_P5 1
#endif
#ifndef REP_P0
#define REP_P0 1
#endif
#ifndef REP_P1
#define REP_P1 1
#endif
#ifndef REP_RET
#define REP_RET 1
#endif
#ifndef REP_SEL
#define REP_SEL 1
#endif
#ifndef REP_ATT
#define REP_ATT 1
#endif
#if defined(PROBE_BAR)
#define XBAR(i) do { unsigned long long tb1_ = 0; if ((i) == PROBE_BAR) tb1_ = __builtin_amdgcn_s_memrealtime(); xcd_barrier(bar); \
        if ((i) == PROBE_BAR && threadIdx.x == 0) ((float*)(ws + WS_CTL) + 140100)[bx] = (float)(__builtin_amdgcn_s_memrealtime() - tb1_) * 0.001f; } while (0)
#else
#define XBAR(i) xcd_barrier(bar)
#endif
__global__ void __launch_bounds__(NTHR, 2) mega_fwd(Args a) {
    extern __shared__ __attribute__((aligned(16))) unsigned char lds_raw[];
    LAS unsigned char* lds = (LAS unsigned char*)lds_raw;
    volatile LAS unsigned* MISC = (volatile LAS unsigned*)(lds + MISC_OFF);
    const int wave = __builtin_amdgcn_readfirstlane((int)threadIdx.x >> 6);
    const int G = gridDim.x, bx = blockIdx.x;
#define PHASE_IDS() unsigned lz_ = 0u; asm volatile("" : "+v"(lz_)); int lane = (int)__builtin_amdgcn_mbcnt_hi(~0u, __builtin_amdgcn_mbcnt_lo(~0u, lz_)); asm volatile("" : "+v"(lane)); const int tid = wave * 64 + lane; (void)tid
    { PHASE_IDS();
    for (int u = tid; u < (LDS_BYTES - LDSCTL_OFF) / 4; u += NTHR) ((LAS unsigned*)(lds + LDSCTL_OFF))[u] = 0u; }
    __syncthreads();
    unsigned char* ws = a.ws;
    unsigned* ctl = (unsigned*)(ws + WS_CTL);
    float* ssq1 = (float*)(ws + WS_CTL); float* ssq2 = ssq1 + MTOK;
    const float2* tab = (const float2*)(ws + WS_TAB);
    h16* WinT = (h16*)(ws + WS_WIN); h16* WoutT = (h16*)(ws + WS_WOUT); h16* WgT = (h16*)(ws + WS_WG); h16* WpT = (h16*)(ws + WS_WP);
    h16* A0 = (h16*)(ws + WS_A0); h16* P16 = (h16*)(ws + WS_P16); h16* proj = (h16*)(ws + WS_PROJ); h16* mix = (h16*)(ws + WS_MIX); h16* pp = (h16*)(ws + WS_PP);
    h16* x1h = proj;
    h16* x2h = proj + (size_t)MTOK * DM;
    const float* rnorm = (const float*)(ws + WS_CTL) + 3 * MTOK;
    XcdBarrier bar = xcd_barrier_post(ctl + CW_BAR, MISC + 8);

#if EN_P0
    for (int rep = 0; rep < REP_P0; ++rep) { PHASE_IDS(); p0_prologue(a, lds, G, bx, tid, lane, wave); __syncthreads(); }
#endif
    XBAR(0);

#if EN_P1
    for (int rep = 0; rep < REP_P1; ++rep) {
        pg8::Gemm g{(const pg8::bf16_t*)A0, (const pg8::bf16_t*)WinT, MTOK, NP, DM, true};
#if defined(PROBE_GEMMWAIT) && !defined(PROBE_G4)
        g.dbg = (float*)(ws + WS_CTL) + 140000;
#endif
        pg8::StaticOrder S; S.init(MTOK, NP, G, bx);
        pg8::EpiProj E{proj, tab, a.kv_norm, (PG8_LAS float*)(lds + L_CKVSS)};
#ifdef STAGGER
        { const int k_ = (bx >> 3) & 3; for (int i_ = 0; i_ < k_ * STAGGER; ++i_) __builtin_amdgcn_s_sleep(127); }
#endif
#if defined(PROBE_CLK) && PROBE_CLK == 1
        const unsigned long long ck0 = __builtin_amdgcn_s_memtime(), cr0 = __builtin_amdgcn_s_memrealtime();
#endif
        pg8::gemm_phase<pg8::EpiProj, pg8::StaticOrder, true, true>(lds, g, S, E, wave);
#if defined(PROBE_CLK) && PROBE_CLK == 1
        if (bx == 0 && threadIdx.x == 0) { const unsigned long long ck1 = __builtin_amdgcn_s_memtime(), cr1 = __builtin_amdgcn_s_memrealtime(); ((float*)(ws + WS_CTL) + 140000)[0] = 10.0f * 0.1f * (float)(ck1 - ck0) / (float)(cr1 - cr0); }
#endif
    }
#endif
    XBAR(1);

#if EN_P1B && !FUSE_CKV
    { PHASE_IDS(); fix_ckv(proj, a.kv_norm, G, bx, lane, wave); }
    XBAR(2);
#endif
#if defined(PROBE_P2IDLE) || defined(PROBE_P2STAT)
    const unsigned long long p2_t0 = __builtin_amdgcn_s_memtime();
#endif

#if EN_RET && !RET_DYN
    for (int rep = 0; rep < REP_RET; ++rep) { PHASE_IDS(); for (int u = bx; u < BATCH * 8; u += G) ret2::retention_unit(lds, u >> 3, u & 7, proj, a.ret_norm, mix, lane, wave); }
#endif
#if EN_DSA && DYN_TAIL
    {
    constexpr int NS = DYN_NS, NB_T = BATCH - 4 * NS, NQ = NB_T * 64;
    unsigned* maskg = (unsigned*)(ws + WS_MASK);
    int tb = 0, tqb = 0;
    for (int step = 0;; ++step) {
        int mode, b, qb;
        if (step < 2 * NS) { const int j = step < NS ? step : step - NS, qq_ = ((bx & 63) + 16 * (j >> 1)) & 63; mode = step < NS ? 0 : 1; b = (bx >> 6) + 4 * j; qb = (j & 1) ? 63 - qq_ : qq_; }
        else if (((step - 2 * NS) & 1) == 0) {
            if (threadIdx.x == 0) MISC[12] = __hip_atomic_fetch_add(ctl + CW_QUEUE, 1u, __ATOMIC_RELAXED, __HIP_MEMORY_SCOPE_AGENT);
            __syncthreads(); const unsigned kq = MISC[12]; __syncthreads();
            if (kq >= (unsigned)NQ) break;
            tb = 4 * NS + (int)(kq % (unsigned)NB_T); tqb = 63 - (int)(kq / (unsigned)NB_T); mode = 0; b = tb; qb = tqb;
        } else { mode = 1; b = tb; qb = tqb; }
        if (mode == 0) { if (qb >= 8) { PHASE_IDS(); dsa::dsa_select_unit(lds, b, qb, proj, (float*)(ws + WS_SCR) + (size_t)bx * (32 * 2048), maskg, tid, lane, wave); } __syncthreads(); }
        else { PHASE_IDS(); dsa::dsa_attn_unit(lds, b, qb, proj, maskg, (const h16*)(ws + WS_WUK), (const h16*)(ws + WS_WUV), mix, tid, lane, wave, (float*)(ws + WS_CTL) + 140000); }
    }
    }
#elif EN_DSA
    for (int rep = 0; rep < REP_SEL; ++rep) { PHASE_IDS();
    unsigned* maskg = (unsigned*)(ws + WS_MASK);
    for (int j = 0; j < 8; ++j) {
        const int b = (bx >> 6) + 4 * j, qq_ = ((bx & 63) + 16 * (j >> 1)) & 63, qb = (j & 1) ? 63 - qq_ : qq_;
        if (qb >= 8) dsa::dsa_select_unit(lds, b, qb, proj, (float*)(ws + WS_SCR) + (size_t)bx * (32 * 2048), maskg, tid, lane, wave);
    } }
    __syncthreads();
    for (int rep = 0; rep < REP_ATT; ++rep) { PHASE_IDS();
#if defined(PROBE_ATTLOOP) || defined(PROBE_ATTWAIT) || defined(PROBE_ATTSEG)
    const unsigned long long t_att0 = __builtin_amdgcn_s_memtime();
#endif
    const unsigned* maskg = (const unsigned*)(ws + WS_MASK);
    for (int j = 0; j < 8; ++j) {
        const int b = (bx >> 6) + 4 * j, qq_ = ((bx & 63) + 16 * (j >> 1)) & 63, qb = (j & 1) ? 63 - qq_ : qq_;
        dsa::dsa_attn_unit(lds, b, qb, proj, maskg, (const h16*)(ws + WS_WUK), (const h16*)(ws + WS_WUV), mix, tid, lane, wave, (float*)(ws + WS_CTL) + 140000);
    }
#if defined(PROBE_ATTLOOP) || defined(PROBE_ATTSEG)
    if (bx == 0 && wave == 0 && lane == 0) { float* dbg = (float*)(ws + WS_CTL) + 140000; dbg[0] = 50.0f * dbg[1] / (float)(__builtin_amdgcn_s_memtime() - t_att0); }
#endif
#ifdef PROBE_ATTWAIT
    if (bx == 0 && wave == PROBE_ATTWAIT - 1 && lane == 0) { float* dbg = (float*)(ws + WS_CTL) + 140000; dbg[0] = 50.0f * dbg[2] / (float)(__builtin_amdgcn_s_memtime() - t_att0); }
#endif
    }
#endif
#if EN_RET && RET_DYN
    {
        __syncthreads();
        unsigned nx = 0u;
        if (threadIdx.x == 0) MISC[12] = __hip_atomic_fetch_add(ctl + CW_QUEUE, 1u, __ATOMIC_RELAXED, __HIP_MEMORY_SCOPE_AGENT);
        __syncthreads();
        unsigned kq = MISC[12];
        while (kq < 1024u) {
            if (threadIdx.x == 0) nx = __hip_atomic_fetch_add(ctl + CW_QUEUE, 1u, __ATOMIC_RELAXED, __HIP_MEMORY_SCOPE_AGENT);
            { PHASE_IDS(); const int g = 3 - (int)(kq >> 8), u = (int)(kq & 255u); ret2::retention_unit(lds, u >> 3, u & 7, proj, a.ret_norm, mix, lane, wave, g, g + 1); }
            __syncthreads();
            if (threadIdx.x == 0) MISC[12] = nx;
            __syncthreads();
            kq = MISC[12];
        }
    }
#endif
#if defined(PROBE_P2IDLE) || defined(PROBE_P2STAT)
    const unsigned long long p2_t1 = __builtin_amdgcn_s_memtime();
#endif
    XBAR(3);
#if defined(PROBE_P2IDLE)
    if (bx == PROBE_P2IDLE - 1 && threadIdx.x == 0) { const unsigned long long p2_t2 = __builtin_amdgcn_s_memtime(); ((float*)(ws + WS_CTL) + 140000)[0] = 50.0f * (float)(p2_t2 - p2_t1) / (float)(p2_t2 - p2_t0); }
#endif
#if defined(PROBE_P2STAT)
    if (threadIdx.x == 0) { const unsigned long long p2_t2 = __builtin_amdgcn_s_memtime(); ((float*)(ws + WS_CTL) + 140100)[bx] = 50.0f * (float)(p2_t2 - p2_t1) / (float)(p2_t2 - p2_t0); }
#endif

#if EN_P3A
    {
        pg8::Gemm g{(const pg8::bf16_t*)mix, (const pg8::bf16_t*)WoutT, MTOK, DM, DM, false}; pg8::StaticOrder S; S.init(MTOK, DM, G, bx);
        pg8::EpiOut E{A0, rnorm, a.norm_mix, x1h, ssq1};
        pg8::gemm_phase<pg8::EpiOut, pg8::StaticOrder, true, true>(lds, g, S, E, wave);
    }
#endif
    __syncthreads();
#if EN_P3B
    {
        int kp = PLE; asm volatile("" : "+s"(kp));
        pg8::Gemm g{(const pg8::bf16_t*)P16, (const pg8::bf16_t*)WpT, MTOK, DM, kp, false}; pg8::StaticOrder S; S.init(MTOK, DM, G, bx);
        pg8::EpiPle E{pp};
        pg8::gemm_phase<pg8::EpiPle, pg8::StaticOrder, true, true>(lds, g, S, E, wave);
    }
#endif
    XBAR(4);

#if EN_P4
    {
        pg8::Gemm g{(const pg8::bf16_t*)x1h, (const pg8::bf16_t*)WgT, MTOK, DM, DM, false};
#if defined(PROBE_GEMMWAIT) && defined(PROBE_G4)
        g.dbg = (float*)(ws + WS_CTL) + 140000;
#endif
        pg8::StaticOrder S; S.init(MTOK, DM, G, bx);
        pg8::EpiGate E{x1h, pp, ssq1, x2h, ssq2};
        pg8::gemm_phase<pg8::EpiGate, pg8::StaticOrder, true, true>(lds, g, S, E, wave);
    }
#endif
    XBAR(5);

#if EN_P5
#if defined(PROBE_P2STAT) || defined(PROBE_BAR)
#ifndef PROBE_P2STAT
#define PROBE_P2STAT 1
#endif
    if (threadIdx.x == 0) { const float* st_ = (const float*)(ws + WS_CTL) + 140100; float mn = 1e9f, mx = -1e9f, sm = 0.f; for (int i = 0; i < 256; ++i) { const float v = st_[i]; mn = fminf(mn, v); mx = fmaxf(mx, v); sm += v; }
        ((float*)(ws + WS_CTL) + 140000)[0] = PROBE_P2STAT == 1 ? sm * (1.0f / 256.0f) : (PROBE_P2STAT == 2 ? mx : mn); }
    asm volatile("s_waitcnt vmcnt(0)" ::: "memory"); __syncthreads();
#endif
    { PHASE_IDS(); final_norm(a.out, x2h, ssq2, a.norm_final, G, bx, lane, wave, (const float*)(ws + WS_CTL) + 140000); }
#endif
}

extern "C" void kernel_launch(void* const* d_in, const int* in_sizes, int n_in, void* d_out, int out_size, void* d_ws, size_t ws_size, hipStream_t stream) {
    static int grid = 0;
    if (grid == 0) {
        if (n_in != 14 || ws_size < WS_END) { fprintf(stderr, "kernel_launch: unexpected inputs (n_in %d, ws %zu)\n", n_in, ws_size); grid = -1; return; }
        int dev = 0, cus = 0;
        if (hipGetDevice(&dev) != hipSuccess || hipDeviceGetAttribute(&cus, hipDeviceAttributeMultiprocessorCount, dev) != hipSuccess) { grid = -1; return; }
        if (hipFuncSetAttribute((const void*)mega_fwd, hipFuncAttributeMaxDynamicSharedMemorySize, LDS_BYTES) != hipSuccess) { fprintf(stderr, "kernel_launch: hipFuncSetAttribute failed\n"); grid = -1; return; }
        int nb = 0;
        if (hipOccupancyMaxActiveBlocksPerMultiprocessor(&nb, (const void*)mega_fwd, NTHR, LDS_BYTES) != hipSuccess || nb < 1) { fprintf(stderr, "kernel_launch: occupancy query failed (%d blocks per CU)\n", nb); grid = -1; return; }
        if (cus != 256) { fprintf(stderr, "kernel_launch: the mixer unit deal is written for 256 CUs (found %d)\n", cus); grid = -1; return; }
        grid = cus;
    }
    if (grid < 0) return;
    if (hipMemsetAsync((char*)d_ws + WS_CTL, 0, CTL_BYTES, stream) != hipSuccess) return;
    Args a{};
    a.x = (const float*)d_in[0]; a.p = (const float*)d_in[1]; a.pos = (const int*)d_in[2]; a.norm_mix = (const float*)d_in[3]; a.w_in = (const float*)d_in[4];
    a.ret_norm = (const float*)d_in[5]; a.kv_norm = (const float*)d_in[6]; a.w_uk = (const float*)d_in[7]; a.w_uv = (const float*)d_in[8]; a.w_out = (const float*)d_in[9];
    a.norm_ple = (const float*)d_in[10]; a.w_ple_gate = (const float*)d_in[11]; a.w_ple_proj = (const float*)d_in[12]; a.norm_final = (const float*)d_in[13];
    a.out = (float*)d_out; a.ws = (unsigned char*)d_ws;
    hipLaunchKernelGGL(mega_fwd, dim3(grid), dim3(NTHR), LDS_BYTES, stream, a);
}
```

```cpp
#include <hip/hip_runtime.h>
#ifndef FUSE_CKV
#define FUSE_CKV 1
#endif
#ifndef RET_DYN
#define RET_DYN 1
#endif
#ifndef P16_TAIL
#define P16_TAIL 1
#endif
#ifndef DYN_NS
#define DYN_NS 4
#endif
#ifndef DYN_TAIL
#define DYN_TAIL 0
#endif
#include <cstdio>
#include <cstdint>

typedef _Float16 h16;
typedef h16 h16x8 __attribute__((ext_vector_type(8)));
typedef h16 h16x4 __attribute__((ext_vector_type(4)));
typedef h16 h16x2 __attribute__((ext_vector_type(2)));

constexpr int BATCH = 32, SEQ = 2048, DM = 1024, MTOK = BATCH * SEQ;
constexpr int NP = 3584;
constexpr int PLE = 256;
constexpr float EPS = 1e-6f;
constexpr int C_RQ = 0, C_RK = 512, C_RV = 1024, C_RG = 1536, C_QPE = 2048, C_QN = 2176, C_CKV = 2560, C_KPE = 2688, C_KI = 2704, C_IW = 2736,
              C_DG = 2752, C_IQ = 3264, C_END = 3520;
constexpr int NFREQ = 44;

constexpr size_t MiB = 1u << 20;
constexpr size_t WS_CTL = 0;
constexpr size_t CTL_BYTES = 1 * MiB;
constexpr size_t WS_TAB = 1 * MiB;
constexpr size_t WS_WIN = 2 * MiB;
constexpr size_t WS_WOUT = 10 * MiB;
constexpr size_t WS_WG = 12 * MiB;
constexpr size_t WS_WP = 14 * MiB;
constexpr size_t WS_A0 = 16 * MiB;
constexpr size_t WS_P16 = 144 * MiB;
constexpr size_t WS_PROJ = 176 * MiB;
constexpr size_t WS_MIX = 624 * MiB;
constexpr size_t WS_PP = 752 * MiB;
constexpr size_t WS_SCR = 880 * MiB;
constexpr size_t WS_WUK = 944 * MiB;
constexpr size_t WS_WUV = 945 * MiB;
constexpr size_t WS_MASK = 946 * MiB;
constexpr size_t WS_END = 962 * MiB;
constexpr int CW_BAR = 131072;
constexpr int CW_QUEUE = 139008;

__host__ __device__ inline int orig_col(int n) {
    if (n < 1024) { int h = (n & 511) >> 6, j = n & 63, i = j >> 1, b = j & 1; return (n & 512) + 64 * h + i + 32 * b; }
    if (n < 2048) return n;
    if (n < 2176) { int j = n - 2048, h = j >> 4, jj = j & 15, i = jj >> 1, b = jj & 1; return 2048 + 64 * h + i + 8 * b; }
    if (n < 2560) { int j = n - 2176, h = j / 48, jj = j % 48; return 2048 + 64 * h + 16 + jj; }
    if (n < 2688) { int p = n - 2560, g = (p >> 2) & 3; if (g == 1) p += 4; else if (g == 2) p -= 4; return 2560 + p; }
    if (n < 2704) { int j = n - 2688, i = j >> 1, b = j & 1; return 2688 + i + 8 * b; }
    if (n < 2736) { int j = n - 2704; if (j < 8) { int i = j >> 1, b = j & 1; return 3472 + i + 4 * b; } return 3472 + j; }
    if (n < 2744) return 3504 + (n - 2736);
    if (n < 2752) return -1;
    if (n < 3264) return 2704 + (n - 2752);
    if (n < 3520) { int j = n - 3264, h = j >> 5, jj = j & 31; if (jj < 8) { int i = jj >> 1, b = jj & 1; return 3216 + 32 * h + i + 4 * b; } return 3216 + 32 * h + jj; }
    return -1;
}
__host__ __device__ inline float col_scale(int n) {
    if (n < 512) return 0.125f;
    if (n >= 2048 && n < 2560) return 0.125f * 1.4426950408889634f;
    if (n >= 2736 && n < 2744) return 0.0625f;
    return 1.0f;
}
__device__ __forceinline__ int freq_idx(int n) {
    if (n < 1024) return (n & 63) >> 1;
    if (n >= 2048 && n < 2176) return 32 + ((n & 15) >> 1);
    if (n >= 2688 && n < 2704) return 32 + ((n - 2688) >> 1);
    if (n >= 2704 && n < 2712) return 40 + ((n - 2704) >> 1);
    if (n >= 3264 && n < 3520) { int jj = (n - 3264) & 31; if (jj < 8) return 40 + (jj >> 1); }
    return -1;
}
__device__ __forceinline__ float silu_f(float v) { return v * __builtin_amdgcn_rcpf(1.0f + __builtin_amdgcn_exp2f(-1.4426950408889634f * v)); }
__device__ __forceinline__ float sigmoid_f(float v) { return __builtin_amdgcn_rcpf(1.0f + __builtin_amdgcn_exp2f(-1.4426950408889634f * v)); }
__device__ __forceinline__ float wave_sum(float v) {
#pragma unroll
    for (int o = 1; o < 64; o <<= 1) v += __shfl_xor(v, o);
    return v;
}
__host__ __device__ __forceinline__ size_t tix(int row, int col, int K) { return ((size_t)(row >> 7) * (K >> 6) + (col >> 6)) * 8192 + (size_t)((row & 127) * 64 + (col & 63)); }
#define LAS __attribute__((address_space(3)))
#define GAS __attribute__((address_space(1)))

namespace pg8 {
#define PG8_LAS __attribute__((address_space(3)))
typedef unsigned short bf16_t;
typedef _Float16 bf16x8 __attribute__((ext_vector_type(8)));
typedef float f32x4 __attribute__((ext_vector_type(4)));
typedef unsigned u32x4 __attribute__((ext_vector_type(4)));
constexpr int BM = 256, BK = 64, HALF = 128, HTB = HALF * BK * 2  , STAGE_BYTES = 8 * HTB, NXCD = 8, WGM = 4;

__host__ __device__ __forceinline__ int lds_byte(int r, int c) { const int st = (r >> 4) * 2 + (c >> 5), rr = r & 15, cc = c & 31, ob = rr * 64 + cc * 2; return st * 1024 + (ob ^ (((ob >> 9) & 1) << 5)); }
__host__ __device__ __forceinline__ void stage_rc(int b, int& R, int& C) { const int st = b / 1024, sb = b % 1024, swz = sb ^ (((sb >> 9) & 1) << 5); R = (st >> 1) * 16 + swz / 64; C = (st & 1) * 32 + (swz % 64) / 2; }
__host__ __device__ __forceinline__ int perm32(int rho) { const int n = rho >> 4, i = rho & 15; return 8 * (i >> 2) + 4 * n + (i & 3); }

struct Unit { int pm, pn; };
struct Gemm { const bf16_t* A; const bf16_t* Bt; int M, N, K; bool tiledA; float* dbg = nullptr; };

struct StaticOrder {
    int nM, nN, nwg, G, c;
    __host__ __device__ void init(int M, int N, int G_, int c_) { nM = M / BM; nN = N / BM; nwg = nM * nN; G = G_; c = c_; }
    __host__ __device__ bool next(int i, Unit& u) const {
        const long L = (long)i * G + c; if (L >= nwg) return false;
        int wgid = (int)L; { const int q = nwg / NXCD, r = nwg % NXCD, xcd = wgid % NXCD, off = wgid / NXCD; wgid = (xcd < r ? xcd * (q + 1) : r * (q + 1) + (xcd - r) * q) + off; }
        const int nig = WGM * nN, gid = wgid / nig, fm = gid * WGM, gsz = (nM - fm) < WGM ? (nM - fm) : WGM;
        u.pm = fm + ((wgid % nig) % gsz); u.pn = (wgid % nig) / gsz; return true;
    }
    __device__ __forceinline__ void a_ready(const Unit&) const {}
    __device__ __forceinline__ void done(const Unit&) const {}
};

typedef short s16x8 __attribute__((ext_vector_type(8)));
template <bool BF> __device__ __forceinline__ f32x4 mma16(bf16x8 a, bf16x8 b, f32x4 c) {
    if constexpr (BF) return __builtin_amdgcn_mfma_f32_16x16x32_bf16(__builtin_bit_cast(s16x8, a), __builtin_bit_cast(s16x8, b), c, 0, 0, 0);
    else return __builtin_amdgcn_mfma_f32_16x16x32_f16(a, b, c, 0, 0, 0);
}
__device__ __forceinline__ unsigned short f2bf(float f) { const unsigned u = __builtin_bit_cast(unsigned, f); return (unsigned short)((u + 0x7fffu + ((u >> 16) & 1u)) >> 16); }
__device__ __forceinline__ float bf2f(unsigned short b) { return __builtin_bit_cast(float, (unsigned)b << 16); }
typedef unsigned short u16x8 __attribute__((ext_vector_type(8)));
__device__ __forceinline__ u16x8 pack8bf(const f32x4& a, const f32x4& b) {
    u16x8 o; o[0] = f2bf(a[0]); o[1] = f2bf(a[1]); o[2] = f2bf(a[2]); o[3] = f2bf(a[3]); o[4] = f2bf(b[0]); o[5] = f2bf(b[1]); o[6] = f2bf(b[2]); o[7] = f2bf(b[3]); return o;
}
__device__ __forceinline__ h16x8 pack8(const f32x4& a, const f32x4& b) {
    h16x8 o; o[0] = (h16)a[0]; o[1] = (h16)a[1]; o[2] = (h16)a[2]; o[3] = (h16)a[3]; o[4] = (h16)b[0]; o[5] = (h16)b[1]; o[6] = (h16)b[2]; o[7] = (h16)b[3]; return o;
}
struct EpiProj {
    static constexpr bool PERM = true, AFTER_DRAIN = false;
    h16* proj; const float2* tab; const float* kvn; PG8_LAS float* ssx;
    __device__ __forceinline__ void operator()(const f32x4 (&acc)[2][2][4][2], const Unit& u, int wr, int wc, int fr, int fq) const {
        const bool ck = (u.pn == C_CKV / BM);
        float rs[2][4]; f32x4 kw0 = (f32x4){1.f, 1.f, 1.f, 1.f}, kw1 = kw0;
#pragma unroll
        for (int ai = 0; ai < 2; ++ai)
#pragma unroll
            for (int m = 0; m < 4; ++m) rs[ai][m] = 1.f;
        if (ck) {
#pragma unroll
            for (int ai = 0; ai < 2; ++ai)
#pragma unroll
                for (int m = 0; m < 4; ++m) {
                    const f32x4 a = acc[ai][0][m][0], b = acc[ai][0][m][1];
                    float s_ = (a[0] * a[0] + a[1] * a[1]) + (a[2] * a[2] + a[3] * a[3]) + (b[0] * b[0] + b[1] * b[1]) + (b[2] * b[2] + b[3] * b[3]);
                    s_ += __shfl_xor(s_, 16); s_ += __shfl_xor(s_, 32);
                    if (fq == 0) ssx[(ai * HALF + wr * 64 + m * 16 + fr) * 4 + wc] = s_;
                }
            { int p0 = 32 * wc + 8 * fq, p1 = p0 + 4; if (fq & 1) p0 -= 4; else p1 += 4;
              kw0 = *(const f32x4*)(kvn + p0); kw1 = *(const f32x4*)(kvn + p1); }
            asm volatile("s_waitcnt lgkmcnt(0)" ::: "memory"); __builtin_amdgcn_s_barrier();
#pragma unroll
            for (int ai = 0; ai < 2; ++ai)
#pragma unroll
                for (int m = 0; m < 4; ++m) { const f32x4 t = *(const PG8_LAS f32x4*)(ssx + (ai * HALF + wr * 64 + m * 16 + fr) * 4); rs[ai][m] = rsqrtf(((t[0] + t[1]) + (t[2] + t[3])) * (1.0f / 128.0f) + EPS); }
        }
#pragma unroll
        for (int bj = 0; bj < 2; ++bj) {
            const int cb = u.pn * BM + bj * HALF + wc * 32;
            const int c0 = cb + 8 * fq;
            const bool rot = (cb < 1024) || (cb >= 2048 && cb < 2176) || (cb == 2688) || (cb >= 3264 && cb < 3520);
            const bool sil = (cb >= 1536 && cb < 2048) || (cb >= 2752 && cb < 3264);
            const int f0 = freq_idx(c0);
#pragma unroll
            for (int ai = 0; ai < 2; ++ai)
#pragma unroll
                for (int m = 0; m < 4; ++m) {
                    const int row = u.pm * BM + ai * HALF + wr * 64 + m * 16 + fr;
                    f32x4 a = acc[ai][bj][m][0], b = acc[ai][bj][m][1];
                    if (rot) {
                        f32x4 t0 = (f32x4){1.f, 0.f, 1.f, 0.f}, t1 = t0;
                        if (f0 >= 0) { const f32x4* tp = (const f32x4*)(tab + (size_t)(row & (SEQ - 1)) * NFREQ + f0); t0 = tp[0]; t1 = tp[1]; }
                        f32x4 ra, rb;
                        ra[0] = a[0] * t0[0] - a[1] * t0[1]; ra[1] = a[1] * t0[0] + a[0] * t0[1];
                        ra[2] = a[2] * t0[2] - a[3] * t0[3]; ra[3] = a[3] * t0[2] + a[2] * t0[3];
                        rb[0] = b[0] * t1[0] - b[1] * t1[1]; rb[1] = b[1] * t1[0] + b[0] * t1[1];
                        rb[2] = b[2] * t1[2] - b[3] * t1[3]; rb[3] = b[3] * t1[2] + b[2] * t1[3];
                        a = ra; b = rb;
                    } else if (sil) {
#pragma unroll
                        for (int e = 0; e < 4; ++e) { a[e] = silu_f(a[e]); b[e] = silu_f(b[e]); }
                    }
                    if (ck && bj == 0) { const float r_ = rs[ai][m];
#pragma unroll
                        for (int e = 0; e < 4; ++e) { a[e] *= r_ * kw0[e]; b[e] *= r_ * kw1[e]; } }
                    *(h16x8*)(proj + (size_t)row * NP + c0) = pack8(a, b);
                    if (m == 3) asm volatile("" ::: "memory");
                }
        }
    }
};
struct EpiOut {
    static constexpr bool PERM = true, AFTER_DRAIN = false;
    const h16* a0; const float* rnorm; const float* g; h16* x1h; float* ssq1;
    __device__ __forceinline__ void operator()(const f32x4 (&acc)[2][2][4][2], const Unit& u, int wr, int wc, int fr, int fq) const {
        f32x4 gi[2][2];
#pragma unroll
        for (int bj = 0; bj < 2; ++bj) {
            const int c0 = u.pn * BM + bj * HALF + wc * 32 + 8 * fq;
            const f32x4* gp = (const f32x4*)(g + c0);
#pragma unroll
            for (int n = 0; n < 2; ++n) { const f32x4 gv = gp[n]; gi[bj][n] = (f32x4){__builtin_amdgcn_rcpf(gv[0]), __builtin_amdgcn_rcpf(gv[1]), __builtin_amdgcn_rcpf(gv[2]), __builtin_amdgcn_rcpf(gv[3])}; }
        }
#pragma unroll
        for (int ai = 0; ai < 2; ++ai)
#pragma unroll
            for (int m = 0; m < 4; ++m) {
                const int row = u.pm * BM + ai * HALF + wr * 64 + m * 16 + fr; float ss = 0.f;
                const float rn = rnorm[row];
#pragma unroll
                for (int bj = 0; bj < 2; ++bj) {
                    const int c0 = u.pn * BM + bj * HALF + wc * 32 + 8 * fq;
                    const h16x8 xv = *(const h16x8*)(a0 + tix(row, c0, DM));
                    f32x4 a = acc[ai][bj][m][0], b = acc[ai][bj][m][1];
#pragma unroll
                    for (int e2 = 0; e2 < 4; ++e2) { a[e2] += (float)xv[e2] * rn * gi[bj][0][e2]; b[e2] += (float)xv[4 + e2] * rn * gi[bj][1][e2]; }
                    ss += (a[0] * a[0] + a[1] * a[1]) + (a[2] * a[2] + a[3] * a[3]) + (b[0] * b[0] + b[1] * b[1]) + (b[2] * b[2] + b[3] * b[3]);
                    *(h16x8*)(x1h + (size_t)row * DM + c0) = pack8(a, b);
                }
                ss += __shfl_xor(ss, 16); ss += __shfl_xor(ss, 32);
                if (fq == 0) atomicAdd(ssq1 + row, ss);
                if (m == 3) asm volatile("" ::: "memory");
            }
    }
};
struct EpiPle {
    static constexpr bool PERM = true, AFTER_DRAIN = false;
    h16* pp;
    __device__ __forceinline__ void operator()(const f32x4 (&acc)[2][2][4][2], const Unit& u, int wr, int wc, int fr, int fq) const {
#pragma unroll
        for (int ai = 0; ai < 2; ++ai)
#pragma unroll
            for (int m = 0; m < 4; ++m) {
                const int row = u.pm * BM + ai * HALF + wr * 64 + m * 16 + fr;
#pragma unroll
                for (int bj = 0; bj < 2; ++bj) {
                    const int c0 = u.pn * BM + bj * HALF + wc * 32 + 8 * fq;
                    *(h16x8*)(pp + (size_t)row * DM + c0) = pack8(acc[ai][bj][m][0], acc[ai][bj][m][1]);
                }
            }
    }
};
struct EpiGate {
    static constexpr bool PERM = true, AFTER_DRAIN = false;
    const h16* x1h; const h16* pp; const float* ssq1; h16* x2h; float* ssq2;
    __device__ __forceinline__ void operator()(const f32x4 (&acc)[2][2][4][2], const Unit& u, int wr, int wc, int fr, int fq) const {
#pragma unroll
        for (int ai = 0; ai < 2; ++ai)
#pragma unroll
            for (int m = 0; m < 4; ++m) {
                const int row = u.pm * BM + ai * HALF + wr * 64 + m * 16 + fr; float ss = 0.f;
                const float rstd = rsqrtf(ssq1[row] * (1.0f / DM) + EPS);
#pragma unroll
                for (int bj = 0; bj < 2; ++bj) {
                    const int c0 = u.pn * BM + bj * HALF + wc * 32 + 8 * fq;
                    const h16x8 xv = *(const h16x8*)(x1h + (size_t)row * DM + c0);
                    const h16x8 pv = *(const h16x8*)(pp + (size_t)row * DM + c0);
                    f32x4 a = acc[ai][bj][m][0], b = acc[ai][bj][m][1], ra, rb;
#pragma unroll
                    for (int e = 0; e < 4; ++e) {
                        ra[e] = (float)xv[e] + sigmoid_f(a[e] * rstd) * (float)pv[e];
                        rb[e] = (float)xv[4 + e] + sigmoid_f(b[e] * rstd) * (float)pv[4 + e];
                        ss += ra[e] * ra[e] + rb[e] * rb[e];
                    }
                    *(h16x8*)(x2h + (size_t)row * DM + c0) = pack8(ra, rb);
                }
                ss += __shfl_xor(ss, 16); ss += __shfl_xor(ss, 32);
                if (fq == 0) atomicAdd(ssq2 + row, ss);
                if (m == 3) asm volatile("" ::: "memory");
            }
    }
};
template <class Epi, class Sched, bool ALIGN_EPI = false, bool SP2 = false, bool BF = false>
__device__ __forceinline__ void gemm_phase(PG8_LAS unsigned char* lds, const Gemm g, const Sched& S, const Epi& E, int wave_in) {
    unsigned lz_ = 0u; asm volatile("" : "+v"(lz_)); int lane_o = (int)__builtin_amdgcn_mbcnt_hi(~0u, __builtin_amdgcn_mbcnt_lo(~0u, lz_)); asm volatile("" : "+v"(lane_o));
    const int wid = __builtin_amdgcn_readfirstlane(wave_in), lane = lane_o, tid = wid * 64 + lane, wr = wid >> 2, wc = wid & 3, fr = lane & 15, fq = lane >> 4;
    const int K = g.K, nt = K / BK;
    unsigned voffA[2], voffB[2];
#pragma unroll
    for (int i = 0; i < 2; ++i) { int R, C; stage_rc(tid * 16 + i * 8192, R, C); const int Rb = Epi::PERM ? ((R & ~31) + perm32(R & 31)) : R;
        voffA[i] = g.tiledA ? (unsigned)(R * BK + C) * 2u : (unsigned)(R * K + C) * 2u; voffB[i] = (unsigned)(Rb * K + C) * 2u; }
    const size_t kstep = (size_t)(BK * 2);
    const size_t kstepA = g.tiledA ? (size_t)(HALF * BK * 2) : kstep;
    const size_t hstep = (size_t)HALF * K * 2;
    const size_t tstep = 2 * hstep;
    const unsigned ldsw = (unsigned)wid * 1024u;
    const int aoff = lds_byte(wr * 64 + fr, fq * 8), boff = lds_byte(wc * 32 + fr, fq * 8);
#define PG8_SA(b, h) (((b) * 2 + (h)) * HTB)
#define PG8_SB(b, h) ((4 + (b) * 2 + (h)) * HTB)
#if defined(PROBE_GEMMWAIT) && PROBE_GEMMWAIT == 4
#define PG8_STAGE(bufoff, gbase, voff) do { const unsigned long long s0_ = __builtin_amdgcn_s_memtime(); _Pragma("unroll") for (int _i = 0; _i < 2; ++_i) \
        __builtin_amdgcn_global_load_lds((const unsigned*)((const char*)(gbase) + (voff)[_i]), (PG8_LAS unsigned*)(lds + (bufoff) + ldsw + _i * 8192), 16, 0, 0); pg_tm += __builtin_amdgcn_s_memtime() - s0_; } while (0)
#else
#define PG8_STAGE(bufoff, gbase, voff) do { _Pragma("unroll") for (int _i = 0; _i < 2; ++_i) \
        __builtin_amdgcn_global_load_lds((const unsigned*)((const char*)(gbase) + (voff)[_i]), (PG8_LAS unsigned*)(lds + (bufoff) + ldsw + _i * 8192), 16, 0, 0); } while (0)
#endif
#define PG8_LDA(dst, b, h) do { _Pragma("unroll") for (int m = 0; m < 4; ++m) _Pragma("unroll") for (int k = 0; k < 2; ++k) dst[m][k] = *(const PG8_LAS bf16x8*)(lds + PG8_SA(b, h) + aoff + m * 2048 + k * 1024); } while (0)
#define PG8_LDB(dst, b, h) do { _Pragma("unroll") for (int n = 0; n < 2; ++n) _Pragma("unroll") for (int k = 0; k < 2; ++k) dst[n][k] = *(const PG8_LAS bf16x8*)(lds + PG8_SB(b, h) + boff + n * 2048 + k * 1024); } while (0)
#define PG8_MMA(ai, bj, At, Bt) do { __builtin_amdgcn_s_setprio(1); _Pragma("unroll") for (int m = 0; m < 4; ++m) _Pragma("unroll") for (int n = 0; n < 2; ++n) _Pragma("unroll") for (int k = 0; k < 2; ++k) \
        acc[ai][bj][m][n] = mma16<BF>(Bt[n][k], At[m][k], acc[ai][bj][m][n]); __builtin_amdgcn_s_setprio(0); } while (0)
#define PG8_WAIT_V(n) asm volatile("s_waitcnt vmcnt(" #n ")" ::: "memory")
#define PG8_WAIT_L(n) asm volatile("s_waitcnt lgkmcnt(" #n ")" ::: "memory")
#define PG8_BAR __builtin_amdgcn_s_barrier()
#define PG8_SCHED __builtin_amdgcn_sched_barrier(0)
#if defined(PROBE_GEMMWAIT)
    unsigned long long pg_tw = 0, pg_tb = 0, pg_t0 = 0, pg_t1 = 0, pg_tm = 0; const unsigned long long pg_begin = __builtin_amdgcn_s_memtime();
#define PG8_TW0 pg_t0 = __builtin_amdgcn_s_memtime()
#define PG8_TW1 { const unsigned long long n_ = __builtin_amdgcn_s_memtime(); pg_tw += n_ - pg_t0; pg_t1 = n_; }
#if PROBE_GEMMWAIT >= 4
#define PG8_TB0 pg_t0 = __builtin_amdgcn_s_memtime()
#else
#define PG8_TB0 { pg_t0 = __builtin_amdgcn_s_memtime(); pg_tm += pg_t0 - pg_t1; }
#endif
#define PG8_TB1 pg_tb += __builtin_amdgcn_s_memtime() - pg_t0
#else
#define PG8_TW0
#define PG8_TW1
#define PG8_TB0
#define PG8_TB1
#endif
    Unit cur, nxt; int ui = 0;
    if (!S.next(0, cur)) return;
    f32x4 acc[2][2][4][2];
#pragma unroll
    for (int a = 0; a < 2; ++a)
#pragma unroll
        for (int b = 0; b < 2; ++b)
#pragma unroll
            for (int m = 0; m < 4; ++m)
#pragma unroll
                for (int n = 0; n < 2; ++n) acc[a][b][m][n] = (f32x4){0.f, 0.f, 0.f, 0.f};
    bf16x8 At[4][2], B0[2][2], B1[2][2];
    const char* cA = (const char*)g.A + (size_t)cur.pm * tstep; const char* cB = (const char*)g.Bt + (size_t)cur.pn * tstep;
    S.a_ready(cur);
    if constexpr (SP2) {
        PG8_STAGE(PG8_SB(0, 0), cB, voffB); PG8_STAGE(PG8_SB(0, 1), cB + hstep, voffB); PG8_STAGE(PG8_SA(0, 0), cA, voffA); PG8_STAGE(PG8_SA(0, 1), cA + hstep, voffA);
        if (wr == 1) PG8_BAR;
        PG8_WAIT_V(2); PG8_BAR;
        PG8_STAGE(PG8_SB(1, 0), cB + kstep, voffB); PG8_STAGE(PG8_SA(1, 0), cA + kstepA, voffA); PG8_STAGE(PG8_SB(1, 1), cB + hstep + kstep, voffB);
        PG8_WAIT_V(6); PG8_BAR;
    } else {
        PG8_STAGE(PG8_SB(0, 0), cB, voffB); PG8_STAGE(PG8_SA(0, 0), cA, voffA); PG8_STAGE(PG8_SB(0, 1), cB + hstep, voffB); PG8_STAGE(PG8_SA(0, 1), cA + hstep, voffA);
        if (wr == 1) PG8_BAR;
        PG8_WAIT_V(4); PG8_BAR;
        PG8_STAGE(PG8_SB(1, 0), cB + kstep, voffB); PG8_STAGE(PG8_SA(1, 0), cA + kstepA, voffA); PG8_STAGE(PG8_SB(1, 1), cB + hstep + kstep, voffB);
        PG8_WAIT_V(6); PG8_BAR;
    }
    for (;;) {
        const bool has_next = S.next(ui + 1, nxt);
        const char* nA = has_next ? (const char*)g.A + (size_t)nxt.pm * tstep : cA; const char* nB = has_next ? (const char*)g.Bt + (size_t)nxt.pn * tstep : cB;
        for (int t = 0; t < nt; t += 2) {
            const bool last = (t == nt - 2);
            const char* a1 = cA + (size_t)(t + 1) * kstepA;
            const char* a2 = last ? nA : cA + (size_t)(t + 2) * kstepA; const char* b2 = last ? nB : cB + (size_t)(t + 2) * kstep;
            const char* a3 = a2 + kstepA; const char* b3 = b2 + kstep;
            if (last && has_next) S.a_ready(nxt);
            if constexpr (SP2) {
            PG8_LDB(B0, 0, 0); PG8_LDB(B1, 0, 1); PG8_SCHED; PG8_LDA(At, 0, 0); PG8_STAGE(PG8_SA(1, 1), a1 + hstep, voffA);
            PG8_TW0; PG8_WAIT_V(8); PG8_WAIT_L(0); PG8_BAR; PG8_TW1; PG8_MMA(0, 0, At, B0); PG8_MMA(0, 1, At, B1); PG8_TB0; PG8_BAR; PG8_TB1; PG8_SCHED;
            PG8_LDA(At, 0, 1); PG8_STAGE(PG8_SB(0, 0), b2, voffB); PG8_STAGE(PG8_SB(0, 1), b2 + hstep, voffB); PG8_STAGE(PG8_SA(0, 0), a2, voffA);
            PG8_TW0; PG8_WAIT_V(8); PG8_WAIT_L(0); PG8_BAR; PG8_TW1; PG8_MMA(1, 0, At, B0); PG8_MMA(1, 1, At, B1); PG8_TB0; PG8_BAR; PG8_TB1; PG8_SCHED;
            PG8_LDB(B0, 1, 0); PG8_LDB(B1, 1, 1); PG8_SCHED; PG8_LDA(At, 1, 0); PG8_STAGE(PG8_SA(0, 1), a2 + hstep, voffA);
            PG8_TW0; PG8_WAIT_V(8); PG8_WAIT_L(0); PG8_BAR; PG8_TW1; PG8_MMA(0, 0, At, B0); PG8_MMA(0, 1, At, B1); PG8_TB0; PG8_BAR; PG8_TB1; PG8_SCHED;
            PG8_LDA(At, 1, 1); PG8_STAGE(PG8_SB(1, 0), b3, voffB); PG8_STAGE(PG8_SB(1, 1), b3 + hstep, voffB); PG8_STAGE(PG8_SA(1, 0), a3, voffA);
            PG8_TW0; PG8_WAIT_V(8); PG8_WAIT_L(0); PG8_BAR; PG8_TW1; PG8_MMA(1, 0, At, B0); PG8_MMA(1, 1, At, B1); PG8_TB0; PG8_BAR; PG8_TB1; PG8_SCHED;
            } else {
            PG8_LDB(B0, 0, 0); PG8_SCHED; PG8_LDA(At, 0, 0); PG8_STAGE(PG8_SA(1, 1), a1 + hstep, voffA);
            PG8_WAIT_L(8); PG8_BAR; PG8_WAIT_L(0); PG8_MMA(0, 0, At, B0); PG8_BAR; PG8_SCHED;
            PG8_LDB(B1, 0, 1); PG8_STAGE(PG8_SB(0, 0), b2, voffB);
            PG8_BAR; PG8_WAIT_L(0); PG8_MMA(0, 1, At, B1); PG8_BAR;
            PG8_LDA(At, 0, 1); PG8_STAGE(PG8_SA(0, 0), a2, voffA);
            PG8_BAR; PG8_WAIT_L(0); PG8_MMA(1, 0, At, B0); PG8_BAR; PG8_SCHED;
            PG8_STAGE(PG8_SB(0, 1), b2 + hstep, voffB);
            PG8_WAIT_V(6); PG8_BAR; PG8_MMA(1, 1, At, B1); PG8_BAR;
            PG8_LDB(B0, 1, 0); PG8_SCHED; PG8_LDA(At, 1, 0); PG8_STAGE(PG8_SA(0, 1), a2 + hstep, voffA);
            PG8_WAIT_L(8); PG8_BAR; PG8_WAIT_L(0); PG8_MMA(0, 0, At, B0); PG8_BAR; PG8_SCHED;
            PG8_LDB(B1, 1, 1); PG8_STAGE(PG8_SB(1, 0), b3, voffB);
            PG8_BAR; PG8_WAIT_L(0); PG8_MMA(0, 1, At, B1); PG8_BAR;
            PG8_LDA(At, 1, 1); PG8_STAGE(PG8_SA(1, 0), a3, voffA);
            PG8_BAR; PG8_WAIT_L(0); PG8_MMA(1, 0, At, B0); PG8_BAR; PG8_SCHED;
            PG8_STAGE(PG8_SB(1, 1), b3 + hstep, voffB);
            PG8_WAIT_V(6); PG8_BAR; PG8_MMA(1, 1, At, B1); PG8_BAR;
            }
        }
        if constexpr (ALIGN_EPI) { if (wr == 0) PG8_BAR; }
#if defined(PROBE_GEMMWAIT) && PROBE_GEMMWAIT == 5
        { const unsigned long long e0_ = __builtin_amdgcn_s_memtime(); if constexpr (!Epi::AFTER_DRAIN) { E(acc, cur, wr, wc, fr, fq); S.done(cur); } asm volatile("s_waitcnt vmcnt(0)" ::: "memory"); pg_tm += __builtin_amdgcn_s_memtime() - e0_; }
#elif defined(PROBE_GEMMWAIT) && PROBE_GEMMWAIT == 6
        { const unsigned long long e0_ = __builtin_amdgcn_s_memtime(); if constexpr (!Epi::AFTER_DRAIN) { E(acc, cur, wr, wc, fr, fq); S.done(cur); } asm volatile("" ::: "memory"); pg_tm += __builtin_amdgcn_s_memtime() - e0_; }
#else
        if constexpr (!Epi::AFTER_DRAIN) { E(acc, cur, wr, wc, fr, fq); S.done(cur); }
#endif
        if (!has_next) break;
#pragma unroll
        for (int a = 0; a < 2; ++a)
#pragma unroll
            for (int b = 0; b < 2; ++b)
#pragma unroll
                for (int m = 0; m < 4; ++m)
#pragma unroll
                    for (int n = 0; n < 2; ++n) acc[a][b][m][n] = (f32x4){0.f, 0.f, 0.f, 0.f};
        cur = nxt; cA = nA; cB = nB; ++ui;
        if constexpr (ALIGN_EPI) { if (wr == 1) PG8_BAR; }
    }
    PG8_WAIT_V(0);
    if constexpr (!ALIGN_EPI) { if (wr == 0) PG8_BAR; }
    PG8_BAR;
    if constexpr (Epi::AFTER_DRAIN) { E.fused(acc, cur, wr, wc, fr, fq, lds, wid, lane); S.done(cur); }
#if defined(PROBE_GEMMWAIT)
    if (blockIdx.x == 0 && wid == 0 && lane == 0 && g.dbg) { const float tot = (float)(__builtin_amdgcn_s_memtime() - pg_begin); g.dbg[0] = 50.0f * (float)(PROBE_GEMMWAIT == 1 ? pg_tw : (PROBE_GEMMWAIT == 2 ? pg_tb : pg_tm)) / tot; }
#endif
#undef PG8_TW0
#undef PG8_TW1
#undef PG8_TB0
#undef PG8_TB1
#undef PG8_SA
#undef PG8_SB
#undef PG8_STAGE
#undef PG8_LDA
#undef PG8_LDB
#undef PG8_MMA
#undef PG8_WAIT_V
#undef PG8_WAIT_L
#undef PG8_BAR
#undef PG8_SCHED
}
}
#define XB_TMO      128
#define XB_XCNT(j)  (256  + 64 * (j))
#define XB_XSUB(j)  (1280 + 64 * (j))
#define XB_XGEN(j)  (2304 + 64 * (j))
#define XB_TOP      3328
#define XB_TOPGEN   3392
#define XCD_BAR_WORDS 3456
#define XB_SPIN_CAP (1u << 18)

__device__ __forceinline__ unsigned xb_ld(unsigned* p)              { return __hip_atomic_load(p, __ATOMIC_RELAXED, __HIP_MEMORY_SCOPE_AGENT); }
__device__ __forceinline__ unsigned xb_add(unsigned* p, unsigned v) { return __hip_atomic_fetch_add(p, v, __ATOMIC_RELAXED, __HIP_MEMORY_SCOPE_AGENT); }
__device__ __forceinline__ unsigned xb_xcc_id() { return (unsigned)__builtin_amdgcn_s_getreg((3 << 11) | 20) & 0xFu; }
#define XB_SPIN(cond, bar) do { unsigned _sp = 0; while (cond) { __builtin_amdgcn_s_sleep(1); \
    if ((++_sp & 255u) == 0u) { if (xb_ld(&(bar)[XB_TMO])) break; if (_sp > XB_SPIN_CAP) { atomicAdd(&(bar)[XB_TMO], 1u); break; } } } } while (0)

struct XcdBarrier {
    unsigned* bar; unsigned x;
    volatile LAS unsigned* st;
};

__device__ __forceinline__ XcdBarrier xcd_barrier_post(unsigned* bar, volatile LAS unsigned* st) {
    XcdBarrier b; b.bar = bar; b.x = xb_xcc_id(); b.st = st;
    if (threadIdx.x == 0) (void)xb_add(&bar[XB_XCNT(b.x)], 1u);
    return b;
}
__device__ __forceinline__ void xcd_barrier_complete(unsigned* bar, unsigned x, unsigned& nloc, unsigned& nx) {
    const unsigned G = gridDim.x * gridDim.y * gridDim.z;
    unsigned sum, cnt, mine, sp = 0u;
    for (;;) {
        sum = 0u; cnt = 0u; mine = 0u;
#pragma unroll
        for (unsigned j = 0; j < 16; ++j) { const unsigned c = xb_ld(&bar[XB_XCNT(j)]); sum += c; cnt += (c > 0u) ? 1u : 0u; mine = (j == x) ? c : mine; }
        if (sum == G) break;
        __builtin_amdgcn_s_sleep(1);
        if ((++sp & 255u) == 0u) { if (xb_ld(&bar[XB_TMO])) break; if (sp > XB_SPIN_CAP) { atomicAdd(&bar[XB_TMO], 1u); break; } }
    }
    nloc = mine > 0u ? mine : 1u; nx = cnt > 0u ? cnt : 1u;
}

__device__ __forceinline__ void xcd_barrier(const XcdBarrier& b) {
    asm volatile("s_waitcnt vmcnt(0)" ::: "memory");
    __syncthreads();
    if (threadIdx.x == 0) {
        unsigned* bar = b.bar;
        __builtin_amdgcn_s_waitcnt(0);
        unsigned nloc = b.st[0], nx = b.st[1];
        if (nloc == 0u) { xcd_barrier_complete(bar, b.x, nloc, nx); b.st[0] = nloc; b.st[1] = nx; }
        const unsigned old = xb_add(&bar[XB_XSUB(b.x)], 1u);
        const unsigned gen = old / nloc;
        if (old + 1u == (gen + 1u) * nloc) {
            __builtin_amdgcn_fence(__ATOMIC_RELEASE, "agent");
            asm volatile("s_waitcnt vmcnt(0)" ::: "memory");
            const unsigned og = xb_add(&bar[XB_TOP], 1u);
            const unsigned tg = og / nx;
            if (og + 1u == (tg + 1u) * nx) xb_add(&bar[XB_TOPGEN], 1u);
            else XB_SPIN(xb_ld(&bar[XB_TOPGEN]) == tg, bar);
            __builtin_amdgcn_fence(__ATOMIC_ACQUIRE, "agent");
            xb_add(&bar[XB_XGEN(b.x)], 1u);
            asm volatile("s_waitcnt vmcnt(0)" ::: "memory");
        } else {
            XB_SPIN(xb_ld(&bar[XB_XGEN(b.x)]) == gen, bar);
            __builtin_amdgcn_fence(__ATOMIC_ACQUIRE, "agent");
            asm volatile("s_waitcnt vmcnt(0)" ::: "memory");
        }
    }
    __syncthreads();
}

constexpr int NWAVES = 8, NTHR = 512;
constexpr int RING_BYTES = 131072, LDSCTL_OFF = RING_BYTES, MISC_OFF = LDSCTL_OFF + 320, L_CKVSS = LDSCTL_OFF + 1024  , LDS_BYTES = 147456;
typedef float f32x4 __attribute__((ext_vector_type(4)));

struct Args {
    const float* x; const float* p; const int* pos; const float* norm_mix; const float* w_in; const float* ret_norm; const float* kv_norm;
    const float* w_uk; const float* w_uv; const float* w_out; const float* norm_ple; const float* w_ple_gate; const float* w_ple_proj; const float* norm_final;
    float* out; unsigned char* ws;
};

__device__ __forceinline__ void p0_transpose_item(const float* __restrict__ W, int ldw, h16* __restrict__ WT, int K, int n0, int k0, bool perm, const float* __restrict__ gk,
                                                  LAS float* scr, int lane, bool asbf = false) {
    const int nn = n0 + (lane & 31);
    const int oc = perm ? orig_col(nn) : nn;
    const float sc = perm ? col_scale(nn) : 1.0f;
#pragma unroll 8
    for (int i = 0; i < 32; ++i) {
        const int kk = 2 * i + (lane >> 5);
        float v = (oc >= 0) ? W[(size_t)(k0 + kk) * ldw + oc] * sc : 0.f;
        if (gk) v *= gk[k0 + kk];
        scr[kk * 33 + (lane & 31)] = v;
    }
    asm volatile("s_waitcnt lgkmcnt(0)" ::: "memory");
    const int c = lane & 7;
#pragma unroll
    for (int j = 0; j < 4; ++j) {
        const int n = (lane >> 3) + 8 * j; const LAS float* s = scr + (8 * c) * 33 + n;
        h16x8 o;
#pragma unroll
        for (int e = 0; e < 8; ++e) o[e] = asbf ? __builtin_bit_cast(h16, pg8::f2bf(s[e * 33])) : (h16)s[e * 33];
        *(h16x8*)(WT + (size_t)(n0 + n) * K + k0 + 8 * c) = o;
    }
    asm volatile("s_waitcnt lgkmcnt(0)" ::: "memory");
}
__device__ __forceinline__ void p0_prologue(const Args& a, LAS unsigned char* lds, int G, int bx, int tid, int lane, int wave) {
    unsigned char* ws = a.ws;
    float2* tab = (float2*)(ws + WS_TAB);
    h16* WinT = (h16*)(ws + WS_WIN); h16* WoutT = (h16*)(ws + WS_WOUT); h16* WgT = (h16*)(ws + WS_WG); h16* WpT = (h16*)(ws + WS_WP);
    h16* A0 = (h16*)(ws + WS_A0); h16* P16 = (h16*)(ws + WS_P16);
    const int gw = bx * NWAVES + wave, NGW = G * NWAVES;
    for (int i = bx * NTHR + tid; i < SEQ * NFREQ; i += G * NTHR) {
        const int s = i / NFREQ, f = i % NFREQ; float inv;
        if (f < 32) inv = powf(10000.0f, -(float)(2 * f) / 64.0f);
        else if (f < 40) inv = powf(500000.0f, -(float)(2 * (f - 32)) / 16.0f);
        else inv = powf(500000.0f, -(float)(2 * (f - 40)) / 8.0f);
        const float ang = (float)a.pos[s] * inv;
        tab[i] = make_float2(cosf(ang), sinf(ang));
    }
    LAS float* scr = (LAS float*)(lds + wave * 16384);
    constexpr int I_IN = 16 * (NP / 32), I_O = 16 * 32, I_G = 16 * 32, I_P = 4 * 32;
    for (int it = gw; it < I_IN + I_O + I_G + I_P; it += NGW) {
        int r = it;
        if (r < I_IN) { p0_transpose_item(a.w_in, 3512, WinT, DM, (r % (NP / 32)) * 32, (r / (NP / 32)) * 64, true, nullptr, scr, lane); continue; } r -= I_IN;
        if (r < I_O) { p0_transpose_item(a.w_out, DM, WoutT, DM, (r % 32) * 32, (r / 32) * 64, false, nullptr, scr, lane); continue; } r -= I_O;
        if (r < I_G) { p0_transpose_item(a.w_ple_gate, DM, WgT, DM, (r % 32) * 32, (r / 32) * 64, false, a.norm_ple, scr, lane); continue; } r -= I_G;
        p0_transpose_item(a.w_ple_proj, DM, WpT, PLE, (r % 32) * 32, (r / 32) * 64, false, nullptr, scr, lane);
    }
    {
        h16* WukT = (h16*)(ws + WS_WUK); h16* WuvT = (h16*)(ws + WS_WUV);
        for (int i = bx * NTHR + tid; i < 8 * 128 * 48; i += G * NTHR) { const int hh = i / (128 * 48), r = i % (128 * 48), c = r / 48, j = r % 48; WukT[i] = (h16)a.w_uk[(hh * 48 + j) * 128 + c]; }
        for (int i = bx * NTHR + tid; i < 8 * 64 * 128; i += G * NTHR) { const int hh = i / (64 * 128), r = i % (64 * 128), d = r / 128, c = r % 128; WuvT[i] = (h16)a.w_uv[(hh * 128 + c) * 64 + d]; }
    }
    {
        f32x4 gg[4];
#pragma unroll
        for (int j = 0; j < 4; ++j) gg[j] = ((const f32x4*)a.norm_mix)[lane + 64 * j];
        for (int row0 = 4 * gw; row0 < MTOK; row0 += 4 * NGW) {
            f32x4 v[4][4]; float ss[4];
#pragma unroll
            for (int rr = 0; rr < 4; ++rr) {
                const f32x4* xr = (const f32x4*)(a.x + (size_t)(row0 + rr) * DM);
#pragma unroll
                for (int j = 0; j < 4; ++j) v[rr][j] = xr[lane + 64 * j];
            }
#pragma unroll
            for (int rr = 0; rr < 4; ++rr) {
                float s_ = 0.f;
#pragma unroll
                for (int j = 0; j < 4; ++j) s_ += (v[rr][j][0] * v[rr][j][0] + v[rr][j][1] * v[rr][j][1]) + (v[rr][j][2] * v[rr][j][2] + v[rr][j][3] * v[rr][j][3]);
                ss[rr] = s_;
            }
#pragma unroll
            for (int o = 1; o < 64; o <<= 1) {
#pragma unroll
                for (int rr = 0; rr < 4; ++rr) ss[rr] += __shfl_xor(ss[rr], o);
            }
#pragma unroll
            for (int rr = 0; rr < 4; ++rr) {
                const int row = row0 + rr;
                const float rstd = rsqrtf(ss[rr] * (1.0f / DM) + EPS);
                if (lane == 0) ((float*)(ws + WS_CTL) + 3 * MTOK)[row] = 1.0f / rstd;
#pragma unroll
                for (int j = 0; j < 4; ++j) {
                    h16x4 o; o[0] = (h16)(v[rr][j][0] * rstd * gg[j][0]); o[1] = (h16)(v[rr][j][1] * rstd * gg[j][1]); o[2] = (h16)(v[rr][j][2] * rstd * gg[j][2]); o[3] = (h16)(v[rr][j][3] * rstd * gg[j][3]);
                    *(h16x4*)(A0 + tix(row, (lane + 64 * j) * 4, DM)) = o;
                }
            }
        }
    }
#if !(RET_DYN && P16_TAIL)
    for (size_t i = (size_t)bx * NTHR + tid; i < (size_t)MTOK * PLE / 4; i += (size_t)4 * G * NTHR) {
        f32x4 v[4];
#pragma unroll
        for (int u2 = 0; u2 < 4; ++u2) v[u2] = ((const f32x4*)a.p)[i + (size_t)u2 * G * NTHR];
#pragma unroll
        for (int u2 = 0; u2 < 4; ++u2) { h16x4 o; o[0] = (h16)v[u2][0]; o[1] = (h16)v[u2][1]; o[2] = (h16)v[u2][2]; o[3] = (h16)v[u2][3]; ((h16x4*)P16)[i + (size_t)u2 * G * NTHR] = o; }
    }
#endif
}

__device__ __forceinline__ void fix_ckv(h16* proj, const float* kvn, int G, int bx, int lane, int wave) {
    const int gw = bx * NWAVES + wave, NGW = G * NWAVES;
    int p0 = 2 * lane; { const int g = (p0 >> 2) & 3; if (g == 1) p0 += 4; else if (g == 2) p0 -= 4; }
    const float g0 = kvn[p0], g1 = kvn[p0 + 1];
    for (int row0 = 4 * gw; row0 < MTOK; row0 += 4 * NGW) {
        h16x2 v[4]; float ss[4];
#pragma unroll
        for (int rr = 0; rr < 4; ++rr) v[rr] = *((const h16x2*)(proj + (size_t)(row0 + rr) * NP + C_CKV) + lane);
#pragma unroll
        for (int rr = 0; rr < 4; ++rr) { const float a_ = (float)v[rr][0], b_ = (float)v[rr][1]; ss[rr] = a_ * a_ + b_ * b_; }
#pragma unroll
        for (int o = 1; o < 64; o <<= 1) {
#pragma unroll
            for (int rr = 0; rr < 4; ++rr) ss[rr] += __shfl_xor(ss[rr], o);
        }
#pragma unroll
        for (int rr = 0; rr < 4; ++rr) {
            const float rstd = rsqrtf(ss[rr] * (1.0f / 128.0f) + EPS);
            h16x2 o; o[0] = (h16)((float)v[rr][0] * rstd * g0); o[1] = (h16)((float)v[rr][1] * rstd * g1);
            *((h16x2*)(proj + (size_t)(row0 + rr) * NP + C_CKV) + lane) = o;
        }
    }
}

namespace dsa {
typedef _Float16 f16x8 __attribute__((ext_vector_type(8)));
typedef _Float16 f16x4 __attribute__((ext_vector_type(4)));
typedef float f32x16 __attribute__((ext_vector_type(16)));
typedef float f32x4 __attribute__((ext_vector_type(4)));
typedef short v4i16_t __attribute__((ext_vector_type(4)));
constexpr int L_KT = 0;
constexpr int L_KR = 49152;
constexpr int L_MASK = 55296;
constexpr int L_QI = 63488;
constexpr int L_BIAS = 63488;
#define DSA_WAIT_BAR(N) asm volatile("s_waitcnt vmcnt(" #N ") lgkmcnt(0)\n\ts_barrier" ::: "memory")
constexpr float NEG = -3.0e38f;

__device__ __forceinline__ unsigned off_b(unsigned row, unsigned ch) { return 256u * row + 16u * (ch ^ (((row & 3) << 2) | ((row >> 2) & 3))); }
__device__ __forceinline__ unsigned off_a(unsigned row, unsigned ch) { return 2048u * (row >> 3) + 512u * (ch >> 2) + 64u * (row & 7) + 16u * ((ch & 3) ^ ((row >> 2) & 3)); }
__device__ __forceinline__ float max3f(float a, float b, float c) { float r; asm("v_max3_f32 %0, %1, %2, %3" : "=v"(r) : "v"(a), "v"(b), "v"(c)); return r; }
__device__ __forceinline__ float relu_s(float a) { float r; asm("v_max_f32_e32 %0, 0, %1" : "=v"(r) : "v"(a)); return r; }
#define MFMA_ASM_FENCE(x) asm volatile("s_nop 15\n\ts_nop 7" : "+v"(x))
__device__ __forceinline__ int wave_isum(int v) {
    v += __builtin_amdgcn_update_dpp(0, v, 0xB1, 0xF, 0xF, false);
    v += __builtin_amdgcn_update_dpp(0, v, 0x4E, 0xF, 0xF, false);
    v += __builtin_amdgcn_update_dpp(0, v, 0x141, 0xF, 0xF, false);
    v += __builtin_amdgcn_update_dpp(0, v, 0x140, 0xF, 0xF, false);
    return __builtin_amdgcn_readlane(v, 0) + __builtin_amdgcn_readlane(v, 16) + __builtin_amdgcn_readlane(v, 32) + __builtin_amdgcn_readlane(v, 48);
}
__device__ __forceinline__ f16x4 vtr(const LAS unsigned char* p) { return __builtin_bit_cast(f16x4, __builtin_amdgcn_ds_read_tr16_b64_v4i16((LAS v4i16_t*)p)); }
__device__ __forceinline__ unsigned ord_key(float f) { const unsigned u = __float_as_uint(f); return (u & 0x80000000u) ? ~u : (u | 0x80000000u); }
__device__ __forceinline__ f32x16 mfma32(f16x8 a, f16x8 b, f32x16 c) { return __builtin_amdgcn_mfma_f32_32x32x16_f16(a, b, c, 0, 0, 0); }
__device__ __forceinline__ float xhalf(float v) { return __shfl_xor(v, 32); }

__device__ __forceinline__ void kstage_dma(LAS unsigned char* lds, int buf, const h16* pb, int key0, int lane, int wave) {
    const int row = 8 * (wave >> 1) + ((lane >> 2) & 7);
    const int ch = 4 * (2 * (wave & 1) + (lane >> 5)) + ((lane & 3) ^ ((row >> 2) & 3));
#pragma unroll
    for (int im = 0; im < 2; ++im) {
        const h16* src = pb + (size_t)(key0 + 32 * im + row) * NP + C_CKV + 8 * ch;
        __builtin_amdgcn_global_load_lds((const unsigned*)src, (LAS unsigned*)(lds + L_KT + buf * 16384 + im * 8192 + wave * 1024), 16, 0, 0);
    }
    {
        const int slot = 64 * (wave & 1) + lane;
        const h16* src = pb + (size_t)(key0 + (slot >> 1)) * NP + C_KPE + 8 * (slot & 1);
        __builtin_amdgcn_global_load_lds((const unsigned*)src, (LAS unsigned*)(lds + L_KR + buf * 2048 + (wave & 1) * 1024), 16, 0, 0);
    }
}

__device__ __forceinline__ void dsa_select_unit(LAS unsigned char* lds, int b, int qb, const h16* __restrict__ proj, float* __restrict__ scr, unsigned* __restrict__ maskg,
                                                int tid, int lane, int wave) {
    const int c = qb >> 1, N = 64 * (c + 1);
    const h16* pb = proj + (size_t)b * SEQ * NP;
    const h16* prow = pb + (unsigned)((32 * qb + (lane & 31)) * NP);
    LAS unsigned* maskw = (LAS unsigned*)(lds + L_MASK);
    if (N > 256) {
        const int q = lane & 31, h = lane >> 5;
        for (int i = tid; i < 2048; i += NTHR) maskw[i] = 0u;
        {
            LAS unsigned char* qil = lds + L_QI;
            { const h16* qsrc = pb + (unsigned)(32 * qb * NP + C_IQ);
#pragma unroll
              for (int i2 = 0; i2 < 2; ++i2) { const int id = tid + NTHR * i2, row = id >> 5, ch = id & 31;
                  *(LAS f16x8*)(qil + row * 528 + ch * 16) = *(const f16x8*)(qsrc + (unsigned)(row * NP + 8 * ch)); } }
            float wq[8];
            { const f16x8 w8 = *(const f16x8*)(prow + C_IW);
#pragma unroll
              for (int hh = 0; hh < 8; ++hh) wq[hh] = (float)w8[hh]; }
            __syncthreads();
            const LAS unsigned char* qfr = qil + q * 528 + 16 * h;
            const unsigned koff = (unsigned)(q * NP + C_KI + 8 * h);
            int kt = wave;
            f16x8 ka0, ka1;
            if (kt < N / 32) { ka0 = *(const f16x8*)(pb + (koff + (unsigned)(32 * kt * NP))); ka1 = *(const f16x8*)(pb + (koff + (unsigned)(32 * kt * NP + 16))); }
            for (; kt < N / 32; kt += 8) {
                const f16x8 a0 = ka0, a1 = ka1;
                if (kt + 8 < N / 32) { ka0 = *(const f16x8*)(pb + (koff + (unsigned)(32 * (kt + 8) * NP))); ka1 = *(const f16x8*)(pb + (koff + (unsigned)(32 * (kt + 8) * NP + 16))); }
                f32x16 sc;
#pragma unroll
                for (int r = 0; r < 16; ++r) sc[r] = 0.f;
#pragma unroll
                for (int hh = 0; hh < 8; ++hh) {
                    const f16x8 q0 = *(const LAS f16x8*)(qfr + 64 * hh), q1 = *(const LAS f16x8*)(qfr + 64 * hh + 32);
                    f32x16 x;
#pragma unroll
                    for (int r = 0; r < 16; ++r) x[r] = 0.f;
                    x = mfma32(a0, q0, x); x = mfma32(a1, q1, x);
                    MFMA_ASM_FENCE(x);
#pragma unroll
                    for (int r = 0; r < 16; ++r) sc[r] += wq[hh] * relu_s(x[r]);
                    if (hh & 1) __builtin_amdgcn_sched_barrier(0);
                }
#pragma unroll
                for (int r4 = 0; r4 < 4; ++r4) {
                    const int kg = 8 * kt + 2 * r4 + h;
                    *(f32x4*)(scr + (unsigned)((kg * 32 + q) * 4)) = (f32x4){sc[4 * r4], sc[4 * r4 + 1], sc[4 * r4 + 2], sc[4 * r4 + 3]};
                }
            }
        }
        __syncthreads();
        const int NG = N >> 2;
        const int nip = (NG + 63) >> 6;
        for (int i = 0; i < 4; ++i) {
            const int qq = 4 * wave + i;
            unsigned kk[32];
#pragma unroll
            for (int ip = 0; ip < 8; ++ip) {
                const int kg = lane + 64 * ip;
                f32x4 v = (f32x4){0.f, 0.f, 0.f, 0.f};
                const bool ok = kg < NG;
                if (ok) v = *(const f32x4*)(scr + (unsigned)((kg * 32 + qq) * 4));
#pragma unroll
                for (int e = 0; e < 4; ++e) kk[4 * ip + e] = ok ? ord_key(v[e]) : 0u;
            }
            unsigned T = 0u; bool exact = false;
            for (int bit = 31; bit >= 0; --bit) {
                const unsigned cand = T | (1u << bit);
                int lc0 = 0, lc1 = 0, lc2 = 0, lc3 = 0;
#pragma unroll
                for (int r0 = 0; r0 < 32; r0 += 4) {
                    if (r0 < 4 * nip) {
                        unsigned long long t0_, t1_, t2_, t3_;
                        asm volatile("v_cmp_le_u32_e64 %4, %12, %8\n\tv_cmp_le_u32_e64 %5, %12, %9\n\tv_cmp_le_u32_e64 %6, %12, %10\n\tv_cmp_le_u32_e64 %7, %12, %11\n\t"
                                     "v_addc_co_u32_e64 %0, %4, 0, %0, %4\n\tv_addc_co_u32_e64 %1, %5, 0, %1, %5\n\tv_addc_co_u32_e64 %2, %6, 0, %2, %6\n\tv_addc_co_u32_e64 %3, %7, 0, %3, %7"
                                     : "+v"(lc0), "+v"(lc1), "+v"(lc2), "+v"(lc3), "=&s"(t0_), "=&s"(t1_), "=&s"(t2_), "=&s"(t3_)
                                     : "v"(kk[r0]), "v"(kk[r0 + 1]), "v"(kk[r0 + 2]), "v"(kk[r0 + 3]), "s"(cand));
                    }
                }
                const int lc = (lc0 + lc1) + (lc2 + lc3);
                const int cnt = wave_isum(lc);
                if (cnt >= 256) T = cand;
                if (cnt == 256) { exact = true; break; }
            }
            asm volatile("" : "+v"(T));
            unsigned selbits = 0u;
            if (exact) {
#pragma unroll
                for (int r0 = 0; r0 < 32; r0 += 4) {
#pragma unroll
                    for (int r = r0; r < r0 + 4; ++r) selbits |= (kk[r] >= T) ? (1u << r) : 0u;
                    __builtin_amdgcn_sched_barrier(0);
                }
            } else {
                int lg = 0;
#pragma unroll
                for (int r = 0; r < 32; ++r) lg += (kk[r] > T) ? 1 : 0;
                const int ngt = wave_isum(lg);
                const int need = 256 - ngt;
                const int lane4 = 4 * lane;
                int J = 0;
                for (int bit = 10; bit >= 0; --bit) {
                    const int cj = J | (1 << bit);
                    unsigned Tv = T; asm volatile("" : "+v"(Tv));
                    int lcj = 0;
#pragma unroll
                    for (int r = 0; r < 32; ++r) lcj += (kk[r] == Tv && lane4 < cj - (256 * (r >> 2) + (r & 3))) ? 1 : 0;
                    const int cnt = wave_isum(lcj);
                    if (cnt < need) J = cj;
                }
#pragma unroll
                for (int r0 = 0; r0 < 32; r0 += 2) {
#pragma unroll
                    for (int r = r0; r < r0 + 2; ++r) selbits |= (kk[r] > T || (kk[r] == T && lane4 <= J - (256 * (r >> 2) + (r & 3)))) ? (1u << r) : 0u;
                    __builtin_amdgcn_sched_barrier(0);
                }
            }
#pragma unroll
            for (int ip = 0; ip < 8; ++ip) {
                const int kg = lane + 64 * ip;
                if (kg < NG) {
                    const unsigned nib = (selbits >> (4 * ip)) & 15u;
                    const int tile = (lane >> 4) + 4 * ip;
                    __hip_atomic_fetch_or(maskw + ((qq * 32 + tile) * 2 + ((lane & 15) >> 3)), nib << (4 * (lane & 7)), __ATOMIC_RELAXED, __HIP_MEMORY_SCOPE_WORKGROUP);
                }
            }
        }
    } else {
        for (int i = tid; i < 2048; i += NTHR) maskw[i] = 0xffffffffu;
    }

    __syncthreads();
    { unsigned* dst = maskg + ((size_t)b * SEQ + 32 * qb) * 64;
      for (int i = tid; i < 2048; i += NTHR) dst[i] = maskw[i]; }
    __syncthreads();
}

__device__ __forceinline__ void bias_tile(LAS unsigned char* lds, int bbuf, const LAS unsigned* maskw, bool allsel, int T, int lane, int wave) {
    const int q = lane & 31, h = lane >> 5, blk = wave >> 2, r4 = wave & 3;
    const unsigned mw = allsel ? 0xffffffffu : maskw[(q * 32 + T) * 2 + blk];
    const unsigned nib = ~(mw >> (8 * r4 + 4 * h));
    f32x4 bv;
#pragma unroll
    for (int e = 0; e < 4; ++e) bv[e] = __uint_as_float((unsigned)__builtin_amdgcn_sbfe((int)nib, e, 1) & 0xff61b1e6u);
    *(LAS f32x4*)(lds + L_BIAS + bbuf * 8192 + ((blk * 4 + r4) * 64 + lane) * 16) = bv;
}

__device__ __forceinline__ void dsa_attn_unit(LAS unsigned char* lds, int b, int qb, const h16* __restrict__ proj, const unsigned* __restrict__ maskg,
                                              const h16* __restrict__ WukT, const h16* __restrict__ WuvT, h16* __restrict__ mix, int tid, int lane, int wave, float* dbg) {
    const int c = qb >> 1;
    const h16* pb = proj + (size_t)b * SEQ * NP;
    const size_t m = (size_t)b * SEQ + 32 * qb + (lane & 31);
    const h16* prow = proj + m * NP;
    kstage_dma(lds, 0, pb, 0, lane, wave);
    if (c >= 1) kstage_dma(lds, 1, pb, 64, lane, wave);
    LAS unsigned* maskw = (LAS unsigned*)(lds + L_MASK);
    if (c >= 4) { const unsigned* src = maskg + ((size_t)b * SEQ + 32 * qb) * 64; for (int i = tid; i < 2048; i += NTHR) maskw[i] = src[i]; }
    __syncthreads();
    bias_tile(lds, 0, maskw, c < 4, 0, lane, wave);
    const int q = lane & 31, h = lane >> 5;
    const int hd = wave;
    f16x8 qbf[8]; f16x8 qpe;
    {
        f16x8 qn[3];
#pragma unroll
        for (int s = 0; s < 3; ++s) qn[s] = *(const f16x8*)(prow + C_QN + 48 * hd + 16 * s + 8 * h);
        qpe = *(const f16x8*)(prow + C_QPE + 16 * hd + 8 * h);
#pragma unroll
        for (int ct = 0; ct < 4; ++ct) {
            f32x16 acc;
#pragma unroll
            for (int r = 0; r < 16; ++r) acc[r] = 0.f;
#pragma unroll
            for (int s = 0; s < 3; ++s) {
                const f16x8 wa = *(const f16x8*)(WukT + (size_t)(hd * 128 + 32 * ct + q) * 48 + 16 * s + 8 * h);
                acc = mfma32(wa, qn[s], acc);
            }
#pragma unroll
            for (int k2 = 0; k2 < 2; ++k2) {
                f16x8 t;
#pragma unroll
                for (int j = 0; j < 8; ++j) t[j] = (_Float16)acc[8 * k2 + j];
                qbf[2 * ct + k2] = t;
            }
        }
    }
    f32x16 O[4];
#pragma unroll
    for (int ct = 0; ct < 4; ++ct)
#pragma unroll
        for (int r = 0; r < 16; ++r) O[ct][r] = 0.f;
    float mrun = -1.0e30f, lrun = 0.f;
#ifdef PROBE_ATTSEG
    unsigned long long segacc = 0;
#endif
    const int qq4 = (lane & 15) >> 2, p4 = lane & 3, b16 = (lane >> 4) & 1;
    const unsigned rbase0 = off_a(q, h), rbase1 = off_a(q, 2 + h);
    const unsigned tbase0 = off_a(4 * h + qq4, 2 * b16 + (p4 >> 1)) + 8 * (p4 & 1), tbase1 = off_a(8 + 4 * h + qq4, 2 * b16 + (p4 >> 1)) + 8 * (p4 & 1);

    __syncthreads();
#ifdef PROBE_ATTLOOP
    const unsigned long long tl0 = __builtin_amdgcn_s_memtime();
#endif
    int buf = 0;
    for (int t = 0; t <= c; ++t) {
        const int bufn = (buf >= 1) ? buf - 1 : 2;
        if (t + 2 <= c) kstage_dma(lds, bufn, pb, 64 * (t + 2), lane, wave);
        if (t + 1 <= c) bias_tile(lds, (t + 1) & 1, maskw, c < 4, t + 1, lane, wave);
        const LAS unsigned char* kt0 = lds + L_KT + buf * 16384;
        const LAS unsigned char* kr0 = lds + L_KR + buf * 2048;
        {
            const LAS unsigned char* img0 = kt0; const LAS unsigned char* img1 = kt0 + 8192;
            f32x16 S0, S1;
            {
                const LAS unsigned char* bp = lds + L_BIAS + (t & 1) * 8192 + lane * 16;
#pragma unroll
                for (int r4 = 0; r4 < 4; ++r4) { const f32x4 b0 = *(const LAS f32x4*)(bp + r4 * 1024), b1 = *(const LAS f32x4*)(bp + 4096 + r4 * 1024);
#pragma unroll
                    for (int e = 0; e < 4; ++e) { S0[4 * r4 + e] = b0[e]; S1[4 * r4 + e] = b1[e]; } }
            }
            f16x8 ka[8]; f16x8 kr;
#define ATT_KLOAD(img, blk) do { _Pragma("unroll") for (int ks = 0; ks < 8; ++ks) ka[ks] = *(const LAS f16x8*)((img) + ((ks & 1) ? rbase1 : rbase0) + 512 * (ks >> 1)); \
                                 kr = *(const LAS f16x8*)(kr0 + (32 * (blk) + q) * 32 + 16 * h); } while (0)
#define ATT_SM(c, S, pk, alpha, mnew, ps) do { \
            if ((c) == 0) { mnew = max3f(S[0], S[1], S[2]); mnew = max3f(mnew, S[3], S[4]); mnew = max3f(mnew, S[5], S[6]); mnew = max3f(mnew, S[7], S[8]); } \
            if ((c) == 1) { mnew = max3f(mnew, S[9], S[10]); mnew = max3f(mnew, S[11], S[12]); mnew = max3f(mnew, S[13], S[14]); mnew = max3f(mnew, S[15], S[15]); } \
            if ((c) == 2) { const float mo_ = xhalf(mnew); mnew = max3f(mnew, mo_, mo_); mnew = max3f(mrun, mnew, mnew); alpha = __builtin_amdgcn_exp2f(mrun - mnew); mrun = mnew; ps = 0.f; } \
            if ((c) >= 3 && (c) <= 6) { _Pragma("unroll") for (int r_ = 4 * ((c) - 3); r_ < 4 * ((c) - 3) + 4; ++r_) { const float e_ = __builtin_amdgcn_exp2f(S[r_] - mnew); S[r_] = e_; ps += e_; } } \
            if ((c) == 7) { _Pragma("unroll") for (int j_ = 0; j_ < 8; ++j_) pk[0][j_] = (_Float16)S[j_]; } \
            if ((c) == 8) { _Pragma("unroll") for (int j_ = 0; j_ < 8; ++j_) pk[1][j_] = (_Float16)S[8 + j_]; lrun = lrun * alpha + ps; } \
        } while (0)
            ATT_KLOAD(img0, 0);
#pragma unroll
            for (int ks = 0; ks < 8; ++ks) S0 = mfma32(ka[ks], qbf[ks], S0);
            S0 = mfma32(kr, qpe, S0);
            ATT_KLOAD(img1, 1);
            MFMA_ASM_FENCE(S0);
            f16x8 pk0[2], pk1[2]; float alpha0 = 1.f, alpha1 = 1.f, mn0 = 0.f, mn1 = 0.f, ps0 = 0.f, ps1 = 0.f;
            __builtin_amdgcn_sched_barrier(0);
#pragma unroll
            for (int ks = 0; ks < 9; ++ks) {
                if (ks < 8) S1 = mfma32(ka[ks], qbf[ks], S1); else S1 = mfma32(kr, qpe, S1);
                ATT_SM(ks, S0, pk0, alpha0, mn0, ps0);
                __builtin_amdgcn_sched_barrier(0);
            }
            if (__any(alpha0 != 1.0f)) {
#pragma unroll
                for (int ct = 0; ct < 4; ++ct)
#pragma unroll
                    for (int r = 0; r < 16; ++r) O[ct][r] *= alpha0;
            }
            f16x4 va0[8], va1[8];
#define ATT_VLOAD(img) do { _Pragma("unroll") for (int i2 = 0; i2 < 8; ++i2) { va0[i2] = vtr((img) + tbase0 + 4096 * (i2 >> 2) + 512 * (i2 & 3)); va1[i2] = vtr((img) + tbase1 + 4096 * (i2 >> 2) + 512 * (i2 & 3)); } } while (0)
#define ATT_VFRAG(i2) (f16x8){va0[i2][0], va0[i2][1], va0[i2][2], va0[i2][3], va1[i2][0], va1[i2][1], va1[i2][2], va1[i2][3]}
            ATT_VLOAD(img0);
            MFMA_ASM_FENCE(S1);
            __builtin_amdgcn_sched_barrier(0);
#pragma unroll
            for (int i2 = 0; i2 < 8; ++i2) {
                O[i2 & 3] = mfma32(ATT_VFRAG(i2), pk0[i2 >> 2], O[i2 & 3]);
                ATT_SM(i2, S1, pk1, alpha1, mn1, ps1);
                if (i2 == 7) ATT_SM(8, S1, pk1, alpha1, mn1, ps1);
                __builtin_amdgcn_sched_barrier(0);
            }
            if (__any(alpha1 != 1.0f)) {
#pragma unroll
                for (int ct = 0; ct < 4; ++ct)
#pragma unroll
                    for (int r = 0; r < 16; ++r) O[ct][r] *= alpha1;
            }
            ATT_VLOAD(img1);
#pragma unroll
            for (int i2 = 0; i2 < 8; ++i2) O[i2 & 3] = mfma32(ATT_VFRAG(i2), pk1[i2 >> 2], O[i2 & 3]);
#undef ATT_KLOAD
#undef ATT_SM
#undef ATT_VLOAD
#undef ATT_VFRAG
        }
#ifdef PROBE_ATTWAIT
        const unsigned long long tw0 = __builtin_amdgcn_s_memtime();
#endif
        if (t + 2 <= c) DSA_WAIT_BAR(3); else DSA_WAIT_BAR(0);
#ifdef PROBE_ATTWAIT
        if (blockIdx.x == 0 && wave == PROBE_ATTWAIT - 1 && lane == 0) dbg[2] += (float)(__builtin_amdgcn_s_memtime() - tw0);
#endif
        buf = (buf == 2) ? 0 : buf + 1;
    }
#ifdef PROBE_ATTLOOP
    if (blockIdx.x == 0 && wave == 0 && lane == 0) { dbg[1] += (float)(__builtin_amdgcn_s_memtime() - tl0); }
#endif
#ifdef PROBE_ATTSEG
    if (blockIdx.x == 0 && wave == 0 && lane == 0) { dbg[1] += (float)segacc; }
#endif
    {
        const float ltot = lrun + xhalf(lrun);
        const float inv = 1.0f / ltot;
        f16x8 ob[8];
#pragma unroll
        for (int ks = 0; ks < 8; ++ks)
#pragma unroll
            for (int j = 0; j < 8; ++j) ob[ks][j] = (_Float16)(O[ks >> 1][8 * (ks & 1) + j] * inv);
#pragma unroll
        for (int dt = 0; dt < 2; ++dt) {
            f32x16 acc;
#pragma unroll
            for (int r = 0; r < 16; ++r) acc[r] = 0.f;
#pragma unroll
            for (int ks = 0; ks < 8; ++ks) {
                const f16x8 wa = *(const f16x8*)(WuvT + (size_t)(hd * 64 + 32 * dt + q) * 128 + 16 * ks + 8 * h);
                acc = mfma32(wa, ob[ks], acc);
            }
#pragma unroll
            for (int r4 = 0; r4 < 4; ++r4) {
                const int d0 = 32 * dt + 8 * r4 + 4 * h;
                const f16x4 g4 = *(const f16x4*)(prow + C_DG + 64 * hd + d0);
                f16x4 o4;
#pragma unroll
                for (int e = 0; e < 4; ++e) o4[e] = (_Float16)(acc[4 * r4 + e] * (float)g4[e]);
                *(f16x4*)(mix + m * DM + 512 + 64 * hd + d0) = o4;
            }
        }
    }
}
}
namespace ret {
using dsa::f16x8; using dsa::f16x4; using dsa::f32x16; using dsa::off_b; using dsa::vtr; using dsa::mfma32; using dsa::xhalf;
constexpr int L_KV = 0;
constexpr int L_ST = 65536;
__device__ __forceinline__ void kv_dma(LAS unsigned char* lds, int boff, const h16* pb, int hd, int key0, int lane, int wave) {
    const int row = 4 * wave + (lane >> 4), chp = lane & 15;
    const int ch = chp ^ (((row & 3) << 2) | ((row >> 2) & 3));
    const int col = (ch < 8 ? C_RK + 8 * ch : C_RV + 8 * (ch - 8)) + 64 * hd;
#pragma unroll
    for (int im = 0; im < 2; ++im) {
        const h16* src = pb + (size_t)(key0 + 32 * im + row) * NP + col;
        __builtin_amdgcn_global_load_lds((const unsigned*)src, (LAS unsigned*)(lds + L_KV + boff + im * 8192 + wave * 1024), 16, 0, 0);
#ifdef PROBE_H4
        __builtin_amdgcn_global_load_lds((const unsigned*)src, (LAS unsigned*)(lds + L_KV + boff + im * 8192 + wave * 1024), 16, 0, 0);
#endif
    }
}
__device__ __forceinline__ void retention_unit(LAS unsigned char* lds, int b, int hd, const h16* __restrict__ proj, const float* __restrict__ ret_norm, h16* __restrict__ mix,
                                               int lane, int wave, float* dbg) {
    const int q = lane & 31, h = lane >> 5;
    const h16* pb = proj + (size_t)b * SEQ * NP;
#if defined(PROBE_RETWAIT) || defined(PROBE_RETFAST) || defined(PROBE_RETSEG)
    unsigned long long t_wait = 0, t_begin = __builtin_amdgcn_s_memtime();
#endif
    const float lg2 = log2f(1.0f - exp2f(-5.0f - (float)hd));
    const float g32 = exp2f(lg2 * 32.0f);
    float cf[16];
#pragma unroll
    for (int r = 0; r < 16; ++r) cf[r] = exp2f(lg2 * (float)(31 - 4 * h - ((r & 3) + 8 * (r >> 2))));
    const int qq4 = (lane & 15) >> 2, p4 = lane & 3, b16 = (lane >> 4) & 1;
    const int n = 32 * (wave & 1) + q;
    const float xi = exp2f(lg2 * (float)(n + 1));
    for (int g = 0; g < 8; ++g) {
        const int cq = 4 * g + (wave >> 1);
#if defined(PROBE_RETSEG)
        unsigned long long ts0 = __builtin_amdgcn_s_memtime();
#endif
        kv_dma(lds, 0, pb, hd, 0, lane, wave); kv_dma(lds, 16384, pb, hd, 64, lane, wave);
        LAS unsigned char* stg = lds + L_ST + wave * 4608;
        const unsigned grow0 = (unsigned)((256 * g + 32 * wave) * NP);
        const int srow = lane >> 3, sch = lane & 7;
#pragma unroll
        for (int i2 = 0; i2 < 4; ++i2)
            *(LAS f16x8*)(stg + (8 * i2 + srow) * 144 + 16 * sch) = *(const f16x8*)(pb + (grow0 + (unsigned)((8 * i2 + srow) * NP + C_RQ + 64 * hd + 8 * sch)));
        asm volatile("s_waitcnt lgkmcnt(0)" ::: "memory");
        f16x8 qf[4];
#pragma unroll
        for (int ks = 0; ks < 4; ++ks) qf[ks] = *(const LAS f16x8*)(stg + q * 144 + 32 * ks + 16 * h);
        asm volatile("" ::: "memory");
        f32x16 O[2];
#pragma unroll
        for (int dt = 0; dt < 2; ++dt)
#pragma unroll
            for (int r = 0; r < 16; ++r) O[dt][r] = 0.f;
        __syncthreads();
#if defined(PROBE_RETSEG)
        if (PROBE_RETSEG == 1) t_wait += __builtin_amdgcn_s_memtime() - ts0;
#endif
        const int nt = 4 * g + 4;
        int slot = 0;
        for (int kp = 0; kp < nt / 2; ++kp) {
            const int slotn = slot ^ 1;
            if (2 * kp + 2 < nt) { kv_dma(lds, slotn * 32768, pb, hd, 64 * (2 * kp + 2), lane, wave); kv_dma(lds, slotn * 32768 + 16384, pb, hd, 64 * (2 * kp + 3), lane, wave); }
#pragma unroll 1
            for (int sub = 0; sub < 2; ++sub) {
            const int kt = 2 * kp + sub;
            const LAS unsigned char* img0 = lds + L_KV + slot * 32768 + sub * 16384;
#ifdef PROBE_RETFAST
            const unsigned long long tf0 = __builtin_amdgcn_s_memtime();
#endif
            if (kt < cq) {
                const float tsc = xi * __builtin_amdgcn_exp2f(lg2 * 64.0f * (float)(cq - kt - 1));
                f32x16 S[2];
#pragma unroll
                for (int blk = 0; blk < 2; ++blk) {
#pragma unroll
                    for (int r2 = 0; r2 < 16; ++r2) S[blk][r2] = 0.f;
#pragma unroll
                    for (int ks = 0; ks < 4; ++ks) {
                        const f16x8 ka = *(const LAS f16x8*)(img0 + blk * 8192 + off_b(q, 2 * ks + h));
#ifdef PROBE_H1
                        { const f16x8 kd = *(const LAS f16x8*)(img0 + (blk ^ 1) * 8192 + off_b(q, 2 * ks + h)); asm volatile("" :: "v"(kd)); }
#endif
                        S[blk] = mfma32(ka, qf[ks], S[blk]);
                    }
                }
#pragma unroll
                for (int blk = 0; blk < 2; ++blk) {
                    const float f = tsc * (blk ? 1.0f : g32);
                    f16x8 pk[2];
#pragma unroll
                    for (int s2 = 0; s2 < 2; ++s2)
#pragma unroll
                        for (int j2 = 0; j2 < 8; ++j2) pk[s2][j2] = (_Float16)(S[blk][8 * s2 + j2] * (cf[8 * s2 + j2] * f));
#pragma unroll
                    for (int s2 = 0; s2 < 2; ++s2)
#pragma unroll
                        for (int dt = 0; dt < 2; ++dt) {
                            const int ct = 2 + dt;
                            const LAS unsigned char* img = img0 + blk * 8192;
                            const f16x4 v0 = vtr(img + off_b(16 * s2 + 4 * h + qq4, 4 * ct + 2 * b16 + (p4 >> 1)) + 8 * (p4 & 1));
                            const f16x4 v1 = vtr(img + off_b(16 * s2 + 8 + 4 * h + qq4, 4 * ct + 2 * b16 + (p4 >> 1)) + 8 * (p4 & 1));
                            const f16x8 va = (f16x8){v0[0], v0[1], v0[2], v0[3], v1[0], v1[1], v1[2], v1[3]};
#ifdef PROBE_H1
                            { const f16x4 d0 = vtr(img0 + (blk ^ 1) * 8192 + off_b(16 * s2 + 4 * h + qq4, 4 * ct + 2 * b16 + (p4 >> 1)) + 8 * (p4 & 1));
                              const f16x4 d1 = vtr(img0 + (blk ^ 1) * 8192 + off_b(16 * s2 + 8 + 4 * h + qq4, 4 * ct + 2 * b16 + (p4 >> 1)) + 8 * (p4 & 1)); asm volatile("" :: "v"(d0), "v"(d1)); }
#endif
#ifdef PROBE_H2
                            { f32x16 dmy = O[dt]; dmy = mfma32(va, pk[s2], dmy); asm volatile("" :: "v"(dmy)); }
#endif
                            O[dt] = mfma32(va, pk[s2], O[dt]);
                        }
                }
#ifdef PROBE_RETFAST
                asm volatile("s_nop 0" ::: "memory"); t_wait += __builtin_amdgcn_s_memtime() - tf0;
#endif
            } else if (kt == cq) {
#if defined(PROBE_RETSEG)
                ts0 = __builtin_amdgcn_s_memtime();
#endif
#pragma unroll 1
                for (int blk = 0; blk < 2; ++blk) {
                    const LAS unsigned char* img = img0 + blk * 8192;
                    f32x16 S;
#pragma unroll
                    for (int r2 = 0; r2 < 16; ++r2) S[r2] = 0.f;
#pragma unroll
                    for (int ks = 0; ks < 4; ++ks) {
                        const f16x8 ka = *(const LAS f16x8*)(img + off_b(q, 2 * ks + h));
                        S = mfma32(ka, qf[ks], S);
                    }
#pragma unroll
                    for (int r2 = 0; r2 < 16; ++r2) {
                        const int mk = 32 * blk + 4 * h + (r2 & 3) + 8 * (r2 >> 2);
                        S[r2] *= __builtin_amdgcn_exp2f(lg2 * fabsf((float)(n - mk)));
                    }
                    f16x8 pk[2];
#pragma unroll
                    for (int s2 = 0; s2 < 2; ++s2)
#pragma unroll
                        for (int j2 = 0; j2 < 8; ++j2) pk[s2][j2] = (_Float16)S[8 * s2 + j2];
#pragma unroll
                    for (int s2 = 0; s2 < 2; ++s2)
#pragma unroll
                        for (int dt = 0; dt < 2; ++dt) {
                            const int ct = 2 + dt;
                            const f16x4 v0 = vtr(img + off_b(16 * s2 + 4 * h + qq4, 4 * ct + 2 * b16 + (p4 >> 1)) + 8 * (p4 & 1));
                            const f16x4 v1 = vtr(img + off_b(16 * s2 + 8 + 4 * h + qq4, 4 * ct + 2 * b16 + (p4 >> 1)) + 8 * (p4 & 1));
                            const f16x8 va = (f16x8){v0[0], v0[1], v0[2], v0[3], v1[0], v1[1], v1[2], v1[3]};
                            O[dt] = mfma32(va, pk[s2], O[dt]);
                        }
                }
            }
#if defined(PROBE_RETSEG)
                if (PROBE_RETSEG == 2 && kt == cq) t_wait += __builtin_amdgcn_s_memtime() - ts0;
#endif
            }
            DSA_WAIT_BAR(0);
            slot ^= 1;
        }
#if defined(PROBE_RETSEG)
        ts0 = __builtin_amdgcn_s_memtime();
#endif
        float s1 = 0.f;
#pragma unroll
        for (int dt = 0; dt < 2; ++dt)
#pragma unroll
            for (int r = 0; r < 16; ++r) s1 += O[dt][r];
        s1 += xhalf(s1);
        const float mu = s1 * (1.0f / 64.0f);
        float s2v = 0.f;
#pragma unroll
        for (int dt = 0; dt < 2; ++dt)
#pragma unroll
            for (int r = 0; r < 16; ++r) { const float d = O[dt][r] - mu; s2v += d * d; }
        s2v += xhalf(s2v);
        const float rstd = rsqrtf(s2v * (1.0f / 64.0f) + EPS);
#pragma unroll
        for (int dt = 0; dt < 2; ++dt)
#pragma unroll
            for (int r4 = 0; r4 < 4; ++r4) {
                const int d0 = 32 * dt + 8 * r4 + 4 * h;
                f16x4 o4;
#pragma unroll
                for (int e = 0; e < 4; ++e) o4[e] = (_Float16)((O[dt][4 * r4 + e] - mu) * rstd);
                *(LAS f16x4*)(stg + q * 144 + 2 * d0) = o4;
            }
        asm volatile("s_waitcnt lgkmcnt(0)" ::: "memory");
        {
            const dsa::f32x4 rn0 = *(const dsa::f32x4*)(ret_norm + 64 * hd + 8 * sch), rn1 = *(const dsa::f32x4*)(ret_norm + 64 * hd + 8 * sch + 4);
#pragma unroll
            for (int i2 = 0; i2 < 4; ++i2) {
                const int row = 8 * i2 + srow;
                const f16x8 y = *(const LAS f16x8*)(stg + row * 144 + 16 * sch);
                const f16x8 gt = *(const f16x8*)(pb + (grow0 + (unsigned)(row * NP + C_RG + 64 * hd + 8 * sch)));
                f16x8 o8;
#pragma unroll
                for (int e = 0; e < 4; ++e) { o8[e] = (_Float16)((float)y[e] * rn0[e] * (float)gt[e]); o8[4 + e] = (_Float16)((float)y[4 + e] * rn1[e] * (float)gt[4 + e]); }
                *(f16x8*)(mix + ((size_t)b * SEQ + 256 * g + 32 * wave + row) * DM + 64 * hd + 8 * sch) = o8;
            }
        }
        asm volatile("s_waitcnt lgkmcnt(0)" ::: "memory");
#if defined(PROBE_RETSEG)
        if (PROBE_RETSEG == 3) { asm volatile("s_waitcnt vmcnt(0)" ::: "memory"); t_wait += __builtin_amdgcn_s_memtime() - ts0; }
#endif
    }
#if defined(PROBE_RETWAIT) || defined(PROBE_RETFAST) || defined(PROBE_RETSEG)
    if (blockIdx.x == 0 && wave == 7 && lane == 0) dbg[0] = 50.0f * (float)t_wait / (float)(__builtin_amdgcn_s_memtime() - t_begin);
#endif
}
}
namespace ret2 {
using dsa::f16x8; using dsa::f16x4; using dsa::f32x16; using dsa::off_b; using dsa::vtr; using dsa::mfma32; using dsa::xhalf;
using ret::L_KV; using ret::L_ST; using dsa::off_a;
__device__ __forceinline__ void kv_dma(LAS unsigned char* lds, int boff, const h16* pb, int hd, int key0, int lane, int wave) {
    const int row = 8 * (wave >> 1) + ((lane >> 2) & 7);
    const int ch = 4 * (2 * (wave & 1) + (lane >> 5)) + ((lane & 3) ^ ((row >> 2) & 3));
    const int col = (ch < 8 ? C_RK + 8 * ch : C_RV + 8 * (ch - 8)) + 64 * hd;
#pragma unroll
    for (int im = 0; im < 2; ++im) {
        const h16* src = pb + (size_t)(key0 + 32 * im + row) * NP + col;
        __builtin_amdgcn_global_load_lds((const unsigned*)src, (LAS unsigned*)(lds + L_KV + boff + im * 8192 + wave * 1024), 16, 0, 0);
    }
}
__device__ __forceinline__ void retention_unit(LAS unsigned char* lds, int b, int hd, const h16* __restrict__ proj, const float* __restrict__ ret_norm, h16* __restrict__ mix,
                                               int lane, int wave, int g0 = 0, int g1 = 4) {
    const int q = lane & 31, h = lane >> 5;
    const h16* pb = proj + (size_t)b * SEQ * NP;
    const float lg2 = log2f(1.0f - exp2f(-5.0f - (float)hd));
    const float g32 = exp2f(lg2 * 32.0f);
    float cf[16];
#pragma unroll
    for (int r = 0; r < 16; ++r) cf[r] = exp2f(lg2 * (float)(31 - 4 * h - ((r & 3) + 8 * (r >> 2))));
    const int qq4 = (lane & 15) >> 2, p4 = lane & 3, b16 = (lane >> 4) & 1;
    const unsigned rbase0 = off_a(q, h), rbase1 = off_a(q, 2 + h);
    const unsigned tbase0 = off_a(4 * h + qq4, 2 * b16 + (p4 >> 1)) + 8 * (p4 & 1), tbase1 = off_a(8 + 4 * h + qq4, 2 * b16 + (p4 >> 1)) + 8 * (p4 & 1);
    const float xiA = exp2f(lg2 * (float)(q + 1));
    LAS unsigned char* stg = lds + L_ST + wave * 4608;
    const int srow = lane >> 3, sch = lane & 7;
    for (int g = g0; g < g1; ++g) {
        const int cq = 8 * g + wave;
        kv_dma(lds, 0, pb, hd, 0, lane, wave); kv_dma(lds, 16384, pb, hd, 64, lane, wave);
        const unsigned grow0 = (unsigned)((64 * cq) * NP);
        f16x8 qf[2][4];
#pragma unroll
        for (int X = 0; X < 2; ++X) {
#pragma unroll
            for (int i2 = 0; i2 < 4; ++i2)
                *(LAS f16x8*)(stg + (8 * i2 + srow) * 144 + 16 * sch) = *(const f16x8*)(pb + (grow0 + (unsigned)((32 * X + 8 * i2 + srow) * NP + C_RQ + 64 * hd + 8 * sch)));
            asm volatile("s_waitcnt lgkmcnt(0)" ::: "memory");
#pragma unroll
            for (int ks = 0; ks < 4; ++ks) qf[X][ks] = *(const LAS f16x8*)(stg + q * 144 + 32 * ks + 16 * h);
            asm volatile("s_waitcnt lgkmcnt(0)" ::: "memory");
            __builtin_amdgcn_sched_barrier(0);
        }
        f32x16 O[2][2];
#pragma unroll
        for (int X = 0; X < 2; ++X)
#pragma unroll
            for (int dt = 0; dt < 2; ++dt)
#pragma unroll
                for (int r = 0; r < 16; ++r) O[X][dt][r] = 0.f;
        __syncthreads();
        const int nt = 8 * g + 8;
        int slot = 0;
        for (int kp = 0; kp < nt / 2; ++kp) {
            const int slotn = slot ^ 1;
            if (2 * kp + 2 < nt) { kv_dma(lds, slotn * 32768, pb, hd, 64 * (2 * kp + 2), lane, wave); kv_dma(lds, slotn * 32768 + 16384, pb, hd, 64 * (2 * kp + 3), lane, wave); }
#pragma unroll 1
            for (int sub = 0; sub < 2; ++sub) {
                const int kt = 2 * kp + sub;
                if (kt > cq) continue;
                const bool own = (kt == cq);
                const float tsc = xiA * __builtin_amdgcn_exp2f(lg2 * 64.0f * (float)(own ? 0 : cq - kt - 1));
#pragma unroll 1
                for (int blk = 0; blk < 2; ++blk) {
                    const LAS unsigned char* img = lds + L_KV + slot * 32768 + sub * 16384 + blk * 8192;
#pragma unroll
                    for (int X = 0; X < 2; ++X) {
                        f32x16 S;
#pragma unroll
                        for (int r2 = 0; r2 < 16; ++r2) S[r2] = 0.f;
#pragma unroll
                        for (int ks = 0; ks < 4; ++ks) {
                            const f16x8 ka = *(const LAS f16x8*)(img + ((ks & 1) ? rbase1 : rbase0) + 512 * (ks >> 1));
                            S = mfma32(ka, qf[X][ks], S);
                        }
                        if (!own) {
                            const float f = tsc * (blk ? 1.0f : g32) * (X ? g32 : 1.0f);
#pragma unroll
                            for (int r2 = 0; r2 < 16; ++r2) S[r2] *= cf[r2] * f;
                        } else {
                            asm volatile("" ::: "memory");
#pragma unroll
                            for (int r2 = 0; r2 < 16; ++r2) {
                                const int mk = 32 * blk + 4 * h + (r2 & 3) + 8 * (r2 >> 2);
                                S[r2] *= __builtin_amdgcn_exp2f(lg2 * fabsf((float)(32 * X + q - mk)));
                            }
                        }
                        f16x8 pk[2];
#pragma unroll
                        for (int s2 = 0; s2 < 2; ++s2)
#pragma unroll
                            for (int j2 = 0; j2 < 8; ++j2) pk[s2][j2] = (_Float16)S[8 * s2 + j2];
#pragma unroll
                        for (int s2 = 0; s2 < 2; ++s2)
#pragma unroll
                            for (int dt = 0; dt < 2; ++dt) {
                                const int ct = 2 + dt;
                                const f16x4 v0 = vtr(img + tbase0 + 4096 * s2 + 512 * ct);
                                const f16x4 v1 = vtr(img + tbase1 + 4096 * s2 + 512 * ct);
                                const f16x8 va = (f16x8){v0[0], v0[1], v0[2], v0[3], v1[0], v1[1], v1[2], v1[3]};
                                O[X][dt] = mfma32(va, pk[s2], O[X][dt]);
                            }
                        __builtin_amdgcn_sched_barrier(0);
                    }
                }
            }
            DSA_WAIT_BAR(0);
            slot ^= 1;
        }
        const dsa::f32x4 rn0 = *(const dsa::f32x4*)(ret_norm + 64 * hd + 8 * sch), rn1 = *(const dsa::f32x4*)(ret_norm + 64 * hd + 8 * sch + 4);
#pragma unroll
        for (int X = 0; X < 2; ++X) {
            float s1 = 0.f;
#pragma unroll
            for (int dt = 0; dt < 2; ++dt)
#pragma unroll
                for (int r = 0; r < 16; ++r) s1 += O[X][dt][r];
            s1 += xhalf(s1);
            const float mu = s1 * (1.0f / 64.0f);
            float s2v = 0.f;
#pragma unroll
            for (int dt = 0; dt < 2; ++dt)
#pragma unroll
                for (int r = 0; r < 16; ++r) { const float d = O[X][dt][r] - mu; s2v += d * d; }
            s2v += xhalf(s2v);
            const float rstd = rsqrtf(s2v * (1.0f / 64.0f) + EPS);
#pragma unroll
            for (int dt = 0; dt < 2; ++dt)
#pragma unroll
                for (int r4 = 0; r4 < 4; ++r4) {
                    const int d0 = 32 * dt + 8 * r4 + 4 * h;
                    f16x4 o4;
#pragma unroll
                    for (int e = 0; e < 4; ++e) o4[e] = (_Float16)((O[X][dt][4 * r4 + e] - mu) * rstd);
                    *(LAS f16x4*)(stg + q * 144 + 2 * d0) = o4;
                }
            asm volatile("s_waitcnt lgkmcnt(0)" ::: "memory");
#pragma unroll
            for (int i2 = 0; i2 < 4; ++i2) {
                const int row = 32 * X + 8 * i2 + srow;
                const f16x8 y = *(const LAS f16x8*)(stg + (8 * i2 + srow) * 144 + 16 * sch);
                const f16x8 gt = *(const f16x8*)(pb + (grow0 + (unsigned)(row * NP + C_RG + 64 * hd + 8 * sch)));
                f16x8 o8;
#pragma unroll
                for (int e = 0; e < 4; ++e) { o8[e] = (_Float16)((float)y[e] * rn0[e] * (float)gt[e]); o8[4 + e] = (_Float16)((float)y[4 + e] * rn1[e] * (float)gt[4 + e]); }
                *(f16x8*)(mix + ((size_t)b * SEQ + 64 * cq + row) * DM + 64 * hd + 8 * sch) = o8;
            }
            asm volatile("s_waitcnt lgkmcnt(0)" ::: "memory");
            __builtin_amdgcn_sched_barrier(0);
        }
    }
}
}
__device__ __forceinline__ void final_norm(float* out, const h16* x2h, const float* ssq2, const float* g, int G, int bx, int lane, int wave, const float* dbgleak) {
    const int gw = bx * NWAVES + wave, NGW = G * NWAVES;
    f32x4 gg[4];
#pragma unroll
    for (int j = 0; j < 4; ++j) gg[j] = ((const f32x4*)g)[2 * lane + 128 * (j >> 1) + (j & 1)];
    for (int row0 = 4 * gw; row0 < MTOK; row0 += 4 * NGW) {
        h16x8 v[4][2]; float rs[4];
#pragma unroll
        for (int rr = 0; rr < 4; ++rr) {
            const h16x8* xr = (const h16x8*)(x2h + (size_t)(row0 + rr) * DM);
            v[rr][0] = xr[lane]; v[rr][1] = xr[lane + 64]; rs[rr] = ssq2[row0 + rr];
        }
#pragma unroll
        for (int rr = 0; rr < 4; ++rr) {
            const int row = row0 + rr;
            const float rstd = rsqrtf(rs[rr] * (1.0f / DM) + EPS);
            f32x4* orow = (f32x4*)(out + (size_t)row * DM);
#pragma unroll
            for (int k = 0; k < 2; ++k) {
                f32x4 o0, o1;
#pragma unroll
                for (int e2 = 0; e2 < 4; ++e2) { o0[e2] = (float)v[rr][k][e2] * gg[2 * k][e2] * rstd; o1[e2] = (float)v[rr][k][4 + e2] * gg[2 * k + 1][e2] * rstd; }
#ifdef PROBE_LEAK
                if (row == 0 && lane == 0 && k == 0) o0[0] += dbgleak[0];
#endif
                orow[2 * lane + 128 * k] = o0; orow[2 * lane + 128 * k + 1] = o1;
            }
        }
    }
}

#ifndef EN_P0
#define EN_P0 1
#endif
#ifndef EN_P1
#define EN_P1 1
#endif
#ifndef EN_P1B
#define EN_P1B 1
#endif
#ifndef EN_RET
#define EN_RET 1
#endif
#ifndef EN_DSA
#define EN_DSA 1
#endif
#ifndef EN_P3A
#define EN_P3A 1
#endif
#ifndef EN_P3B
#define EN_P3B 1
#endif
#ifndef EN_P4
#define EN_P4 1
#endif
#ifndef EN_P5
#define EN_P5 1
#endif
#ifndef REP_P0
#define REP_P0 1
#endif
#ifndef REP_P1
#define REP_P1 1
#endif
#ifndef REP_RET
#define REP_RET 1
#endif
#ifndef REP_SEL
#define REP_SEL 1
#endif
#ifndef REP_ATT
#define REP_ATT 1
#endif
#if defined(PROBE_BAR)
#define XBAR(i) do { unsigned long long tb1_ = 0; if ((i) == PROBE_BAR) tb1_ = __builtin_amdgcn_s_memrealtime(); xcd_barrier(bar); \
        if ((i) == PROBE_BAR && threadIdx.x == 0) ((float*)(ws + WS_CTL) + 140100)[bx] = (float)(__builtin_amdgcn_s_memrealtime() - tb1_) * 0.001f; } while (0)
#else
#define XBAR(i) xcd_barrier(bar)
#endif
__global__ void __launch_bounds__(NTHR, 2) mega_fwd(Args a) {
    extern __shared__ __attribute__((aligned(16))) unsigned char lds_raw[];
    LAS unsigned char* lds = (LAS unsigned char*)lds_raw;
    volatile LAS unsigned* MISC = (volatile LAS unsigned*)(lds + MISC_OFF);
    const int wave = __builtin_amdgcn_readfirstlane((int)threadIdx.x >> 6);
    const int G = gridDim.x, bx = blockIdx.x;
#define PHASE_IDS() unsigned lz_ = 0u; asm volatile("" : "+v"(lz_)); int lane = (int)__builtin_amdgcn_mbcnt_hi(~0u, __builtin_amdgcn_mbcnt_lo(~0u, lz_)); asm volatile("" : "+v"(lane)); const int tid = wave * 64 + lane; (void)tid
    { PHASE_IDS();
    for (int u = tid; u < (LDS_BYTES - LDSCTL_OFF) / 4; u += NTHR) ((LAS unsigned*)(lds + LDSCTL_OFF))[u] = 0u; }
    __syncthreads();
    unsigned char* ws = a.ws;
    unsigned* ctl = (unsigned*)(ws + WS_CTL);
    float* ssq1 = (float*)(ws + WS_CTL); float* ssq2 = ssq1 + MTOK;
    const float2* tab = (const float2*)(ws + WS_TAB);
    h16* WinT = (h16*)(ws + WS_WIN); h16* WoutT = (h16*)(ws + WS_WOUT); h16* WgT = (h16*)(ws + WS_WG); h16* WpT = (h16*)(ws + WS_WP);
    h16* A0 = (h16*)(ws + WS_A0); h16* P16 = (h16*)(ws + WS_P16); h16* proj = (h16*)(ws + WS_PROJ); h16* mix = (h16*)(ws + WS_MIX); h16* pp = (h16*)(ws + WS_PP);
    h16* x1h = proj;
    h16* x2h = proj + (size_t)MTOK * DM;
    const float* rnorm = (const float*)(ws + WS_CTL) + 3 * MTOK;
    XcdBarrier bar = xcd_barrier_post(ctl + CW_BAR, MISC + 8);

#if EN_P0
    for (int rep = 0; rep < REP_P0; ++rep) { PHASE_IDS(); p0_prologue(a, lds, G, bx, tid, lane, wave); __syncthreads(); }
#endif
    XBAR(0);

#if EN_P1
    for (int rep = 0; rep < REP_P1; ++rep) {
        pg8::Gemm g{(const pg8::bf16_t*)A0, (const pg8::bf16_t*)WinT, MTOK, NP, DM, true};
#if defined(PROBE_GEMMWAIT) && !defined(PROBE_G4)
        g.dbg = (float*)(ws + WS_CTL) + 140000;
#endif
        pg8::StaticOrder S; S.init(MTOK, NP, G, bx);
        pg8::EpiProj E{proj, tab, a.kv_norm, (PG8_LAS float*)(lds + L_CKVSS)};
#ifdef STAGGER
        { const int k_ = (bx >> 3) & 3; for (int i_ = 0; i_ < k_ * STAGGER; ++i_) __builtin_amdgcn_s_sleep(127); }
#endif
#if defined(PROBE_CLK) && PROBE_CLK == 1
        const unsigned long long ck0 = __builtin_amdgcn_s_memtime(), cr0 = __builtin_amdgcn_s_memrealtime();
#endif
        pg8::gemm_phase<pg8::EpiProj, pg8::StaticOrder, true, true>(lds, g, S, E, wave);
#if defined(PROBE_CLK) && PROBE_CLK == 1
        if (bx == 0 && threadIdx.x == 0) { const unsigned long long ck1 = __builtin_amdgcn_s_memtime(), cr1 = __builtin_amdgcn_s_memrealtime(); ((float*)(ws + WS_CTL) + 140000)[0] = 10.0f * 0.1f * (float)(ck1 - ck0) / (float)(cr1 - cr0); }
#endif
    }
#endif
    XBAR(1);

#if EN_P1B && !FUSE_CKV
    { PHASE_IDS(); fix_ckv(proj, a.kv_norm, G, bx, lane, wave); }
    XBAR(2);
#endif
#if defined(PROBE_P2IDLE) || defined(PROBE_P2STAT)
    const unsigned long long p2_t0 = __builtin_amdgcn_s_memtime();
#endif

#if EN_RET && !RET_DYN
    for (int rep = 0; rep < REP_RET; ++rep) { PHASE_IDS(); for (int u = bx; u < BATCH * 8; u += G) ret2::retention_unit(lds, u >> 3, u & 7, proj, a.ret_norm, mix, lane, wave); }
#endif
#if EN_DSA && DYN_TAIL
    {
    constexpr int NS = DYN_NS, NB_T = BATCH - 4 * NS, NQ = NB_T * 64;
    unsigned* maskg = (unsigned*)(ws + WS_MASK);
    int tb = 0, tqb = 0;
    for (int step = 0;; ++step) {
        int mode, b, qb;
        if (step < 2 * NS) { const int j = step < NS ? step : step - NS, qq_ = ((bx & 63) + 16 * (j >> 1)) & 63; mode = step < NS ? 0 : 1; b = (bx >> 6) + 4 * j; qb = (j & 1) ? 63 - qq_ : qq_; }
        else if (((step - 2 * NS) & 1) == 0) {
            if (threadIdx.x == 0) MISC[12] = __hip_atomic_fetch_add(ctl + CW_QUEUE, 1u, __ATOMIC_RELAXED, __HIP_MEMORY_SCOPE_AGENT);
            __syncthreads(); const unsigned kq = MISC[12]; __syncthreads();
            if (kq >= (unsigned)NQ) break;
            tb = 4 * NS + (int)(kq % (unsigned)NB_T); tqb = 63 - (int)(kq / (unsigned)NB_T); mode = 0; b = tb; qb = tqb;
        } else { mode = 1; b = tb; qb = tqb; }
        if (mode == 0) { if (qb >= 8) { PHASE_IDS(); dsa::dsa_select_unit(lds, b, qb, proj, (float*)(ws + WS_SCR) + (size_t)bx * (32 * 2048), maskg, tid, lane, wave); } __syncthreads(); }
        else { PHASE_IDS(); dsa::dsa_attn_unit(lds, b, qb, proj, maskg, (const h16*)(ws + WS_WUK), (const h16*)(ws + WS_WUV), mix, tid, lane, wave, (float*)(ws + WS_CTL) + 140000); }
    }
    }
#elif EN_DSA
    for (int rep = 0; rep < REP_SEL; ++rep) { PHASE_IDS();
    unsigned* maskg = (unsigned*)(ws + WS_MASK);
    for (int j = 0; j < 8; ++j) {
        const int b = (bx >> 6) + 4 * j, qq_ = ((bx & 63) + 16 * (j >> 1)) & 63, qb = (j & 1) ? 63 - qq_ : qq_;
        if (qb >= 8) dsa::dsa_select_unit(lds, b, qb, proj, (float*)(ws + WS_SCR) + (size_t)bx * (32 * 2048), maskg, tid, lane, wave);
    } }
    __syncthreads();
    for (int rep = 0; rep < REP_ATT; ++rep) { PHASE_IDS();
#if defined(PROBE_ATTLOOP) || defined(PROBE_ATTWAIT) || defined(PROBE_ATTSEG)
    const unsigned long long t_att0 = __builtin_amdgcn_s_memtime();
#endif
    const unsigned* maskg = (const unsigned*)(ws + WS_MASK);
    for (int j = 0; j < 8; ++j) {
        const int b = (bx >> 6) + 4 * j, qq_ = ((bx & 63) + 16 * (j >> 1)) & 63, qb = (j & 1) ? 63 - qq_ : qq_;
        dsa::dsa_attn_unit(lds, b, qb, proj, maskg, (const h16*)(ws + WS_WUK), (const h16*)(ws + WS_WUV), mix, tid, lane, wave, (float*)(ws + WS_CTL) + 140000);
    }
#if defined(PROBE_ATTLOOP) || defined(PROBE_ATTSEG)
    if (bx == 0 && wave == 0 && lane == 0) { float* dbg = (float*)(ws + WS_CTL) + 140000; dbg[0] = 50.0f * dbg[1] / (float)(__builtin_amdgcn_s_memtime() - t_att0); }
#endif
#ifdef PROBE_ATTWAIT
    if (bx == 0 && wave == PROBE_ATTWAIT - 1 && lane == 0) { float* dbg = (float*)(ws + WS_CTL) + 140000; dbg[0] = 50.0f * dbg[2] / (float)(__builtin_amdgcn_s_memtime() - t_att0); }
#endif
    }
#endif
#if EN_RET && RET_DYN
    {
        __syncthreads();
        unsigned nx = 0u;
        if (threadIdx.x == 0) MISC[12] = __hip_atomic_fetch_add(ctl + CW_QUEUE, 1u, __ATOMIC_RELAXED, __HIP_MEMORY_SCOPE_AGENT);
        __syncthreads();
        unsigned kq = MISC[12];
        while (kq < 1024u + (P16_TAIL ? 1024u : 0u)) {
            if (threadIdx.x == 0) nx = __hip_atomic_fetch_add(ctl + CW_QUEUE, 1u, __ATOMIC_RELAXED, __HIP_MEMORY_SCOPE_AGENT);
            if (kq < 1024u) { PHASE_IDS(); const int g = 3 - (int)(kq >> 8), u = (int)(kq & 255u); ret2::retention_unit(lds, u >> 3, u & 7, proj, a.ret_norm, mix, lane, wave, g, g + 1); }
#if P16_TAIL
            else {
                PHASE_IDS();
                const size_t base = (size_t)(kq - 1024u) * 4096 + tid;
                f32x4 v[8];
#pragma unroll
                for (int u2 = 0; u2 < 8; ++u2) v[u2] = ((const f32x4*)a.p)[base + (size_t)u2 * NTHR];
#pragma unroll
                for (int u2 = 0; u2 < 8; ++u2) { h16x4 o; o[0] = (h16)v[u2][0]; o[1] = (h16)v[u2][1]; o[2] = (h16)v[u2][2]; o[3] = (h16)v[u2][3]; ((h16x4*)P16)[base + (size_t)u2 * NTHR] = o; }
            }
#endif
            __syncthreads();
            if (threadIdx.x == 0) MISC[12] = nx;
            __syncthreads();
            kq = MISC[12];
        }
    }
#endif
#if defined(PROBE_P2IDLE) || defined(PROBE_P2STAT)
    const unsigned long long p2_t1 = __builtin_amdgcn_s_memtime();
#endif
    XBAR(3);
#if defined(PROBE_P2IDLE)
    if (bx == PROBE_P2IDLE - 1 && threadIdx.x == 0) { const unsigned long long p2_t2 = __builtin_amdgcn_s_memtime(); ((float*)(ws + WS_CTL) + 140000)[0] = 50.0f * (float)(p2_t2 - p2_t1) / (float)(p2_t2 - p2_t0); }
#endif
#if defined(PROBE_P2STAT)
    if (threadIdx.x == 0) { const unsigned long long p2_t2 = __builtin_amdgcn_s_memtime(); ((float*)(ws + WS_CTL) + 140100)[bx] = 50.0f * (float)(p2_t2 - p2_t1) / (float)(p2_t2 - p2_t0); }
#endif

#if EN_P3A
    {
        pg8::Gemm g{(const pg8::bf16_t*)mix, (const pg8::bf16_t*)WoutT, MTOK, DM, DM, false}; pg8::StaticOrder S; S.init(MTOK, DM, G, bx);
        pg8::EpiOut E{A0, rnorm, a.norm_mix, x1h, ssq1};
        pg8::gemm_phase<pg8::EpiOut, pg8::StaticOrder, true, true>(lds, g, S, E, wave);
    }
#endif
    __syncthreads();
#if EN_P3B
    {
        int kp = PLE; asm volatile("" : "+s"(kp));
        pg8::Gemm g{(const pg8::bf16_t*)P16, (const pg8::bf16_t*)WpT, MTOK, DM, kp, false}; pg8::StaticOrder S; S.init(MTOK, DM, G, bx);
        pg8::EpiPle E{pp};
        pg8::gemm_phase<pg8::EpiPle, pg8::StaticOrder, true, true>(lds, g, S, E, wave);
    }
#endif
    XBAR(4);

#if EN_P4
    {
        pg8::Gemm g{(const pg8::bf16_t*)x1h, (const pg8::bf16_t*)WgT, MTOK, DM, DM, false};
#if defined(PROBE_GEMMWAIT) && defined(PROBE_G4)
        g.dbg = (float*)(ws + WS_CTL) + 140000;
#endif
        pg8::StaticOrder S; S.init(MTOK, DM, G, bx);
        pg8::EpiGate E{x1h, pp, ssq1, x2h, ssq2};
        pg8::gemm_phase<pg8::EpiGate, pg8::StaticOrder, true, true>(lds, g, S, E, wave);
    }
#endif
    XBAR(5);

#if EN_P5
#if defined(PROBE_P2STAT) || defined(PROBE_BAR)
#ifndef PROBE_P2STAT
#define PROBE_P2STAT 1
#endif
    if (threadIdx.x == 0) { const float* st_ = (const float*)(ws + WS_CTL) + 140100; float mn = 1e9f, mx = -1e9f, sm = 0.f; for (int i = 0; i < 256; ++i) { const float v = st_[i]; mn = fminf(mn, v); mx = fmaxf(mx, v); sm += v; }
        ((float*)(ws + WS_CTL) + 140000)[0] = PROBE_P2STAT == 1 ? sm * (1.0f / 256.0f) : (PROBE_P2STAT == 2 ? mx : mn); }
    asm volatile("s_waitcnt vmcnt(0)" ::: "memory"); __syncthreads();
#endif
    { PHASE_IDS(); final_norm(a.out, x2h, ssq2, a.norm_final, G, bx, lane, wave, (const float*)(ws + WS_CTL) + 140000); }
#endif
}

extern "C" void kernel_launch(void* const* d_in, const int* in_sizes, int n_in, void* d_out, int out_size, void* d_ws, size_t ws_size, hipStream_t stream) {
    static int grid = 0;
    if (grid == 0) {
        if (n_in != 14 || ws_size < WS_END) { fprintf(stderr, "kernel_launch: unexpected inputs (n_in %d, ws %zu)\n", n_in, ws_size); grid = -1; return; }
        int dev = 0, cus = 0;
        if (hipGetDevice(&dev) != hipSuccess || hipDeviceGetAttribute(&cus, hipDeviceAttributeMultiprocessorCount, dev) != hipSuccess) { grid = -1; return; }
        if (hipFuncSetAttribute((const void*)mega_fwd, hipFuncAttributeMaxDynamicSharedMemorySize, LDS_BYTES) != hipSuccess) { fprintf(stderr, "kernel_launch: hipFuncSetAttribute failed\n"); grid = -1; return; }
        int nb = 0;
        if (hipOccupancyMaxActiveBlocksPerMultiprocessor(&nb, (const void*)mega_fwd, NTHR, LDS_BYTES) != hipSuccess || nb < 1) { fprintf(stderr, "kernel_launch: occupancy query failed (%d blocks per CU)\n", nb); grid = -1; return; }
        if (cus != 256) { fprintf(stderr, "kernel_launch: the mixer unit deal is written for 256 CUs (found %d)\n", cus); grid = -1; return; }
        grid = cus;
    }
    if (grid < 0) return;
    if (hipMemsetAsync((char*)d_ws + WS_CTL, 0, CTL_BYTES, stream) != hipSuccess) return;
    Args a{};
    a.x = (const float*)d_in[0]; a.p = (const float*)d_in[1]; a.pos = (const int*)d_in[2]; a.norm_mix = (const float*)d_in[3]; a.w_in = (const float*)d_in[4];
    a.ret_norm = (const float*)d_in[5]; a.kv_norm = (const float*)d_in[6]; a.w_uk = (const float*)d_in[7]; a.w_uv = (const float*)d_in[8]; a.w_out = (const float*)d_in[9];
    a.norm_ple = (const float*)d_in[10]; a.w_ple_gate = (const float*)d_in[11]; a.w_ple_proj = (const float*)d_in[12]; a.norm_final = (const float*)d_in[13];
    a.out = (float*)d_out; a.ws = (unsigned char*)d_ws;
    hipLaunchKernelGGL(mega_fwd, dim3(grid), dim3(NTHR), LDS_BYTES, stream, a);
}
```

```cpp
#include <hip/hip_runtime.h>
#ifndef FUSE_CKV
#define FUSE_CKV 1
#endif
#ifndef RET_DYN
#define RET_DYN 1
#endif
#ifndef P16_TAIL
#define P16_TAIL 1
#endif
#ifndef DYN_NS
#define DYN_NS 4
#endif
#ifndef DYN_TAIL
#define DYN_TAIL 0
#endif
#include <cstdio>
#include <cstdint>

typedef _Float16 h16;
typedef h16 h16x8 __attribute__((ext_vector_type(8)));
typedef h16 h16x4 __attribute__((ext_vector_type(4)));
typedef h16 h16x2 __attribute__((ext_vector_type(2)));

constexpr int BATCH = 32, SEQ = 2048, DM = 1024, MTOK = BATCH * SEQ;
constexpr int NP = 3584;
constexpr int PLE = 256;
constexpr float EPS = 1e-6f;
constexpr int C_RQ = 0, C_RK = 512, C_RV = 1024, C_RG = 1536, C_QPE = 2048, C_QN = 2176, C_CKV = 2560, C_KPE = 2688, C_KI = 2704, C_IW = 2736,
              C_DG = 2752, C_IQ = 3264, C_END = 3520;
constexpr int NFREQ = 44;

constexpr size_t MiB = 1u << 20;
constexpr size_t WS_CTL = 0;
constexpr size_t CTL_BYTES = 1 * MiB;
constexpr size_t WS_TAB = 1 * MiB;
constexpr size_t WS_WIN = 2 * MiB;
constexpr size_t WS_WOUT = 10 * MiB;
constexpr size_t WS_WG = 12 * MiB;
constexpr size_t WS_WP = 14 * MiB;
constexpr size_t WS_A0 = 16 * MiB;
constexpr size_t WS_P16 = 144 * MiB;
constexpr size_t WS_PROJ = 176 * MiB;
constexpr size_t WS_MIX = 624 * MiB;
constexpr size_t WS_PP = 752 * MiB;
constexpr size_t WS_SCR = 880 * MiB;
constexpr size_t WS_WUK = 944 * MiB;
constexpr size_t WS_WUV = 945 * MiB;
constexpr size_t WS_MASK = 946 * MiB;
constexpr size_t WS_END = 962 * MiB;
constexpr int CW_BAR = 131072;
constexpr int CW_QUEUE = 139008;

__host__ __device__ inline int orig_col(int n) {
    if (n < 1024) { int h = (n & 511) >> 6, j = n & 63, i = j >> 1, b = j & 1; return (n & 512) + 64 * h + i + 32 * b; }
    if (n < 2048) return n;
    if (n < 2176) { int j = n - 2048, h = j >> 4, jj = j & 15, i = jj >> 1, b = jj & 1; return 2048 + 64 * h + i + 8 * b; }
    if (n < 2560) { int j = n - 2176, h = j / 48, jj = j % 48; return 2048 + 64 * h + 16 + jj; }
    if (n < 2688) { int p = n - 2560, g = (p >> 2) & 3; if (g == 1) p += 4; else if (g == 2) p -= 4; return 2560 + p; }
    if (n < 2704) { int j = n - 2688, i = j >> 1, b = j & 1; return 2688 + i + 8 * b; }
    if (n < 2736) { int j = n - 2704; if (j < 8) { int i = j >> 1, b = j & 1; return 3472 + i + 4 * b; } return 3472 + j; }
    if (n < 2744) return 3504 + (n - 2736);
    if (n < 2752) return -1;
    if (n < 3264) return 2704 + (n - 2752);
    if (n < 3520) { int j = n - 3264, h = j >> 5, jj = j & 31; if (jj < 8) { int i = jj >> 1, b = jj & 1; return 3216 + 32 * h + i + 4 * b; } return 3216 + 32 * h + jj; }
    return -1;
}
__host__ __device__ inline float col_scale(int n) {
    if (n < 512) return 0.125f;
    if (n >= 2048 && n < 2560) return 0.125f * 1.4426950408889634f;
    if (n >= 2736 && n < 2744) return 0.0625f;
    return 1.0f;
}
__device__ __forceinline__ int freq_idx(int n) {
    if (n < 1024) return (n & 63) >> 1;
    if (n >= 2048 && n < 2176) return 32 + ((n & 15) >> 1);
    if (n >= 2688 && n < 2704) return 32 + ((n - 2688) >> 1);
    if (n >= 2704 && n < 2712) return 40 + ((n - 2704) >> 1);
    if (n >= 3264 && n < 3520) { int jj = (n - 3264) & 31; if (jj < 8) return 40 + (jj >> 1); }
    return -1;
}
__device__ __forceinline__ float silu_f(float v) { return v * __builtin_amdgcn_rcpf(1.0f + __builtin_amdgcn_exp2f(-1.4426950408889634f * v)); }
__device__ __forceinline__ float sigmoid_f(float v) { return __builtin_amdgcn_rcpf(1.0f + __builtin_amdgcn_exp2f(-1.4426950408889634f * v)); }
__device__ __forceinline__ float wave_sum(float v) {
#pragma unroll
    for (int o = 1; o < 64; o <<= 1) v += __shfl_xor(v, o);
    return v;
}
__host__ __device__ __forceinline__ size_t tix(int row, int col, int K) { return ((size_t)(row >> 7) * (K >> 6) + (col >> 6)) * 8192 + (size_t)((row & 127) * 64 + (col & 63)); }
#define LAS __attribute__((address_space(3)))
#define GAS __attribute__((address_space(1)))

namespace pg8 {
#define PG8_LAS __attribute__((address_space(3)))
typedef unsigned short bf16_t;
typedef _Float16 bf16x8 __attribute__((ext_vector_type(8)));
typedef float f32x4 __attribute__((ext_vector_type(4)));
typedef unsigned u32x4 __attribute__((ext_vector_type(4)));
constexpr int BM = 256, BK = 64, HALF = 128, HTB = HALF * BK * 2  , STAGE_BYTES = 8 * HTB, NXCD = 8, WGM = 4;

__host__ __device__ __forceinline__ int lds_byte(int r, int c) { const int st = (r >> 4) * 2 + (c >> 5), rr = r & 15, cc = c & 31, ob = rr * 64 + cc * 2; return st * 1024 + (ob ^ (((ob >> 9) & 1) << 5)); }
__host__ __device__ __forceinline__ void stage_rc(int b, int& R, int& C) { const int st = b / 1024, sb = b % 1024, swz = sb ^ (((sb >> 9) & 1) << 5); R = (st >> 1) * 16 + swz / 64; C = (st & 1) * 32 + (swz % 64) / 2; }
__host__ __device__ __forceinline__ int perm32(int rho) { const int n = rho >> 4, i = rho & 15; return 8 * (i >> 2) + 4 * n + (i & 3); }

struct Unit { int pm, pn; };
struct Gemm { const bf16_t* A; const bf16_t* Bt; int M, N, K; bool tiledA; float* dbg = nullptr; };

struct StaticOrder {
    int nM, nN, nwg, G, c;
    __host__ __device__ void init(int M, int N, int G_, int c_) { nM = M / BM; nN = N / BM; nwg = nM * nN; G = G_; c = c_; }
    __host__ __device__ bool next(int i, Unit& u) const {
        const long L = (long)i * G + c; if (L >= nwg) return false;
        int wgid = (int)L; { const int q = nwg / NXCD, r = nwg % NXCD, xcd = wgid % NXCD, off = wgid / NXCD; wgid = (xcd < r ? xcd * (q + 1) : r * (q + 1) + (xcd - r) * q) + off; }
        const int nig = WGM * nN, gid = wgid / nig, fm = gid * WGM, gsz = (nM - fm) < WGM ? (nM - fm) : WGM;
        u.pm = fm + ((wgid % nig) % gsz); u.pn = (wgid % nig) / gsz; return true;
    }
    __device__ __forceinline__ void a_ready(const Unit&) const {}
    __device__ __forceinline__ void done(const Unit&) const {}
};

typedef short s16x8 __attribute__((ext_vector_type(8)));
template <bool BF> __device__ __forceinline__ f32x4 mma16(bf16x8 a, bf16x8 b, f32x4 c) {
    if constexpr (BF) return __builtin_amdgcn_mfma_f32_16x16x32_bf16(__builtin_bit_cast(s16x8, a), __builtin_bit_cast(s16x8, b), c, 0, 0, 0);
    else return __builtin_amdgcn_mfma_f32_16x16x32_f16(a, b, c, 0, 0, 0);
}
__device__ __forceinline__ unsigned short f2bf(float f) { const unsigned u = __builtin_bit_cast(unsigned, f); return (unsigned short)((u + 0x7fffu + ((u >> 16) & 1u)) >> 16); }
__device__ __forceinline__ float bf2f(unsigned short b) { return __builtin_bit_cast(float, (unsigned)b << 16); }
typedef unsigned short u16x8 __attribute__((ext_vector_type(8)));
__device__ __forceinline__ u16x8 pack8bf(const f32x4& a, const f32x4& b) {
    u16x8 o; o[0] = f2bf(a[0]); o[1] = f2bf(a[1]); o[2] = f2bf(a[2]); o[3] = f2bf(a[3]); o[4] = f2bf(b[0]); o[5] = f2bf(b[1]); o[6] = f2bf(b[2]); o[7] = f2bf(b[3]); return o;
}
__device__ __forceinline__ h16x8 pack8(const f32x4& a, const f32x4& b) {
    h16x8 o; o[0] = (h16)a[0]; o[1] = (h16)a[1]; o[2] = (h16)a[2]; o[3] = (h16)a[3]; o[4] = (h16)b[0]; o[5] = (h16)b[1]; o[6] = (h16)b[2]; o[7] = (h16)b[3]; return o;
}
struct EpiProj {
    static constexpr bool PERM = true, AFTER_DRAIN = false;
    h16* proj; const float2* tab; const float* kvn; PG8_LAS float* ssx;
    __device__ __forceinline__ void operator()(const f32x4 (&acc)[2][2][4][2], const Unit& u, int wr, int wc, int fr, int fq) const {
        const bool ck = (u.pn == C_CKV / BM);
        float rs[2][4]; f32x4 kw0 = (f32x4){1.f, 1.f, 1.f, 1.f}, kw1 = kw0;
#pragma unroll
        for (int ai = 0; ai < 2; ++ai)
#pragma unroll
            for (int m = 0; m < 4; ++m) rs[ai][m] = 1.f;
        if (ck) {
#pragma unroll
            for (int ai = 0; ai < 2; ++ai)
#pragma unroll
                for (int m = 0; m < 4; ++m) {
                    const f32x4 a = acc[ai][0][m][0], b = acc[ai][0][m][1];
                    float s_ = (a[0] * a[0] + a[1] * a[1]) + (a[2] * a[2] + a[3] * a[3]) + (b[0] * b[0] + b[1] * b[1]) + (b[2] * b[2] + b[3] * b[3]);
                    s_ += __shfl_xor(s_, 16); s_ += __shfl_xor(s_, 32);
                    if (fq == 0) ssx[(ai * HALF + wr * 64 + m * 16 + fr) * 4 + wc] = s_;
                }
            { int p0 = 32 * wc + 8 * fq, p1 = p0 + 4; if (fq & 1) p0 -= 4; else p1 += 4;
              kw0 = *(const f32x4*)(kvn + p0); kw1 = *(const f32x4*)(kvn + p1); }
            asm volatile("s_waitcnt lgkmcnt(0)" ::: "memory"); __builtin_amdgcn_s_barrier();
#pragma unroll
            for (int ai = 0; ai < 2; ++ai)
#pragma unroll
                for (int m = 0; m < 4; ++m) { const f32x4 t = *(const PG8_LAS f32x4*)(ssx + (ai * HALF + wr * 64 + m * 16 + fr) * 4); rs[ai][m] = rsqrtf(((t[0] + t[1]) + (t[2] + t[3])) * (1.0f / 128.0f) + EPS); }
        }
#pragma unroll
        for (int bj = 0; bj < 2; ++bj) {
            const int cb = u.pn * BM + bj * HALF + wc * 32;
            const int c0 = cb + 8 * fq;
            const bool rot = (cb < 1024) || (cb >= 2048 && cb < 2176) || (cb == 2688) || (cb >= 3264 && cb < 3520);
            const bool sil = (cb >= 1536 && cb < 2048) || (cb >= 2752 && cb < 3264);
            const int f0 = freq_idx(c0);
#pragma unroll
            for (int ai = 0; ai < 2; ++ai)
#pragma unroll
                for (int m = 0; m < 4; ++m) {
                    const int row = u.pm * BM + ai * HALF + wr * 64 + m * 16 + fr;
                    f32x4 a = acc[ai][bj][m][0], b = acc[ai][bj][m][1];
                    if (rot) {
                        f32x4 t0 = (f32x4){1.f, 0.f, 1.f, 0.f}, t1 = t0;
                        if (f0 >= 0) { const f32x4* tp = (const f32x4*)(tab + (size_t)(row & (SEQ - 1)) * NFREQ + f0); t0 = tp[0]; t1 = tp[1]; }
                        f32x4 ra, rb;
                        ra[0] = a[0] * t0[0] - a[1] * t0[1]; ra[1] = a[1] * t0[0] + a[0] * t0[1];
                        ra[2] = a[2] * t0[2] - a[3] * t0[3]; ra[3] = a[3] * t0[2] + a[2] * t0[3];
                        rb[0] = b[0] * t1[0] - b[1] * t1[1]; rb[1] = b[1] * t1[0] + b[0] * t1[1];
                        rb[2] = b[2] * t1[2] - b[3] * t1[3]; rb[3] = b[3] * t1[2] + b[2] * t1[3];
                        a = ra; b = rb;
                    } else if (sil) {
#pragma unroll
                        for (int e = 0; e < 4; ++e) { a[e] = silu_f(a[e]); b[e] = silu_f(b[e]); }
                    }
                    if (ck && bj == 0) { const float r_ = rs[ai][m];
#pragma unroll
                        for (int e = 0; e < 4; ++e) { a[e] *= r_ * kw0[e]; b[e] *= r_ * kw1[e]; } }
                    *(h16x8*)(proj + (size_t)row * NP + c0) = pack8(a, b);
                    if (m == 3) asm volatile("" ::: "memory");
                }
        }
    }
};
struct EpiOut {
    static constexpr bool PERM = true, AFTER_DRAIN = false;
    const h16* a0; const float* rnorm; const float* g; h16* x1h; float* ssq1;
    __device__ __forceinline__ void operator()(const f32x4 (&acc)[2][2][4][2], const Unit& u, int wr, int wc, int fr, int fq) const {
        f32x4 gi[2][2];
#pragma unroll
        for (int bj = 0; bj < 2; ++bj) {
            const int c0 = u.pn * BM + bj * HALF + wc * 32 + 8 * fq;
            const f32x4* gp = (const f32x4*)(g + c0);
#pragma unroll
            for (int n = 0; n < 2; ++n) { const f32x4 gv = gp[n]; gi[bj][n] = (f32x4){__builtin_amdgcn_rcpf(gv[0]), __builtin_amdgcn_rcpf(gv[1]), __builtin_amdgcn_rcpf(gv[2]), __builtin_amdgcn_rcpf(gv[3])}; }
        }
#pragma unroll
        for (int ai = 0; ai < 2; ++ai)
#pragma unroll
            for (int m = 0; m < 4; ++m) {
                const int row = u.pm * BM + ai * HALF + wr * 64 + m * 16 + fr; float ss = 0.f;
                const float rn = rnorm[row];
#pragma unroll
                for (int bj = 0; bj < 2; ++bj) {
                    const int c0 = u.pn * BM + bj * HALF + wc * 32 + 8 * fq;
                    const h16x8 xv = *(const h16x8*)(a0 + tix(row, c0, DM));
                    f32x4 a = acc[ai][bj][m][0], b = acc[ai][bj][m][1];
#pragma unroll
                    for (int e2 = 0; e2 < 4; ++e2) { a[e2] += (float)xv[e2] * rn * gi[bj][0][e2]; b[e2] += (float)xv[4 + e2] * rn * gi[bj][1][e2]; }
                    ss += (a[0] * a[0] + a[1] * a[1]) + (a[2] * a[2] + a[3] * a[3]) + (b[0] * b[0] + b[1] * b[1]) + (b[2] * b[2] + b[3] * b[3]);
                    *(h16x8*)(x1h + (size_t)row * DM + c0) = pack8(a, b);
                }
                ss += __shfl_xor(ss, 16); ss += __shfl_xor(ss, 32);
                if (fq == 0) atomicAdd(ssq1 + row, ss);
                if (m == 3) asm volatile("" ::: "memory");
            }
    }
};
struct EpiPle {
    static constexpr bool PERM = true, AFTER_DRAIN = false;
    h16* pp;
    __device__ __forceinline__ void operator()(const f32x4 (&acc)[2][2][4][2], const Unit& u, int wr, int wc, int fr, int fq) const {
#pragma unroll
        for (int ai = 0; ai < 2; ++ai)
#pragma unroll
            for (int m = 0; m < 4; ++m) {
                const int row = u.pm * BM + ai * HALF + wr * 64 + m * 16 + fr;
#pragma unroll
                for (int bj = 0; bj < 2; ++bj) {
                    const int c0 = u.pn * BM + bj * HALF + wc * 32 + 8 * fq;
                    *(h16x8*)(pp + (size_t)row * DM + c0) = pack8(acc[ai][bj][m][0], acc[ai][bj][m][1]);
                }
            }
    }
};
struct EpiGate {
    static constexpr bool PERM = true, AFTER_DRAIN = false;
    const h16* x1h; const h16* pp; const float* ssq1; h16* x2h; float* ssq2;
    __device__ __forceinline__ void operator()(const f32x4 (&acc)[2][2][4][2], const Unit& u, int wr, int wc, int fr, int fq) const {
#pragma unroll
        for (int ai = 0; ai < 2; ++ai)
#pragma unroll
            for (int m = 0; m < 4; ++m) {
                const int row = u.pm * BM + ai * HALF + wr * 64 + m * 16 + fr; float ss = 0.f;
                const float rstd = rsqrtf(ssq1[row] * (1.0f / DM) + EPS);
#pragma unroll
                for (int bj = 0; bj < 2; ++bj) {
                    const int c0 = u.pn * BM + bj * HALF + wc * 32 + 8 * fq;
                    const h16x8 xv = *(const h16x8*)(x1h + (size_t)row * DM + c0);
                    const h16x8 pv = *(const h16x8*)(pp + (size_t)row * DM + c0);
                    f32x4 a = acc[ai][bj][m][0], b = acc[ai][bj][m][1], ra, rb;
#pragma unroll
                    for (int e = 0; e < 4; ++e) {
                        ra[e] = (float)xv[e] + sigmoid_f(a[e] * rstd) * (float)pv[e];
                        rb[e] = (float)xv[4 + e] + sigmoid_f(b[e] * rstd) * (float)pv[4 + e];
                        ss += ra[e] * ra[e] + rb[e] * rb[e];
                    }
                    *(h16x8*)(x2h + (size_t)row * DM + c0) = pack8(ra, rb);
                }
                ss += __shfl_xor(ss, 16); ss += __shfl_xor(ss, 32);
                if (fq == 0) atomicAdd(ssq2 + row, ss);
                if (m == 3) asm volatile("" ::: "memory");
            }
    }
};
template <class Epi, class Sched, bool ALIGN_EPI = false, bool SP2 = false, bool BF = false>
__device__ __forceinline__ void gemm_phase(PG8_LAS unsigned char* lds, const Gemm g, const Sched& S, const Epi& E, int wave_in) {
    unsigned lz_ = 0u; asm volatile("" : "+v"(lz_)); int lane_o = (int)__builtin_amdgcn_mbcnt_hi(~0u, __builtin_amdgcn_mbcnt_lo(~0u, lz_)); asm volatile("" : "+v"(lane_o));
    const int wid = __builtin_amdgcn_readfirstlane(wave_in), lane = lane_o, tid = wid * 64 + lane, wr = wid >> 2, wc = wid & 3, fr = lane & 15, fq = lane >> 4;
    const int K = g.K, nt = K / BK;
    unsigned voffA[2], voffB[2];
#pragma unroll
    for (int i = 0; i < 2; ++i) { int R, C; stage_rc(tid * 16 + i * 8192, R, C); const int Rb = Epi::PERM ? ((R & ~31) + perm32(R & 31)) : R;
        voffA[i] = g.tiledA ? (unsigned)(R * BK + C) * 2u : (unsigned)(R * K + C) * 2u; voffB[i] = (unsigned)(Rb * K + C) * 2u; }
    const size_t kstep = (size_t)(BK * 2);
    const size_t kstepA = g.tiledA ? (size_t)(HALF * BK * 2) : kstep;
    const size_t hstep = (size_t)HALF * K * 2;
    const size_t tstep = 2 * hstep;
    const unsigned ldsw = (unsigned)wid * 1024u;
    const int aoff = lds_byte(wr * 64 + fr, fq * 8), boff = lds_byte(wc * 32 + fr, fq * 8);
#define PG8_SA(b, h) (((b) * 2 + (h)) * HTB)
#define PG8_SB(b, h) ((4 + (b) * 2 + (h)) * HTB)
#if defined(PROBE_GEMMWAIT) && PROBE_GEMMWAIT == 4
#define PG8_STAGE(bufoff, gbase, voff) do { const unsigned long long s0_ = __builtin_amdgcn_s_memtime(); _Pragma("unroll") for (int _i = 0; _i < 2; ++_i) \
        __builtin_amdgcn_global_load_lds((const unsigned*)((const char*)(gbase) + (voff)[_i]), (PG8_LAS unsigned*)(lds + (bufoff) + ldsw + _i * 8192), 16, 0, 0); pg_tm += __builtin_amdgcn_s_memtime() - s0_; } while (0)
#else
#define PG8_STAGE(bufoff, gbase, voff) do { _Pragma("unroll") for (int _i = 0; _i < 2; ++_i) \
        __builtin_amdgcn_global_load_lds((const unsigned*)((const char*)(gbase) + (voff)[_i]), (PG8_LAS unsigned*)(lds + (bufoff) + ldsw + _i * 8192), 16, 0, 0); } while (0)
#endif
#define PG8_LDA(dst, b, h) do { _Pragma("unroll") for (int m = 0; m < 4; ++m) _Pragma("unroll") for (int k = 0; k < 2; ++k) dst[m][k] = *(const PG8_LAS bf16x8*)(lds + PG8_SA(b, h) + aoff + m * 2048 + k * 1024); } while (0)
#define PG8_LDB(dst, b, h) do { _Pragma("unroll") for (int n = 0; n < 2; ++n) _Pragma("unroll") for (int k = 0; k < 2; ++k) dst[n][k] = *(const PG8_LAS bf16x8*)(lds + PG8_SB(b, h) + boff + n * 2048 + k * 1024); } while (0)
#define PG8_MMA(ai, bj, At, Bt) do { __builtin_amdgcn_s_setprio(1); _Pragma("unroll") for (int m = 0; m < 4; ++m) _Pragma("unroll") for (int n = 0; n < 2; ++n) _Pragma("unroll") for (int k = 0; k < 2; ++k) \
        acc[ai][bj][m][n] = mma16<BF>(Bt[n][k], At[m][k], acc[ai][bj][m][n]); __builtin_amdgcn_s_setprio(0); } while (0)
#define PG8_WAIT_V(n) asm volatile("s_waitcnt vmcnt(" #n ")" ::: "memory")
#define PG8_WAIT_L(n) asm volatile("s_waitcnt lgkmcnt(" #n ")" ::: "memory")
#define PG8_BAR __builtin_amdgcn_s_barrier()
#define PG8_SCHED __builtin_amdgcn_sched_barrier(0)
#if defined(PROBE_GEMMWAIT)
    unsigned long long pg_tw = 0, pg_tb = 0, pg_t0 = 0, pg_t1 = 0, pg_tm = 0; const unsigned long long pg_begin = __builtin_amdgcn_s_memtime();
#define PG8_TW0 pg_t0 = __builtin_amdgcn_s_memtime()
#define PG8_TW1 { const unsigned long long n_ = __builtin_amdgcn_s_memtime(); pg_tw += n_ - pg_t0; pg_t1 = n_; }
#if PROBE_GEMMWAIT >= 4
#define PG8_TB0 pg_t0 = __builtin_amdgcn_s_memtime()
#else
#define PG8_TB0 { pg_t0 = __builtin_amdgcn_s_memtime(); pg_tm += pg_t0 - pg_t1; }
#endif
#define PG8_TB1 pg_tb += __builtin_amdgcn_s_memtime() - pg_t0
#else
#define PG8_TW0
#define PG8_TW1
#define PG8_TB0
#define PG8_TB1
#endif
    Unit cur, nxt; int ui = 0;
    if (!S.next(0, cur)) return;
    f32x4 acc[2][2][4][2];
#pragma unroll
    for (int a = 0; a < 2; ++a)
#pragma unroll
        for (int b = 0; b < 2; ++b)
#pragma unroll
            for (int m = 0; m < 4; ++m)
#pragma unroll
                for (int n = 0; n < 2; ++n) acc[a][b][m][n] = (f32x4){0.f, 0.f, 0.f, 0.f};
    bf16x8 At[4][2], B0[2][2], B1[2][2];
    const char* cA = (const char*)g.A + (size_t)cur.pm * tstep; const char* cB = (const char*)g.Bt + (size_t)cur.pn * tstep;
    S.a_ready(cur);
    if constexpr (SP2) {
        PG8_STAGE(PG8_SB(0, 0), cB, voffB); PG8_STAGE(PG8_SB(0, 1), cB + hstep, voffB); PG8_STAGE(PG8_SA(0, 0), cA, voffA); PG8_STAGE(PG8_SA(0, 1), cA + hstep, voffA);
        if (wr == 1) PG8_BAR;
        PG8_WAIT_V(2); PG8_BAR;
        PG8_STAGE(PG8_SB(1, 0), cB + kstep, voffB); PG8_STAGE(PG8_SA(1, 0), cA + kstepA, voffA); PG8_STAGE(PG8_SB(1, 1), cB + hstep + kstep, voffB);
        PG8_WAIT_V(6); PG8_BAR;
    } else {
        PG8_STAGE(PG8_SB(0, 0), cB, voffB); PG8_STAGE(PG8_SA(0, 0), cA, voffA); PG8_STAGE(PG8_SB(0, 1), cB + hstep, voffB); PG8_STAGE(PG8_SA(0, 1), cA + hstep, voffA);
        if (wr == 1) PG8_BAR;
        PG8_WAIT_V(4); PG8_BAR;
        PG8_STAGE(PG8_SB(1, 0), cB + kstep, voffB); PG8_STAGE(PG8_SA(1, 0), cA + kstepA, voffA); PG8_STAGE(PG8_SB(1, 1), cB + hstep + kstep, voffB);
        PG8_WAIT_V(6); PG8_BAR;
    }
    for (;;) {
        const bool has_next = S.next(ui + 1, nxt);
        const char* nA = has_next ? (const char*)g.A + (size_t)nxt.pm * tstep : cA; const char* nB = has_next ? (const char*)g.Bt + (size_t)nxt.pn * tstep : cB;
        for (int t = 0; t < nt; t += 2) {
            const bool last = (t == nt - 2);
            const char* a1 = cA + (size_t)(t + 1) * kstepA;
            const char* a2 = last ? nA : cA + (size_t)(t + 2) * kstepA; const char* b2 = last ? nB : cB + (size_t)(t + 2) * kstep;
            const char* a3 = a2 + kstepA; const char* b3 = b2 + kstep;
            if (last && has_next) S.a_ready(nxt);
            if constexpr (SP2) {
            PG8_LDB(B0, 0, 0); PG8_LDB(B1, 0, 1); PG8_SCHED; PG8_LDA(At, 0, 0); PG8_STAGE(PG8_SA(1, 1), a1 + hstep, voffA);
            PG8_TW0; PG8_WAIT_V(8); PG8_WAIT_L(0); PG8_BAR; PG8_TW1; PG8_MMA(0, 0, At, B0); PG8_MMA(0, 1, At, B1); PG8_TB0; PG8_BAR; PG8_TB1; PG8_SCHED;
            PG8_LDA(At, 0, 1); PG8_STAGE(PG8_SB(0, 0), b2, voffB); PG8_STAGE(PG8_SB(0, 1), b2 + hstep, voffB); PG8_STAGE(PG8_SA(0, 0), a2, voffA);
            PG8_TW0; PG8_WAIT_V(8); PG8_WAIT_L(0); PG8_BAR; PG8_TW1; PG8_MMA(1, 0, At, B0); PG8_MMA(1, 1, At, B1); PG8_TB0; PG8_BAR; PG8_TB1; PG8_SCHED;
            PG8_LDB(B0, 1, 0); PG8_LDB(B1, 1, 1); PG8_SCHED; PG8_LDA(At, 1, 0); PG8_STAGE(PG8_SA(0, 1), a2 + hstep, voffA);
            PG8_TW0; PG8_WAIT_V(8); PG8_WAIT_L(0); PG8_BAR; PG8_TW1; PG8_MMA(0, 0, At, B0); PG8_MMA(0, 1, At, B1); PG8_TB0; PG8_BAR; PG8_TB1; PG8_SCHED;
            PG8_LDA(At, 1, 1); PG8_STAGE(PG8_SB(1, 0), b3, voffB); PG8_STAGE(PG8_SB(1, 1), b3 + hstep, voffB); PG8_STAGE(PG8_SA(1, 0), a3, voffA);
            PG8_TW0; PG8_WAIT_V(8); PG8_WAIT_L(0); PG8_BAR; PG8_TW1; PG8_MMA(1, 0, At, B0); PG8_MMA(1, 1, At, B1); PG8_TB0; PG8_BAR; PG8_TB1; PG8_SCHED;
            } else {
            PG8_LDB(B0, 0, 0); PG8_SCHED; PG8_LDA(At, 0, 0); PG8_STAGE(PG8_SA(1, 1), a1 + hstep, voffA);
            PG8_WAIT_L(8); PG8_BAR; PG8_WAIT_L(0); PG8_MMA(0, 0, At, B0); PG8_BAR; PG8_SCHED;
            PG8_LDB(B1, 0, 1); PG8_STAGE(PG8_SB(0, 0), b2, voffB);
            PG8_BAR; PG8_WAIT_L(0); PG8_MMA(0, 1, At, B1); PG8_BAR;
            PG8_LDA(At, 0, 1); PG8_STAGE(PG8_SA(0, 0), a2, voffA);
            PG8_BAR; PG8_WAIT_L(0); PG8_MMA(1, 0, At, B0); PG8_BAR; PG8_SCHED;
            PG8_STAGE(PG8_SB(0, 1), b2 + hstep, voffB);
            PG8_WAIT_V(6); PG8_BAR; PG8_MMA(1, 1, At, B1); PG8_BAR;
            PG8_LDB(B0, 1, 0); PG8_SCHED; PG8_LDA(At, 1, 0); PG8_STAGE(PG8_SA(0, 1), a2 + hstep, voffA);
            PG8_WAIT_L(8); PG8_BAR; PG8_WAIT_L(0); PG8_MMA(0, 0, At, B0); PG8_BAR; PG8_SCHED;
            PG8_LDB(B1, 1, 1); PG8_STAGE(PG8_SB(1, 0), b3, voffB);
            PG8_BAR; PG8_WAIT_L(0); PG8_MMA(0, 1, At, B1); PG8_BAR;
            PG8_LDA(At, 1, 1); PG8_STAGE(PG8_SA(1, 0), a3, voffA);
            PG8_BAR; PG8_WAIT_L(0); PG8_MMA(1, 0, At, B0); PG8_BAR; PG8_SCHED;
            PG8_STAGE(PG8_SB(1, 1), b3 + hstep, voffB);
            PG8_WAIT_V(6); PG8_BAR; PG8_MMA(1, 1, At, B1); PG8_BAR;
            }
        }
        if constexpr (ALIGN_EPI) { if (wr == 0) PG8_BAR; }
#if defined(PROBE_GEMMWAIT) && PROBE_GEMMWAIT == 5
        { const unsigned long long e0_ = __builtin_amdgcn_s_memtime(); if constexpr (!Epi::AFTER_DRAIN) { E(acc, cur, wr, wc, fr, fq); S.done(cur); } asm volatile("s_waitcnt vmcnt(0)" ::: "memory"); pg_tm += __builtin_amdgcn_s_memtime() - e0_; }
#elif defined(PROBE_GEMMWAIT) && PROBE_GEMMWAIT == 6
        { const unsigned long long e0_ = __builtin_amdgcn_s_memtime(); if constexpr (!Epi::AFTER_DRAIN) { E(acc, cur, wr, wc, fr, fq); S.done(cur); } asm volatile("" ::: "memory"); pg_tm += __builtin_amdgcn_s_memtime() - e0_; }
#else
        if constexpr (!Epi::AFTER_DRAIN) { E(acc, cur, wr, wc, fr, fq); S.done(cur); }
#endif
        if (!has_next) break;
#pragma unroll
        for (int a = 0; a < 2; ++a)
#pragma unroll
            for (int b = 0; b < 2; ++b)
#pragma unroll
                for (int m = 0; m < 4; ++m)
#pragma unroll
                    for (int n = 0; n < 2; ++n) acc[a][b][m][n] = (f32x4){0.f, 0.f, 0.f, 0.f};
        cur = nxt; cA = nA; cB = nB; ++ui;
        if constexpr (ALIGN_EPI) { if (wr == 1) PG8_BAR; }
    }
    PG8_WAIT_V(0);
    if constexpr (!ALIGN_EPI) { if (wr == 0) PG8_BAR; }
    PG8_BAR;
    if constexpr (Epi::AFTER_DRAIN) { E.fused(acc, cur, wr, wc, fr, fq, lds, wid, lane); S.done(cur); }
#if defined(PROBE_GEMMWAIT)
    if (blockIdx.x == 0 && wid == 0 && lane == 0 && g.dbg) { const float tot = (float)(__builtin_amdgcn_s_memtime() - pg_begin); g.dbg[0] = 50.0f * (float)(PROBE_GEMMWAIT == 1 ? pg_tw : (PROBE_GEMMWAIT == 2 ? pg_tb : pg_tm)) / tot; }
#endif
#undef PG8_TW0
#undef PG8_TW1
#undef PG8_TB0
#undef PG8_TB1
#undef PG8_SA
#undef PG8_SB
#undef PG8_STAGE
#undef PG8_LDA
#undef PG8_LDB
#undef PG8_MMA
#undef PG8_WAIT_V
#undef PG8_WAIT_L
#undef PG8_BAR
#undef PG8_SCHED
}
}
#define XB_TMO      128
#define XB_XCNT(j)  (256  + 64 * (j))
#define XB_XSUB(j)  (1280 + 64 * (j))
#define XB_XGEN(j)  (2304 + 64 * (j))
#define XB_TOP      3328
#define XB_TOPGEN   3392
#define XCD_BAR_WORDS 3456
#define XB_SPIN_CAP (1u << 18)

__device__ __forceinline__ unsigned xb_ld(unsigned* p)              { return __hip_atomic_load(p, __ATOMIC_RELAXED, __HIP_MEMORY_SCOPE_AGENT); }
__device__ __forceinline__ unsigned xb_add(unsigned* p, unsigned v) { return __hip_atomic_fetch_add(p, v, __ATOMIC_RELAXED, __HIP_MEMORY_SCOPE_AGENT); }
__device__ __forceinline__ unsigned xb_xcc_id() { return (unsigned)__builtin_amdgcn_s_getreg((3 << 11) | 20) & 0xFu; }
#define XB_SPIN(cond, bar) do { unsigned _sp = 0; while (cond) { __builtin_amdgcn_s_sleep(1); \
    if ((++_sp & 255u) == 0u) { if (xb_ld(&(bar)[XB_TMO])) break; if (_sp > XB_SPIN_CAP) { atomicAdd(&(bar)[XB_TMO], 1u); break; } } } } while (0)

struct XcdBarrier {
    unsigned* bar; unsigned x;
    volatile LAS unsigned* st;
};

__device__ __forceinline__ XcdBarrier xcd_barrier_post(unsigned* bar, volatile LAS unsigned* st) {
    XcdBarrier b; b.bar = bar; b.x = xb_xcc_id(); b.st = st;
    if (threadIdx.x == 0) (void)xb_add(&bar[XB_XCNT(b.x)], 1u);
    return b;
}
__device__ __forceinline__ void xcd_barrier_complete(unsigned* bar, unsigned x, unsigned& nloc, unsigned& nx) {
    const unsigned G = gridDim.x * gridDim.y * gridDim.z;
    unsigned sum, cnt, mine, sp = 0u;
    for (;;) {
        sum = 0u; cnt = 0u; mine = 0u;
#pragma unroll
        for (unsigned j = 0; j < 16; ++j) { const unsigned c = xb_ld(&bar[XB_XCNT(j)]); sum += c; cnt += (c > 0u) ? 1u : 0u; mine = (j == x) ? c : mine; }
        if (sum == G) break;
        __builtin_amdgcn_s_sleep(1);
        if ((++sp & 255u) == 0u) { if (xb_ld(&bar[XB_TMO])) break; if (sp > XB_SPIN_CAP) { atomicAdd(&bar[XB_TMO], 1u); break; } }
    }
    nloc = mine > 0u ? mine : 1u; nx = cnt > 0u ? cnt : 1u;
}

__device__ __forceinline__ void xcd_barrier(const XcdBarrier& b) {
    asm volatile("s_waitcnt vmcnt(0)" ::: "memory");
    __syncthreads();
    if (threadIdx.x == 0) {
        unsigned* bar = b.bar;
        __builtin_amdgcn_s_waitcnt(0);
        unsigned nloc = b.st[0], nx = b.st[1];
        if (nloc == 0u) { xcd_barrier_complete(bar, b.x, nloc, nx); b.st[0] = nloc; b.st[1] = nx; }
        const unsigned old = xb_add(&bar[XB_XSUB(b.x)], 1u);
        const unsigned gen = old / nloc;
        if (old + 1u == (gen + 1u) * nloc) {
            __builtin_amdgcn_fence(__ATOMIC_RELEASE, "agent");
            asm volatile("s_waitcnt vmcnt(0)" ::: "memory");
            const unsigned og = xb_add(&bar[XB_TOP], 1u);
            const unsigned tg = og / nx;
            if (og + 1u == (tg + 1u) * nx) xb_add(&bar[XB_TOPGEN], 1u);
            else XB_SPIN(xb_ld(&bar[XB_TOPGEN]) == tg, bar);
            __builtin_amdgcn_fence(__ATOMIC_ACQUIRE, "agent");
            xb_add(&bar[XB_XGEN(b.x)], 1u);
            asm volatile("s_waitcnt vmcnt(0)" ::: "memory");
        } else {
            XB_SPIN(xb_ld(&bar[XB_XGEN(b.x)]) == gen, bar);
            __builtin_amdgcn_fence(__ATOMIC_ACQUIRE, "agent");
            asm volatile("s_waitcnt vmcnt(0)" ::: "memory");
        }
    }
    __syncthreads();
}

constexpr int NWAVES = 8, NTHR = 512;
constexpr int RING_BYTES = 131072, LDSCTL_OFF = RING_BYTES, MISC_OFF = LDSCTL_OFF + 320, L_CKVSS = LDSCTL_OFF + 1024  , LDS_BYTES = 147456;
typedef float f32x4 __attribute__((ext_vector_type(4)));

struct Args {
    const float* x; const float* p; const int* pos; const float* norm_mix; const float* w_in; const float* ret_norm; const float* kv_norm;
    const float* w_uk; const float* w_uv; const float* w_out; const float* norm_ple; const float* w_ple_gate; const float* w_ple_proj; const float* norm_final;
    float* out; unsigned char* ws;
};

__device__ __forceinline__ void p0_transpose_item(const float* __restrict__ W, int ldw, h16* __restrict__ WT, int K, int n0, int k0, bool perm, const float* __restrict__ gk,
                                                  LAS float* scr, int lane, bool asbf = false) {
    const int nn = n0 + (lane & 31);
    const int oc = perm ? orig_col(nn) : nn;
    const float sc = perm ? col_scale(nn) : 1.0f;
#pragma unroll 8
    for (int i = 0; i < 32; ++i) {
        const int kk = 2 * i + (lane >> 5);
        float v = (oc >= 0) ? W[(size_t)(k0 + kk) * ldw + oc] * sc : 0.f;
        if (gk) v *= gk[k0 + kk];
        scr[kk * 33 + (lane & 31)] = v;
    }
    asm volatile("s_waitcnt lgkmcnt(0)" ::: "memory");
    const int c = lane & 7;
#pragma unroll
    for (int j = 0; j < 4; ++j) {
        const int n = (lane >> 3) + 8 * j; const LAS float* s = scr + (8 * c) * 33 + n;
        h16x8 o;
#pragma unroll
        for (int e = 0; e < 8; ++e) o[e] = asbf ? __builtin_bit_cast(h16, pg8::f2bf(s[e * 33])) : (h16)s[e * 33];
        *(h16x8*)(WT + (size_t)(n0 + n) * K + k0 + 8 * c) = o;
    }
    asm volatile("s_waitcnt lgkmcnt(0)" ::: "memory");
}
__device__ __forceinline__ void p0_prologue(const Args& a, LAS unsigned char* lds, int G, int bx, int tid, int lane, int wave) {
    unsigned char* ws = a.ws;
    float2* tab = (float2*)(ws + WS_TAB);
    h16* WinT = (h16*)(ws + WS_WIN); h16* WoutT = (h16*)(ws + WS_WOUT); h16* WgT = (h16*)(ws + WS_WG); h16* WpT = (h16*)(ws + WS_WP);
    h16* A0 = (h16*)(ws + WS_A0); h16* P16 = (h16*)(ws + WS_P16);
    const int gw = bx * NWAVES + wave, NGW = G * NWAVES;
    for (int i = bx * NTHR + tid; i < SEQ * NFREQ; i += G * NTHR) {
        const int s = i / NFREQ, f = i % NFREQ; float inv;
        if (f < 32) inv = powf(10000.0f, -(float)(2 * f) / 64.0f);
        else if (f < 40) inv = powf(500000.0f, -(float)(2 * (f - 32)) / 16.0f);
        else inv = powf(500000.0f, -(float)(2 * (f - 40)) / 8.0f);
        const float ang = (float)a.pos[s] * inv;
        tab[i] = make_float2(cosf(ang), sinf(ang));
    }
    LAS float* scr = (LAS float*)(lds + wave * 16384);
    constexpr int I_IN = 16 * (NP / 32), I_O = 16 * 32, I_G = 16 * 32, I_P = 4 * 32;
    for (int it = gw; it < I_IN + I_O + I_G + I_P; it += NGW) {
        int r = it;
        if (r < I_IN) { p0_transpose_item(a.w_in, 3512, WinT, DM, (r % (NP / 32)) * 32, (r / (NP / 32)) * 64, true, nullptr, scr, lane); continue; } r -= I_IN;
        if (r < I_O) { p0_transpose_item(a.w_out, DM, WoutT, DM, (r % 32) * 32, (r / 32) * 64, false, nullptr, scr, lane); continue; } r -= I_O;
        if (r < I_G) { p0_transpose_item(a.w_ple_gate, DM, WgT, DM, (r % 32) * 32, (r / 32) * 64, false, a.norm_ple, scr, lane); continue; } r -= I_G;
        p0_transpose_item(a.w_ple_proj, DM, WpT, PLE, (r % 32) * 32, (r / 32) * 64, false, nullptr, scr, lane);
    }
    {
        h16* WukT = (h16*)(ws + WS_WUK); h16* WuvT = (h16*)(ws + WS_WUV);
        for (int i = bx * NTHR + tid; i < 8 * 128 * 48; i += G * NTHR) { const int e = i & 7, ln = (i >> 3) & 63, f = i >> 9, s = f % 3, ct = (f / 3) & 3, hh = f / 12, q_ = ln & 31, h_ = ln >> 5;
            WukT[i] = (h16)a.w_uk[(hh * 48 + 16 * s + 8 * h_ + e) * 128 + 32 * ct + q_]; }
        for (int i = bx * NTHR + tid; i < 8 * 64 * 128; i += G * NTHR) { const int e = i & 7, ln = (i >> 3) & 63, f = i >> 9, ks = f & 7, dt = (f >> 3) & 1, hh = f >> 4, q_ = ln & 31, h_ = ln >> 5;
            WuvT[i] = (h16)a.w_uv[(hh * 128 + 16 * ks + 8 * h_ + e) * 64 + 32 * dt + q_]; }
    }
    {
        f32x4 gg[4];
#pragma unroll
        for (int j = 0; j < 4; ++j) gg[j] = ((const f32x4*)a.norm_mix)[lane + 64 * j];
        for (int row0 = 4 * gw; row0 < MTOK; row0 += 4 * NGW) {
            f32x4 v[4][4]; float ss[4];
#pragma unroll
            for (int rr = 0; rr < 4; ++rr) {
                const f32x4* xr = (const f32x4*)(a.x + (size_t)(row0 + rr) * DM);
#pragma unroll
                for (int j = 0; j < 4; ++j) v[rr][j] = __builtin_nontemporal_load(&xr[lane + 64 * j]);
            }
#pragma unroll
            for (int rr = 0; rr < 4; ++rr) {
                float s_ = 0.f;
#pragma unroll
                for (int j = 0; j < 4; ++j) s_ += (v[rr][j][0] * v[rr][j][0] + v[rr][j][1] * v[rr][j][1]) + (v[rr][j][2] * v[rr][j][2] + v[rr][j][3] * v[rr][j][3]);
                ss[rr] = s_;
            }
#pragma unroll
            for (int o = 1; o < 64; o <<= 1) {
#pragma unroll
                for (int rr = 0; rr < 4; ++rr) ss[rr] += __shfl_xor(ss[rr], o);
            }
#pragma unroll
            for (int rr = 0; rr < 4; ++rr) {
                const int row = row0 + rr;
                const float rstd = rsqrtf(ss[rr] * (1.0f / DM) + EPS);
                if (lane == 0) ((float*)(ws + WS_CTL) + 3 * MTOK)[row] = 1.0f / rstd;
#pragma unroll
                for (int j = 0; j < 4; ++j) {
                    h16x4 o; o[0] = (h16)(v[rr][j][0] * rstd * gg[j][0]); o[1] = (h16)(v[rr][j][1] * rstd * gg[j][1]); o[2] = (h16)(v[rr][j][2] * rstd * gg[j][2]); o[3] = (h16)(v[rr][j][3] * rstd * gg[j][3]);
                    *(h16x4*)(A0 + tix(row, (lane + 64 * j) * 4, DM)) = o;
                }
            }
        }
    }
#if !(RET_DYN && P16_TAIL)
    for (size_t i = (size_t)bx * NTHR + tid; i < (size_t)MTOK * PLE / 4; i += (size_t)4 * G * NTHR) {
        f32x4 v[4];
#pragma unroll
        for (int u2 = 0; u2 < 4; ++u2) v[u2] = ((const f32x4*)a.p)[i + (size_t)u2 * G * NTHR];
#pragma unroll
        for (int u2 = 0; u2 < 4; ++u2) { h16x4 o; o[0] = (h16)v[u2][0]; o[1] = (h16)v[u2][1]; o[2] = (h16)v[u2][2]; o[3] = (h16)v[u2][3]; ((h16x4*)P16)[i + (size_t)u2 * G * NTHR] = o; }
    }
#endif
}

__device__ __forceinline__ void fix_ckv(h16* proj, const float* kvn, int G, int bx, int lane, int wave) {
    const int gw = bx * NWAVES + wave, NGW = G * NWAVES;
    int p0 = 2 * lane; { const int g = (p0 >> 2) & 3; if (g == 1) p0 += 4; else if (g == 2) p0 -= 4; }
    const float g0 = kvn[p0], g1 = kvn[p0 + 1];
    for (int row0 = 4 * gw; row0 < MTOK; row0 += 4 * NGW) {
        h16x2 v[4]; float ss[4];
#pragma unroll
        for (int rr = 0; rr < 4; ++rr) v[rr] = *((const h16x2*)(proj + (size_t)(row0 + rr) * NP + C_CKV) + lane);
#pragma unroll
        for (int rr = 0; rr < 4; ++rr) { const float a_ = (float)v[rr][0], b_ = (float)v[rr][1]; ss[rr] = a_ * a_ + b_ * b_; }
#pragma unroll
        for (int o = 1; o < 64; o <<= 1) {
#pragma unroll
            for (int rr = 0; rr < 4; ++rr) ss[rr] += __shfl_xor(ss[rr], o);
        }
#pragma unroll
        for (int rr = 0; rr < 4; ++rr) {
            const float rstd = rsqrtf(ss[rr] * (1.0f / 128.0f) + EPS);
            h16x2 o; o[0] = (h16)((float)v[rr][0] * rstd * g0); o[1] = (h16)((float)v[rr][1] * rstd * g1);
            *((h16x2*)(proj + (size_t)(row0 + rr) * NP + C_CKV) + lane) = o;
        }
    }
}

namespace dsa {
typedef _Float16 f16x8 __attribute__((ext_vector_type(8)));
typedef _Float16 f16x4 __attribute__((ext_vector_type(4)));
typedef float f32x16 __attribute__((ext_vector_type(16)));
typedef float f32x4 __attribute__((ext_vector_type(4)));
typedef short v4i16_t __attribute__((ext_vector_type(4)));
constexpr int L_KT = 0;
constexpr int L_KR = 65536;
constexpr int L_MASK = 73728;
constexpr int L_QI = 81920;
constexpr int L_ATS = 98304;
constexpr int L_BIAS = 81920;
#define DSA_WAIT_BAR(N) asm volatile("s_waitcnt vmcnt(" #N ") lgkmcnt(0)\n\ts_barrier" ::: "memory")
constexpr float NEG = -3.0e38f;

__device__ __forceinline__ unsigned off_b(unsigned row, unsigned ch) { return 256u * row + 16u * (ch ^ (((row & 3) << 2) | ((row >> 2) & 3))); }
__device__ __forceinline__ unsigned off_a(unsigned row, unsigned ch) { return 2048u * (row >> 3) + 512u * (ch >> 2) + 64u * (row & 7) + 16u * ((ch & 3) ^ ((row >> 2) & 3)); }
__device__ __forceinline__ float max3f(float a, float b, float c) { float r; asm("v_max3_f32 %0, %1, %2, %3" : "=v"(r) : "v"(a), "v"(b), "v"(c)); return r; }
__device__ __forceinline__ float relu_s(float a) { float r; asm("v_max_f32_e32 %0, 0, %1" : "=v"(r) : "v"(a)); return r; }
#define MFMA_ASM_FENCE(x) asm volatile("s_nop 15\n\ts_nop 7" : "+v"(x))
__device__ __forceinline__ int wave_isum(int v) {
    v += __builtin_amdgcn_update_dpp(0, v, 0xB1, 0xF, 0xF, false);
    v += __builtin_amdgcn_update_dpp(0, v, 0x4E, 0xF, 0xF, false);
    v += __builtin_amdgcn_update_dpp(0, v, 0x141, 0xF, 0xF, false);
    v += __builtin_amdgcn_update_dpp(0, v, 0x140, 0xF, 0xF, false);
    return __builtin_amdgcn_readlane(v, 0) + __builtin_amdgcn_readlane(v, 16) + __builtin_amdgcn_readlane(v, 32) + __builtin_amdgcn_readlane(v, 48);
}
__device__ __forceinline__ f16x4 vtr(const LAS unsigned char* p) { return __builtin_bit_cast(f16x4, __builtin_amdgcn_ds_read_tr16_b64_v4i16((LAS v4i16_t*)p)); }
__device__ __forceinline__ unsigned ord_key(float f) { const unsigned u = __float_as_uint(f); return (u & 0x80000000u) ? ~u : (u | 0x80000000u); }
__device__ __forceinline__ f32x16 mfma32(f16x8 a, f16x8 b, f32x16 c) { return __builtin_amdgcn_mfma_f32_32x32x16_f16(a, b, c, 0, 0, 0); }
__device__ __forceinline__ float xhalf(float v) { return __shfl_xor(v, 32); }
__device__ __forceinline__ float hsum32(float v) { const auto r = __builtin_amdgcn_permlane32_swap(__float_as_uint(v), __float_as_uint(v), false, false); return __uint_as_float(r[0]) + __uint_as_float(r[1]); }

__device__ __forceinline__ void kstage_dma(LAS unsigned char* lds, int buf, const h16* pb, int key0, int lane, int wave) {
    const int row = 8 * (wave >> 1) + ((lane >> 2) & 7);
    const int ch = 4 * (2 * (wave & 1) + (lane >> 5)) + ((lane & 3) ^ ((row >> 2) & 3));
#pragma unroll
    for (int im = 0; im < 2; ++im) {
        const h16* src = pb + (unsigned)((key0 + 32 * im + row) * NP + C_CKV + 8 * ch);
        __builtin_amdgcn_global_load_lds((const unsigned*)src, (LAS unsigned*)(lds + L_KT + buf * 16384 + im * 8192 + wave * 1024), 16, 0, 0);
    }
    {
        const int slot = 64 * (wave & 1) + lane;
        const h16* src = pb + (unsigned)((key0 + (slot >> 1)) * NP + C_KPE + 8 * (slot & 1));
        __builtin_amdgcn_global_load_lds((const unsigned*)src, (LAS unsigned*)(lds + L_KR + buf * 2048 + (wave & 1) * 1024), 16, 0, 0);
    }
}

__device__ __forceinline__ void kstage_piece(LAS unsigned char* lds, int buf, const h16* pb, int key0, int lane, int wave, int which) {
    if (which < 2) {
        const int row = 8 * (wave >> 1) + ((lane >> 2) & 7);
        const int ch = 4 * (2 * (wave & 1) + (lane >> 5)) + ((lane & 3) ^ ((row >> 2) & 3));
        const h16* src = pb + (size_t)(key0 + 32 * which + row) * NP + C_CKV + 8 * ch;
        __builtin_amdgcn_global_load_lds((const unsigned*)src, (LAS unsigned*)(lds + L_KT + buf * 16384 + which * 8192 + wave * 1024), 16, 0, 0);
    } else {
        const int slot = 64 * (wave & 1) + lane;
        const h16* src = pb + (size_t)(key0 + (slot >> 1)) * NP + C_KPE + 8 * (slot & 1);
        __builtin_amdgcn_global_load_lds((const unsigned*)src, (LAS unsigned*)(lds + L_KR + buf * 2048 + (wave & 1) * 1024), 16, 0, 0);
    }
}

__device__ __forceinline__ void dsa_select_unit(LAS unsigned char* lds, int b, int qb, const h16* __restrict__ proj, float* __restrict__ scr, unsigned* __restrict__ maskg,
                                                int tid, int lane, int wave) {
    const int c = qb >> 1, N = 64 * (c + 1);
    const h16* pb = proj + (size_t)b * SEQ * NP;
    const h16* prow = pb + (unsigned)((32 * qb + (lane & 31)) * NP);
    LAS unsigned* maskw = (LAS unsigned*)(lds + L_MASK);
    if (N > 256) {
        const int q = lane & 31, h = lane >> 5;
        for (int i = tid; i < 2048; i += NTHR) maskw[i] = 0u;
        LAS int* qctr = (LAS int*)(lds + MISC_OFF + 14 * 4);
        if (tid == 0) *qctr = 0;
        {
            LAS unsigned char* qil = lds + L_QI;
            { const h16* qsrc = pb + (unsigned)(32 * qb * NP + C_IQ);
#pragma unroll
              for (int i2 = 0; i2 < 2; ++i2) { const int id = tid + NTHR * i2, row = id >> 5, ch = id & 31;
                  *(LAS f16x8*)(qil + row * 528 + ch * 16) = *(const f16x8*)(qsrc + (unsigned)(row * NP + 8 * ch)); } }
            float wq[8];
            { const f16x8 w8 = *(const f16x8*)(prow + C_IW);
#pragma unroll
              for (int hh = 0; hh < 8; ++hh) wq[hh] = (float)w8[hh]; }
            __syncthreads();
            const LAS unsigned char* qfr = qil + q * 528 + 16 * h;
            const unsigned koff = (unsigned)(q * NP + C_KI + 8 * h);
            int kt = wave;
            f16x8 ka0, ka1;
            if (kt < N / 32) { ka0 = *(const f16x8*)(pb + (koff + (unsigned)(32 * kt * NP))); ka1 = *(const f16x8*)(pb + (koff + (unsigned)(32 * kt * NP + 16))); }
            for (; kt < N / 32; kt += 8) {
                const f16x8 a0 = ka0, a1 = ka1;
                if (kt + 8 < N / 32) { ka0 = *(const f16x8*)(pb + (koff + (unsigned)(32 * (kt + 8) * NP))); ka1 = *(const f16x8*)(pb + (koff + (unsigned)(32 * (kt + 8) * NP + 16))); }
                f32x16 sc;
#pragma unroll
                for (int r = 0; r < 16; ++r) sc[r] = 0.f;
#pragma unroll
                for (int hh = 0; hh < 8; ++hh) {
                    const f16x8 q0 = *(const LAS f16x8*)(qfr + 64 * hh), q1 = *(const LAS f16x8*)(qfr + 64 * hh + 32);
                    f32x16 x;
#pragma unroll
                    for (int r = 0; r < 16; ++r) x[r] = 0.f;
                    x = mfma32(a0, q0, x); x = mfma32(a1, q1, x);
                    MFMA_ASM_FENCE(x);
#pragma unroll
                    for (int r = 0; r < 16; ++r) sc[r] += wq[hh] * relu_s(x[r]);
                    if (hh & 1) __builtin_amdgcn_sched_barrier(0);
                }
#pragma unroll
                for (int r4 = 0; r4 < 4; ++r4) {
                    const int kg = 8 * kt + 2 * r4 + h;
                    *(f32x4*)(scr + (unsigned)((kg * 32 + q) * 4)) = (f32x4){sc[4 * r4], sc[4 * r4 + 1], sc[4 * r4 + 2], sc[4 * r4 + 3]};
                }
            }
        }
        __syncthreads();
        const int NG = N >> 2;
        const int nip = (NG + 63) >> 6;
        for (;;) {
            int qq = 0; if (lane == 0) qq = __hip_atomic_fetch_add(qctr, 1, __ATOMIC_RELAXED, __HIP_MEMORY_SCOPE_WORKGROUP);
            qq = __builtin_amdgcn_readfirstlane(qq);
            if (qq >= 32) break;
            unsigned kk[32];
#define SEL_LOADCVT(NIP_) \
            _Pragma("unroll") for (int ip = 0; ip < 8; ++ip) { \
                if (ip < (NIP_)) { \
                    const int kg = lane + 64 * ip; \
                    const f32x4 v = *(const f32x4*)(scr + (unsigned)((kg * 32 + qq) * 4));        \
                    const bool ok = (ip < (NIP_) - 1) || (kg < NG); \
                    _Pragma("unroll") for (int e = 0; e < 4; ++e) kk[4 * ip + e] = ok ? ord_key(v[e]) : 0u; \
                } else { _Pragma("unroll") for (int e = 0; e < 4; ++e) kk[4 * ip + e] = 0u; } \
            }
            switch (nip) {
                case 2: SEL_LOADCVT(2); break;
                case 3: SEL_LOADCVT(3); break;
                case 4: SEL_LOADCVT(4); break;
                case 5: SEL_LOADCVT(5); break;
                case 6: SEL_LOADCVT(6); break;
                case 7: SEL_LOADCVT(7); break;
                default: SEL_LOADCVT(8); break;
            }
#undef SEL_LOADCVT
            unsigned T = 0u; bool exact = false;
#define SEL_BISECT(NIP_) \
            for (int bit = 31; bit >= 0; --bit) { \
                const unsigned cand = T | (1u << bit); \
                int lc0 = 0, lc1 = 0, lc2 = 0, lc3 = 0;             \
                _Pragma("unroll") for (int r0 = 0; r0 < 4 * (NIP_); r0 += 4) { \
                    unsigned long long t0_, t1_, t2_, t3_; \
                    asm volatile("v_cmp_le_u32_e64 %4, %12, %8\n\tv_cmp_le_u32_e64 %5, %12, %9\n\tv_cmp_le_u32_e64 %6, %12, %10\n\tv_cmp_le_u32_e64 %7, %12, %11\n\t" \
                                 "v_addc_co_u32_e64 %0, %4, 0, %0, %4\n\tv_addc_co_u32_e64 %1, %5, 0, %1, %5\n\tv_addc_co_u32_e64 %2, %6, 0, %2, %6\n\tv_addc_co_u32_e64 %3, %7, 0, %3, %7" \
                                 : "+v"(lc0), "+v"(lc1), "+v"(lc2), "+v"(lc3), "=&s"(t0_), "=&s"(t1_), "=&s"(t2_), "=&s"(t3_) \
                                 : "v"(kk[r0]), "v"(kk[r0 + 1]), "v"(kk[r0 + 2]), "v"(kk[r0 + 3]), "s"(cand)); \
                } \
                const int lc = (lc0 + lc1) + (lc2 + lc3); \
                const int cnt = wave_isum(lc); \
                if (cnt >= 256) T = cand; \
                if (cnt == 256) { exact = true; break; } \
            }
            switch (nip) {
                case 2: SEL_BISECT(2); break;
                case 3: SEL_BISECT(3); break;
                case 4: SEL_BISECT(4); break;
                case 5: SEL_BISECT(5); break;
                case 6: SEL_BISECT(6); break;
                case 7: SEL_BISECT(7); break;
                default: SEL_BISECT(8); break;
            }
#undef SEL_BISECT
            asm volatile("" : "+v"(T));
            unsigned selbits = 0u;
            if (exact) {
#pragma unroll
                for (int r0 = 0; r0 < 32; r0 += 4) {
#pragma unroll
                    for (int r = r0; r < r0 + 4; ++r) selbits |= (kk[r] >= T) ? (1u << r) : 0u;
                    __builtin_amdgcn_sched_barrier(0);
                }
            } else {
                int lg = 0;
#pragma unroll
                for (int r = 0; r < 32; ++r) lg += (kk[r] > T) ? 1 : 0;
                const int ngt = wave_isum(lg);
                const int need = 256 - ngt;
                const int lane4 = 4 * lane;
                int J = 0;
                for (int bit = 10; bit >= 0; --bit) {
                    const int cj = J | (1 << bit);
                    unsigned Tv = T; asm volatile("" : "+v"(Tv));
                    int lcj = 0;
#pragma unroll
                    for (int r = 0; r < 32; ++r) lcj += (kk[r] == Tv && lane4 < cj - (256 * (r >> 2) + (r & 3))) ? 1 : 0;
                    const int cnt = wave_isum(lcj);
                    if (cnt < need) J = cj;
                }
#pragma unroll
                for (int r0 = 0; r0 < 32; r0 += 2) {
#pragma unroll
                    for (int r = r0; r < r0 + 2; ++r) selbits |= (kk[r] > T || (kk[r] == T && lane4 <= J - (256 * (r >> 2) + (r & 3)))) ? (1u << r) : 0u;
                    __builtin_amdgcn_sched_barrier(0);
                }
            }
#define SEL_MASKOUT(NIP_) \
            _Pragma("unroll") for (int ip = 0; ip < (NIP_); ++ip) { \
                const unsigned nib = (selbits >> (4 * ip)) & 15u; \
                const int tile = (lane >> 4) + 4 * ip; \
                __hip_atomic_fetch_or(maskw + ((qq * 32 + tile) * 2 + ((lane & 15) >> 3)), nib << (4 * (lane & 7)), __ATOMIC_RELAXED, __HIP_MEMORY_SCOPE_WORKGROUP); \
            }
            switch (nip) {
                case 2: SEL_MASKOUT(2); break;
                case 3: SEL_MASKOUT(3); break;
                case 4: SEL_MASKOUT(4); break;
                case 5: SEL_MASKOUT(5); break;
                case 6: SEL_MASKOUT(6); break;
                case 7: SEL_MASKOUT(7); break;
                default: SEL_MASKOUT(8); break;
            }
#undef SEL_MASKOUT
        }
    } else {
        for (int i = tid; i < 2048; i += NTHR) maskw[i] = 0xffffffffu;
    }

    __syncthreads();
    { unsigned* dst = maskg + ((size_t)b * SEQ + 32 * qb) * 64;
      for (int i = tid; i < 2048; i += NTHR) dst[i] = maskw[i]; }
    __syncthreads();
}

__device__ __forceinline__ void bias_tile(LAS unsigned char* lds, int bbuf, const LAS unsigned* maskw, bool allsel, int T, int lane, int wave) {
    const int q = lane & 31, h = lane >> 5, blk = wave >> 2, r4 = wave & 3;
    const unsigned mw = allsel ? 0xffffffffu : maskw[(q * 32 + T) * 2 + blk];
    const unsigned nib = ~(mw >> (8 * r4 + 4 * h));
    f32x4 bv;
#pragma unroll
    for (int e = 0; e < 4; ++e) bv[e] = __uint_as_float((unsigned)__builtin_amdgcn_sbfe((int)nib, e, 1) & 0xff61b1e6u);
    *(LAS f32x4*)(lds + L_BIAS + bbuf * 8192 + ((blk * 4 + r4) * 64 + lane) * 16) = bv;
}

__device__ __forceinline__ void dsa_attn_unit(LAS unsigned char* lds, int b, int qb, const h16* __restrict__ proj, const unsigned* __restrict__ maskg,
                                              const h16* __restrict__ WukT, const h16* __restrict__ WuvT, h16* __restrict__ mix, int tid, int lane, int wave, float* dbg, int& sbase) {
    const int c = qb >> 1;
    const int sb_ = sbase;
    const h16* pb = proj + (size_t)b * SEQ * NP;
    const size_t m = (size_t)b * SEQ + 32 * qb + (lane & 31);
    const h16* prow = proj + m * NP;
    kstage_dma(lds, sb_ & 3, pb, 0, lane, wave);
    if (c >= 1) kstage_dma(lds, (sb_ + 1) & 3, pb, 64, lane, wave);
    LAS unsigned* maskw = (LAS unsigned*)(lds + L_MASK);
    if (c >= 4) { const unsigned* src = maskg + ((size_t)b * SEQ + 32 * qb) * 64;
#pragma unroll
        for (int j = 0; j < 4; ++j) maskw[tid + NTHR * j] = src[tid + NTHR * j]; }
    __syncthreads();
    bias_tile(lds, 0, maskw, c < 4, 0, lane, wave);
    const int q = lane & 31, h = lane >> 5;
    const int hd = wave;
    f16x8 qbf[8]; f16x8 qpe;
    {
        int lw_ = lane; asm volatile("" : "+v"(lw_));
        f16x8 qn[3];
#pragma unroll
        for (int s = 0; s < 3; ++s) qn[s] = *(const f16x8*)(prow + C_QN + 48 * hd + 16 * s + 8 * h);
        qpe = *(const f16x8*)(prow + C_QPE + 16 * hd + 8 * h);
#pragma unroll
        for (int ct = 0; ct < 4; ++ct) {
            f32x16 acc;
#pragma unroll
            for (int r = 0; r < 16; ++r) acc[r] = 0.f;
#pragma unroll
            for (int s = 0; s < 3; ++s) {
                const f16x8 wa = *(const f16x8*)(WukT + (unsigned)((((hd * 4 + ct) * 3 + s) * 64 + lw_) * 8));
                acc = mfma32(wa, qn[s], acc);
            }
#pragma unroll
            for (int k2 = 0; k2 < 2; ++k2) {
                f16x8 t;
#pragma unroll
                for (int j = 0; j < 8; ++j) t[j] = (_Float16)acc[8 * k2 + j];
                qbf[2 * ct + k2] = t;
            }
        }
    }
    f32x16 O[4];
#pragma unroll
    for (int ct = 0; ct < 4; ++ct)
#pragma unroll
        for (int r = 0; r < 16; ++r) O[ct][r] = 0.f;
    float mrun = -1.0e30f, lrun = 0.f;
#ifdef PROBE_ATTSEG
    unsigned long long segacc = 0;
#endif
    const int qq4 = (lane & 15) >> 2, p4 = lane & 3, b16 = (lane >> 4) & 1;
    const unsigned rbase0 = off_a(q, h), rbase1 = off_a(q, 2 + h);
    const unsigned tbase0 = off_a(4 * h + qq4, 2 * b16 + (p4 >> 1)) + 8 * (p4 & 1), tbase1 = off_a(8 + 4 * h + qq4, 2 * b16 + (p4 >> 1)) + 8 * (p4 & 1);

    __syncthreads();
    f32x16 S0, S1; f16x8 ka[8]; f16x8 kr; f16x4 va0[8], va1[8]; f16x8 pk0[2], pk1[2];
    float alpha0 = 1.f, alpha1 = 1.f, mn0 = 0.f, mn1 = 0.f, ps0 = 0.f, ps1 = 0.f;
#define ATT_K1(img, ks) (*(const LAS f16x8*)((img) + (((ks) & 1) ? rbase1 : rbase0) + 512 * ((ks) >> 1)))
#define ATT_KR1(kr0, blk) (*(const LAS f16x8*)((kr0) + (32 * (blk) + q) * 32 + 16 * h))
#define ATT_V1(img, i2) do { va0[i2] = vtr((img) + tbase0 + 4096 * ((i2) >> 2) + 512 * ((i2) & 3)); va1[i2] = vtr((img) + tbase1 + 4096 * ((i2) >> 2) + 512 * ((i2) & 3)); } while (0)
#define ATT_VFRAG(i2) (f16x8){va0[i2][0], va0[i2][1], va0[i2][2], va0[i2][3], va1[i2][0], va1[i2][1], va1[i2][2], va1[i2][3]}
#define ATT_THR 10.0f
#define ATT_SM(c, S, pk, alpha, mnew, ps) do { \
            if ((c) == 0) { mnew = max3f(S[0], S[1], S[2]); mnew = max3f(mnew, S[3], S[4]); mnew = max3f(mnew, S[5], S[6]); mnew = max3f(mnew, S[7], S[8]); } \
            if ((c) == 1) { mnew = max3f(mnew, S[9], S[10]); mnew = max3f(mnew, S[11], S[12]); mnew = max3f(mnew, S[13], S[14]); mnew = max3f(mnew, S[15], S[15]); } \
            if ((c) == 2) { const auto sw_ = __builtin_amdgcn_permlane32_swap(__float_as_uint(mnew), __float_as_uint(mnew), false, false); mnew = max3f(__uint_as_float(sw_[0]), __uint_as_float(sw_[1]), __uint_as_float(sw_[1]));        \
                if (__any(mnew - mrun > ATT_THR)) { mnew = max3f(mrun, mnew, mnew); alpha = __builtin_amdgcn_exp2f(mrun - mnew); mrun = mnew; }     \
                else mnew = mrun;                                                                \
                ps = 0.f; } \
            if ((c) >= 3 && (c) <= 6) { _Pragma("unroll") for (int r_ = 4 * ((c) - 3); r_ < 4 * ((c) - 3) + 4; ++r_) { const float e_ = __builtin_amdgcn_exp2f(S[r_] - mnew); S[r_] = e_; ps += e_; } } \
            if ((c) == 7) { _Pragma("unroll") for (int j_ = 0; j_ < 8; ++j_) pk[0][j_] = (_Float16)S[j_]; } \
            if ((c) == 8) { _Pragma("unroll") for (int j_ = 0; j_ < 8; ++j_) pk[1][j_] = (_Float16)S[8 + j_]; lrun = lrun * alpha + ps; } \
        } while (0)
#define ATT_RESCALE(alpha) do { if (__any((alpha) != 1.0f)) { _Pragma("unroll") for (int ct = 0; ct < 4; ++ct) _Pragma("unroll") for (int r = 0; r < 16; ++r) O[ct][r] *= (alpha); } } while (0)
#define ATT_TOP(t) do { if ((t) + 1 <= c) bias_tile(lds, ((t) + 1) & 1, maskw, c < 4, (t) + 1, lane, wave); } while (0)
#define ATT_DMA(t, w_) do { if ((t) + 2 <= c) kstage_piece(lds, (sb_ + (t) + 2) & 3, pb, 64 * ((t) + 2), lane, wave, w_); } while (0)
#define ATT_PH1(t) do { const LAS unsigned char* i0_ = lds + L_KT + ((sb_ + (t)) & 3) * 16384; const LAS unsigned char* k0_ = lds + L_KR + ((sb_ + (t)) & 3) * 2048; \
            { const LAS unsigned char* bp = lds + L_BIAS + ((t) & 1) * 8192 + lane * 16;        \
              _Pragma("unroll") for (int r4 = 0; r4 < 4; ++r4) { const f32x4 b0 = *(const LAS f32x4*)(bp + r4 * 1024), b1 = *(const LAS f32x4*)(bp + 4096 + r4 * 1024); \
                  _Pragma("unroll") for (int e = 0; e < 4; ++e) { S0[4 * r4 + e] = b0[e]; S1[4 * r4 + e] = b1[e]; } } } \
            _Pragma("unroll") for (int ks = 0; ks < 8; ++ks) ka[ks] = ATT_K1(i0_, ks); \
            kr = ATT_KR1(k0_, 0); \
            _Pragma("unroll") for (int ks = 0; ks < 8; ++ks) { S0 = mfma32(ka[ks], qbf[ks], S0); ka[ks] = ATT_K1(i0_ + 8192, ks); if (ks == 1) ATT_DMA(t, 0); if (ks == 3) ATT_DMA(t, 1); if (ks == 5) ATT_DMA(t, 2); } \
            S0 = mfma32(kr, qpe, S0); kr = ATT_KR1(k0_, 1); } while (0)
#define ATT_PH2(t) do { const LAS unsigned char* i0_ = lds + L_KT + ((sb_ + (t)) & 3) * 16384; \
            MFMA_ASM_FENCE(S0); alpha0 = 1.f; mn0 = 0.f; ps0 = 0.f; \
            __builtin_amdgcn_sched_barrier(0); \
            _Pragma("unroll") for (int ks = 0; ks < 9; ++ks) { \
                if (ks < 8) { S1 = mfma32(ka[ks], qbf[ks], S1); ATT_V1(i0_, ks); } else S1 = mfma32(kr, qpe, S1); \
                ATT_SM(ks, S0, pk0, alpha0, mn0, ps0); \
                __builtin_amdgcn_sched_barrier(0); } } while (0)
#define ATT_PH3(t) do { const LAS unsigned char* i1_ = lds + L_KT + ((sb_ + (t)) & 3) * 16384 + 8192; \
            ATT_RESCALE(alpha0); \
            MFMA_ASM_FENCE(S1); alpha1 = 1.f; mn1 = 0.f; ps1 = 0.f; \
            __builtin_amdgcn_sched_barrier(0); \
            _Pragma("unroll") for (int i2 = 0; i2 < 8; ++i2) { \
                O[i2 & 3] = mfma32(ATT_VFRAG(i2), pk0[i2 >> 2], O[i2 & 3]); ATT_V1(i1_, i2); \
                ATT_SM(i2, S1, pk1, alpha1, mn1, ps1); \
                if (i2 == 7) ATT_SM(8, S1, pk1, alpha1, mn1, ps1); \
                __builtin_amdgcn_sched_barrier(0); } } while (0)
#define ATT_PH4() do { ATT_RESCALE(alpha1); \
            _Pragma("unroll") for (int i2 = 0; i2 < 8; ++i2) O[i2 & 3] = mfma32(ATT_VFRAG(i2), pk1[i2 >> 2], O[i2 & 3]); } while (0)
#define ATT_BAR(t) do { if ((t) + 2 <= c) DSA_WAIT_BAR(3); else DSA_WAIT_BAR(0); } while (0)
    const bool late = wave >= 4;
    for (int t = 0; t <= c; ++t) {
        ATT_TOP(t); ATT_PH1(t); ATT_PH2(t);
        if (late) ATT_BAR(t);
        ATT_PH3(t); ATT_PH4();
        if (!late) ATT_BAR(t);
    }
#undef ATT_K1
#undef ATT_KR1
#undef ATT_V1
#undef ATT_VFRAG
#undef ATT_SM
#undef ATT_RESCALE
#undef ATT_TOP
#undef ATT_DMA
#undef ATT_PH1
#undef ATT_PH2
#undef ATT_PH3
#undef ATT_PH4
#undef ATT_BAR
    {
        LAS unsigned char* ats = lds + L_ATS + wave * 4096;
        int lv_ = lane; asm volatile("" : "+v"(lv_));
        const int erow = lv_ >> 3, ech = lv_ & 7;
        const h16* grow_ = pb + (unsigned)((32 * qb) * NP + C_DG + 64 * hd + 8 * ech);
        f16x8 gt[4];
#pragma unroll
        for (int i2 = 0; i2 < 4; ++i2) gt[i2] = *(const f16x8*)(grow_ + (unsigned)((8 * i2 + erow) * NP));
        const float ltot = hsum32(lrun);
        const float inv = 1.0f / ltot;
        f16x8 ob[8];
#pragma unroll
        for (int ks = 0; ks < 8; ++ks)
#pragma unroll
            for (int j = 0; j < 8; ++j) ob[ks][j] = (_Float16)(O[ks >> 1][8 * (ks & 1) + j] * inv);
#pragma unroll
        for (int dt = 0; dt < 2; ++dt) {
            f32x16 acc;
#pragma unroll
            for (int r = 0; r < 16; ++r) acc[r] = 0.f;
#pragma unroll
            for (int ks = 0; ks < 8; ++ks) {
                const f16x8 wa = *(const f16x8*)(WuvT + (unsigned)((((hd * 2 + dt) * 8 + ks) * 64 + lv_) * 8));
                acc = mfma32(wa, ob[ks], acc);
            }
#pragma unroll
            for (int r4 = 0; r4 < 4; ++r4) {
                const int d0 = 32 * dt + 8 * r4 + 4 * h;
                f16x4 o4;
#pragma unroll
                for (int e = 0; e < 4; ++e) o4[e] = (_Float16)acc[4 * r4 + e];
                *(LAS f16x4*)(ats + q * 128 + (((4 * dt + r4) ^ (q & 7)) * 16) + 8 * h) = o4;
            }
        }
        asm volatile("s_waitcnt lgkmcnt(0)" ::: "memory");
        h16* mrow_ = mix + ((size_t)b * SEQ + 32 * qb) * DM + 512 + 64 * hd + 8 * ech;
#pragma unroll
        for (int i2 = 0; i2 < 4; ++i2) {
            const int row = 8 * i2 + erow;
            const f16x8 y = *(const LAS f16x8*)(ats + row * 128 + ((ech ^ (row & 7)) * 16));
            f16x8 o8;
#pragma unroll
            for (int e = 0; e < 8; ++e) o8[e] = (_Float16)((float)y[e] * (float)gt[i2][e]);
            *(f16x8*)(mrow_ + (unsigned)(row * DM)) = o8;
        }
        asm volatile("s_waitcnt lgkmcnt(0)" ::: "memory");
    }
    sbase = (sb_ + c + 1) & 3;
}
}
namespace ret {
using dsa::f16x8; using dsa::f16x4; using dsa::f32x16; using dsa::off_b; using dsa::vtr; using dsa::mfma32; using dsa::xhalf;
constexpr int L_KV = 0;
constexpr int L_ST = 65536;
__device__ __forceinline__ void kv_dma(LAS unsigned char* lds, int boff, const h16* pb, int hd, int key0, int lane, int wave) {
    const int row = 4 * wave + (lane >> 4), chp = lane & 15;
    const int ch = chp ^ (((row & 3) << 2) | ((row >> 2) & 3));
    const int col = (ch < 8 ? C_RK + 8 * ch : C_RV + 8 * (ch - 8)) + 64 * hd;
#pragma unroll
    for (int im = 0; im < 2; ++im) {
        const h16* src = pb + (size_t)(key0 + 32 * im + row) * NP + col;
        __builtin_amdgcn_global_load_lds((const unsigned*)src, (LAS unsigned*)(lds + L_KV + boff + im * 8192 + wave * 1024), 16, 0, 0);
#ifdef PROBE_H4
        __builtin_amdgcn_global_load_lds((const unsigned*)src, (LAS unsigned*)(lds + L_KV + boff + im * 8192 + wave * 1024), 16, 0, 0);
#endif
    }
}
__device__ __forceinline__ void retention_unit(LAS unsigned char* lds, int b, int hd, const h16* __restrict__ proj, const float* __restrict__ ret_norm, h16* __restrict__ mix,
                                               int lane, int wave, float* dbg) {
    const int q = lane & 31, h = lane >> 5;
    const h16* pb = proj + (size_t)b * SEQ * NP;
#if defined(PROBE_RETWAIT) || defined(PROBE_RETFAST) || defined(PROBE_RETSEG)
    unsigned long long t_wait = 0, t_begin = __builtin_amdgcn_s_memtime();
#endif
    const float lg2 = log2f(1.0f - exp2f(-5.0f - (float)hd));
    const float g32 = exp2f(lg2 * 32.0f);
    float cf[16];
#pragma unroll
    for (int r = 0; r < 16; ++r) cf[r] = exp2f(lg2 * (float)(31 - 4 * h - ((r & 3) + 8 * (r >> 2))));
    const int qq4 = (lane & 15) >> 2, p4 = lane & 3, b16 = (lane >> 4) & 1;
    const int n = 32 * (wave & 1) + q;
    const float xi = exp2f(lg2 * (float)(n + 1));
    for (int g = 0; g < 8; ++g) {
        const int cq = 4 * g + (wave >> 1);
#if defined(PROBE_RETSEG)
        unsigned long long ts0 = __builtin_amdgcn_s_memtime();
#endif
        kv_dma(lds, 0, pb, hd, 0, lane, wave); kv_dma(lds, 16384, pb, hd, 64, lane, wave);
        LAS unsigned char* stg = lds + L_ST + wave * 4608;
        const unsigned grow0 = (unsigned)((256 * g + 32 * wave) * NP);
        const int srow = lane >> 3, sch = lane & 7;
#pragma unroll
        for (int i2 = 0; i2 < 4; ++i2)
            *(LAS f16x8*)(stg + (8 * i2 + srow) * 144 + 16 * sch) = *(const f16x8*)(pb + (grow0 + (unsigned)((8 * i2 + srow) * NP + C_RQ + 64 * hd + 8 * sch)));
        asm volatile("s_waitcnt lgkmcnt(0)" ::: "memory");
        f16x8 qf[4];
#pragma unroll
        for (int ks = 0; ks < 4; ++ks) qf[ks] = *(const LAS f16x8*)(stg + q * 144 + 32 * ks + 16 * h);
        asm volatile("" ::: "memory");
        f32x16 O[2];
#pragma unroll
        for (int dt = 0; dt < 2; ++dt)
#pragma unroll
            for (int r = 0; r < 16; ++r) O[dt][r] = 0.f;
        __syncthreads();
#if defined(PROBE_RETSEG)
        if (PROBE_RETSEG == 1) t_wait += __builtin_amdgcn_s_memtime() - ts0;
#endif
        const int nt = 4 * g + 4;
        int slot = 0;
        for (int kp = 0; kp < nt / 2; ++kp) {
            const int slotn = slot ^ 1;
            if (2 * kp + 2 < nt) { kv_dma(lds, slotn * 32768, pb, hd, 64 * (2 * kp + 2), lane, wave); kv_dma(lds, slotn * 32768 + 16384, pb, hd, 64 * (2 * kp + 3), lane, wave); }
#pragma unroll 1
            for (int sub = 0; sub < 2; ++sub) {
            const int kt = 2 * kp + sub;
            const LAS unsigned char* img0 = lds + L_KV + slot * 32768 + sub * 16384;
#ifdef PROBE_RETFAST
            const unsigned long long tf0 = __builtin_amdgcn_s_memtime();
#endif
            if (kt < cq) {
                const float tsc = xi * __builtin_amdgcn_exp2f(lg2 * 64.0f * (float)(cq - kt - 1));
                f32x16 S[2];
#pragma unroll
                for (int blk = 0; blk < 2; ++blk) {
#pragma unroll
                    for (int r2 = 0; r2 < 16; ++r2) S[blk][r2] = 0.f;
#pragma unroll
                    for (int ks = 0; ks < 4; ++ks) {
                        const f16x8 ka = *(const LAS f16x8*)(img0 + blk * 8192 + off_b(q, 2 * ks + h));
#ifdef PROBE_H1
                        { const f16x8 kd = *(const LAS f16x8*)(img0 + (blk ^ 1) * 8192 + off_b(q, 2 * ks + h)); asm volatile("" :: "v"(kd)); }
#endif
                        S[blk] = mfma32(ka, qf[ks], S[blk]);
                    }
                }
#pragma unroll
                for (int blk = 0; blk < 2; ++blk) {
                    const float f = tsc * (blk ? 1.0f : g32);
                    f16x8 pk[2];
#pragma unroll
                    for (int s2 = 0; s2 < 2; ++s2)
#pragma unroll
                        for (int j2 = 0; j2 < 8; ++j2) pk[s2][j2] = (_Float16)(S[blk][8 * s2 + j2] * (cf[8 * s2 + j2] * f));
#pragma unroll
                    for (int s2 = 0; s2 < 2; ++s2)
#pragma unroll
                        for (int dt = 0; dt < 2; ++dt) {
                            const int ct = 2 + dt;
                            const LAS unsigned char* img = img0 + blk * 8192;
                            const f16x4 v0 = vtr(img + off_b(16 * s2 + 4 * h + qq4, 4 * ct + 2 * b16 + (p4 >> 1)) + 8 * (p4 & 1));
                            const f16x4 v1 = vtr(img + off_b(16 * s2 + 8 + 4 * h + qq4, 4 * ct + 2 * b16 + (p4 >> 1)) + 8 * (p4 & 1));
                            const f16x8 va = (f16x8){v0[0], v0[1], v0[2], v0[3], v1[0], v1[1], v1[2], v1[3]};
#ifdef PROBE_H1
                            { const f16x4 d0 = vtr(img0 + (blk ^ 1) * 8192 + off_b(16 * s2 + 4 * h + qq4, 4 * ct + 2 * b16 + (p4 >> 1)) + 8 * (p4 & 1));
                              const f16x4 d1 = vtr(img0 + (blk ^ 1) * 8192 + off_b(16 * s2 + 8 + 4 * h + qq4, 4 * ct + 2 * b16 + (p4 >> 1)) + 8 * (p4 & 1)); asm volatile("" :: "v"(d0), "v"(d1)); }
#endif
#ifdef PROBE_H2
                            { f32x16 dmy = O[dt]; dmy = mfma32(va, pk[s2], dmy); asm volatile("" :: "v"(dmy)); }
#endif
                            O[dt] = mfma32(va, pk[s2], O[dt]);
                        }
                }
#ifdef PROBE_RETFAST
                asm volatile("s_nop 0" ::: "memory"); t_wait += __builtin_amdgcn_s_memtime() - tf0;
#endif
            } else if (kt == cq) {
#if defined(PROBE_RETSEG)
                ts0 = __builtin_amdgcn_s_memtime();
#endif
#pragma unroll 1
                for (int blk = 0; blk < 2; ++blk) {
                    const LAS unsigned char* img = img0 + blk * 8192;
                    f32x16 S;
#pragma unroll
                    for (int r2 = 0; r2 < 16; ++r2) S[r2] = 0.f;
#pragma unroll
                    for (int ks = 0; ks < 4; ++ks) {
                        const f16x8 ka = *(const LAS f16x8*)(img + off_b(q, 2 * ks + h));
                        S = mfma32(ka, qf[ks], S);
                    }
#pragma unroll
                    for (int r2 = 0; r2 < 16; ++r2) {
                        const int mk = 32 * blk + 4 * h + (r2 & 3) + 8 * (r2 >> 2);
                        S[r2] *= __builtin_amdgcn_exp2f(lg2 * fabsf((float)(n - mk)));
                    }
                    f16x8 pk[2];
#pragma unroll
                    for (int s2 = 0; s2 < 2; ++s2)
#pragma unroll
                        for (int j2 = 0; j2 < 8; ++j2) pk[s2][j2] = (_Float16)S[8 * s2 + j2];
#pragma unroll
                    for (int s2 = 0; s2 < 2; ++s2)
#pragma unroll
                        for (int dt = 0; dt < 2; ++dt) {
                            const int ct = 2 + dt;
                            const f16x4 v0 = vtr(img + off_b(16 * s2 + 4 * h + qq4, 4 * ct + 2 * b16 + (p4 >> 1)) + 8 * (p4 & 1));
                            const f16x4 v1 = vtr(img + off_b(16 * s2 + 8 + 4 * h + qq4, 4 * ct + 2 * b16 + (p4 >> 1)) + 8 * (p4 & 1));
                            const f16x8 va = (f16x8){v0[0], v0[1], v0[2], v0[3], v1[0], v1[1], v1[2], v1[3]};
                            O[dt] = mfma32(va, pk[s2], O[dt]);
                        }
                }
            }
#if defined(PROBE_RETSEG)
                if (PROBE_RETSEG == 2 && kt == cq) t_wait += __builtin_amdgcn_s_memtime() - ts0;
#endif
            }
            DSA_WAIT_BAR(0);
            slot ^= 1;
        }
#if defined(PROBE_RETSEG)
        ts0 = __builtin_amdgcn_s_memtime();
#endif
        float s1 = 0.f;
#pragma unroll
        for (int dt = 0; dt < 2; ++dt)
#pragma unroll
            for (int r = 0; r < 16; ++r) s1 += O[dt][r];
        s1 += xhalf(s1);
        const float mu = s1 * (1.0f / 64.0f);
        float s2v = 0.f;
#pragma unroll
        for (int dt = 0; dt < 2; ++dt)
#pragma unroll
            for (int r = 0; r < 16; ++r) { const float d = O[dt][r] - mu; s2v += d * d; }
        s2v += xhalf(s2v);
        const float rstd = rsqrtf(s2v * (1.0f / 64.0f) + EPS);
#pragma unroll
        for (int dt = 0; dt < 2; ++dt)
#pragma unroll
            for (int r4 = 0; r4 < 4; ++r4) {
                const int d0 = 32 * dt + 8 * r4 + 4 * h;
                f16x4 o4;
#pragma unroll
                for (int e = 0; e < 4; ++e) o4[e] = (_Float16)((O[dt][4 * r4 + e] - mu) * rstd);
                *(LAS f16x4*)(stg + q * 144 + 2 * d0) = o4;
            }
        asm volatile("s_waitcnt lgkmcnt(0)" ::: "memory");
        {
            const dsa::f32x4 rn0 = *(const dsa::f32x4*)(ret_norm + 64 * hd + 8 * sch), rn1 = *(const dsa::f32x4*)(ret_norm + 64 * hd + 8 * sch + 4);
#pragma unroll
            for (int i2 = 0; i2 < 4; ++i2) {
                const int row = 8 * i2 + srow;
                const f16x8 y = *(const LAS f16x8*)(stg + row * 144 + 16 * sch);
                const f16x8 gt = *(const f16x8*)(pb + (grow0 + (unsigned)(row * NP + C_RG + 64 * hd + 8 * sch)));
                f16x8 o8;
#pragma unroll
                for (int e = 0; e < 4; ++e) { o8[e] = (_Float16)((float)y[e] * rn0[e] * (float)gt[e]); o8[4 + e] = (_Float16)((float)y[4 + e] * rn1[e] * (float)gt[4 + e]); }
                *(f16x8*)(mix + ((size_t)b * SEQ + 256 * g + 32 * wave + row) * DM + 64 * hd + 8 * sch) = o8;
            }
        }
        asm volatile("s_waitcnt lgkmcnt(0)" ::: "memory");
#if defined(PROBE_RETSEG)
        if (PROBE_RETSEG == 3) { asm volatile("s_waitcnt vmcnt(0)" ::: "memory"); t_wait += __builtin_amdgcn_s_memtime() - ts0; }
#endif
    }
#if defined(PROBE_RETWAIT) || defined(PROBE_RETFAST) || defined(PROBE_RETSEG)
    if (blockIdx.x == 0 && wave == 7 && lane == 0) dbg[0] = 50.0f * (float)t_wait / (float)(__builtin_amdgcn_s_memtime() - t_begin);
#endif
}
}
namespace ret2 {
using dsa::f16x8; using dsa::f16x4; using dsa::f32x16; using dsa::off_b; using dsa::vtr; using dsa::mfma32; using dsa::xhalf;
using ret::L_KV; using ret::L_ST; using dsa::off_a;
using dsa::hsum32;
__device__ __forceinline__ void kv_dma(LAS unsigned char* lds, int boff, const h16* pb, int hd, int key0, int lane, int wave) {
    const int row = 8 * (wave >> 1) + ((lane >> 2) & 7);
    const int ch = 4 * (2 * (wave & 1) + (lane >> 5)) + ((lane & 3) ^ ((row >> 2) & 3));
    const int col = (ch < 8 ? C_RK + 8 * ch : C_RV + 8 * (ch - 8)) + 64 * hd;
#pragma unroll
    for (int im = 0; im < 2; ++im) {
        const h16* src = pb + (size_t)(key0 + 32 * im + row) * NP + col;
        __builtin_amdgcn_global_load_lds((const unsigned*)src, (LAS unsigned*)(lds + L_KV + boff + im * 8192 + wave * 1024), 16, 0, 0);
    }
}
__device__ __forceinline__ void retention_unit(LAS unsigned char* lds, int b, int hd, const h16* __restrict__ proj, const float* __restrict__ ret_norm, h16* __restrict__ mix,
                                               int lane, int wave, int g0 = 0, int g1 = 4) {
    const int q = lane & 31, h = lane >> 5;
    const h16* pb = proj + (size_t)b * SEQ * NP;
    const float lg2 = log2f(1.0f - exp2f(-5.0f - (float)hd));
    const float g32 = exp2f(lg2 * 32.0f);
    float cf[16];
#pragma unroll
    for (int r = 0; r < 16; ++r) cf[r] = exp2f(lg2 * (float)(31 - 4 * h - ((r & 3) + 8 * (r >> 2))));
    const int qq4 = (lane & 15) >> 2, p4 = lane & 3, b16 = (lane >> 4) & 1;
    const unsigned rbase0 = off_a(q, h), rbase1 = off_a(q, 2 + h);
    const unsigned tbase0 = off_a(4 * h + qq4, 2 * b16 + (p4 >> 1)) + 8 * (p4 & 1), tbase1 = off_a(8 + 4 * h + qq4, 2 * b16 + (p4 >> 1)) + 8 * (p4 & 1);
    const float xiA = exp2f(lg2 * (float)(q + 1));
    LAS unsigned char* stg = lds + L_ST + wave * 4608;
    const int srow = lane >> 3, sch = lane & 7;
    for (int g = g0; g < g1; ++g) {
        const int cqa = 8 * g + wave, cqb = 8 * g + 7 - wave;
        kv_dma(lds, 0, pb, hd, 0, lane, wave); kv_dma(lds, 16384, pb, hd, 64, lane, wave);
        const unsigned growa = (unsigned)((64 * cqa) * NP), growb = (unsigned)((64 * cqb) * NP);
        f16x8 qf[2][4];
#pragma unroll
        for (int X = 0; X < 2; ++X) {
#pragma unroll
            for (int i2 = 0; i2 < 4; ++i2)
                *(LAS f16x8*)(stg + (8 * i2 + srow) * 144 + 16 * sch) = *(const f16x8*)(pb + ((X ? growb : growa) + (unsigned)((32 * X + 8 * i2 + srow) * NP + C_RQ + 64 * hd + 8 * sch)));
            asm volatile("s_waitcnt lgkmcnt(0)" ::: "memory");
#pragma unroll
            for (int ks = 0; ks < 4; ++ks) qf[X][ks] = *(const LAS f16x8*)(stg + q * 144 + 32 * ks + 16 * h);
            asm volatile("s_waitcnt lgkmcnt(0)" ::: "memory");
            __builtin_amdgcn_sched_barrier(0);
        }
        f32x16 O[2][2];
#pragma unroll
        for (int X = 0; X < 2; ++X)
#pragma unroll
            for (int dt = 0; dt < 2; ++dt)
#pragma unroll
                for (int r = 0; r < 16; ++r) O[X][dt][r] = 0.f;
        __syncthreads();
        const int nt = 8 * g + 8;
        int slot = 0;
        for (int kp = 0; kp < nt / 2; ++kp) {
            const int slotn = slot ^ 1;
            if (2 * kp + 2 < nt) { kv_dma(lds, slotn * 32768, pb, hd, 64 * (2 * kp + 2), lane, wave); kv_dma(lds, slotn * 32768 + 16384, pb, hd, 64 * (2 * kp + 3), lane, wave); }
            if (kp < 4 * g) {
#pragma unroll 1
            for (int sub = 0; sub < 2; ++sub) {
                const int kt = 2 * kp + sub;
#pragma unroll 1
                for (int blk = 0; blk < 2; ++blk) {
                    const LAS unsigned char* img = lds + L_KV + slot * 32768 + sub * 16384 + blk * 8192;
#pragma unroll
                    for (int X = 0; X < 2; ++X) {
                        const int cqx = X ? cqb : cqa;
                        constexpr bool own = false;
                        const float tsc = xiA * __builtin_amdgcn_exp2f(lg2 * 64.0f * (float)(own ? 0 : cqx - kt - 1));
                        f32x16 S;
#pragma unroll
                        for (int r2 = 0; r2 < 16; ++r2) S[r2] = 0.f;
#pragma unroll
                        for (int ks = 0; ks < 4; ++ks) {
                            const f16x8 ka = *(const LAS f16x8*)(img + ((ks & 1) ? rbase1 : rbase0) + 512 * (ks >> 1));
                            S = mfma32(ka, qf[X][ks], S);
                        }
                        if (!own) {
                            const float f = tsc * (blk ? 1.0f : g32) * (X ? g32 : 1.0f);
#pragma unroll
                            for (int r2 = 0; r2 < 16; ++r2) S[r2] *= cf[r2] * f;
                        } else {
                            asm volatile("" ::: "memory");
#pragma unroll
                            for (int r2 = 0; r2 < 16; ++r2) {
                                const int mk = 32 * blk + 4 * h + (r2 & 3) + 8 * (r2 >> 2);
                                S[r2] *= __builtin_amdgcn_exp2f(lg2 * fabsf((float)(32 * X + q - mk)));
                            }
                        }
                        f16x8 pk[2];
#pragma unroll
                        for (int s2 = 0; s2 < 2; ++s2)
#pragma unroll
                            for (int j2 = 0; j2 < 8; ++j2) pk[s2][j2] = (_Float16)S[8 * s2 + j2];
#pragma unroll
                        for (int s2 = 0; s2 < 2; ++s2)
#pragma unroll
                            for (int dt = 0; dt < 2; ++dt) {
                                const int ct = 2 + dt;
                                const f16x4 v0 = vtr(img + tbase0 + 4096 * s2 + 512 * ct);
                                const f16x4 v1 = vtr(img + tbase1 + 4096 * s2 + 512 * ct);
                                const f16x8 va = (f16x8){v0[0], v0[1], v0[2], v0[3], v1[0], v1[1], v1[2], v1[3]};
                                O[X][dt] = mfma32(va, pk[s2], O[X][dt]);
                            }
                        __builtin_amdgcn_sched_barrier(0);
                    }
                }
            }
            } else {
#pragma unroll 1
            for (int sub = 0; sub < 2; ++sub) {
                const int kt = 2 * kp + sub;
                if (kt > cqa && kt > cqb) continue;
#pragma unroll 1
                for (int blk = 0; blk < 2; ++blk) {
                    const LAS unsigned char* img = lds + L_KV + slot * 32768 + sub * 16384 + blk * 8192;
#pragma unroll
                    for (int X = 0; X < 2; ++X) {
                        const int cqx = X ? cqb : cqa;
                        if (kt > cqx) continue;
                        const bool own = (kt == cqx);
                        const float tsc = xiA * __builtin_amdgcn_exp2f(lg2 * 64.0f * (float)(own ? 0 : cqx - kt - 1));
                        f32x16 S;
#pragma unroll
                        for (int r2 = 0; r2 < 16; ++r2) S[r2] = 0.f;
#pragma unroll
                        for (int ks = 0; ks < 4; ++ks) {
                            const f16x8 ka = *(const LAS f16x8*)(img + ((ks & 1) ? rbase1 : rbase0) + 512 * (ks >> 1));
                            S = mfma32(ka, qf[X][ks], S);
                        }
                        if (!own) {
                            const float f = tsc * (blk ? 1.0f : g32) * (X ? g32 : 1.0f);
#pragma unroll
                            for (int r2 = 0; r2 < 16; ++r2) S[r2] *= cf[r2] * f;
                        } else {
                            asm volatile("" ::: "memory");
#pragma unroll
                            for (int r2 = 0; r2 < 16; ++r2) {
                                const int mk = 32 * blk + 4 * h + (r2 & 3) + 8 * (r2 >> 2);
                                S[r2] *= __builtin_amdgcn_exp2f(lg2 * fabsf((float)(32 * X + q - mk)));
                            }
                        }
                        f16x8 pk[2];
#pragma unroll
                        for (int s2 = 0; s2 < 2; ++s2)
#pragma unroll
                            for (int j2 = 0; j2 < 8; ++j2) pk[s2][j2] = (_Float16)S[8 * s2 + j2];
#pragma unroll
                        for (int s2 = 0; s2 < 2; ++s2)
#pragma unroll
                            for (int dt = 0; dt < 2; ++dt) {
                                const int ct = 2 + dt;
                                const f16x4 v0 = vtr(img + tbase0 + 4096 * s2 + 512 * ct);
                                const f16x4 v1 = vtr(img + tbase1 + 4096 * s2 + 512 * ct);
                                const f16x8 va = (f16x8){v0[0], v0[1], v0[2], v0[3], v1[0], v1[1], v1[2], v1[3]};
                                O[X][dt] = mfma32(va, pk[s2], O[X][dt]);
                            }
                        __builtin_amdgcn_sched_barrier(0);
                    }
                }
            }
            }
            DSA_WAIT_BAR(0);
            slot ^= 1;
        }
        const dsa::f32x4 rn0 = *(const dsa::f32x4*)(ret_norm + 64 * hd + 8 * sch), rn1 = *(const dsa::f32x4*)(ret_norm + 64 * hd + 8 * sch + 4);
#pragma unroll
        for (int X = 0; X < 2; ++X) {
            float s1 = 0.f;
#pragma unroll
            for (int dt = 0; dt < 2; ++dt)
#pragma unroll
                for (int r = 0; r < 16; ++r) s1 += O[X][dt][r];
            s1 = hsum32(s1);
            const float mu = s1 * (1.0f / 64.0f);
            float s2v = 0.f;
#pragma unroll
            for (int dt = 0; dt < 2; ++dt)
#pragma unroll
                for (int r = 0; r < 16; ++r) { const float d = O[X][dt][r] - mu; s2v += d * d; }
            s2v = hsum32(s2v);
            const float rstd = rsqrtf(s2v * (1.0f / 64.0f) + EPS);
#pragma unroll
            for (int dt = 0; dt < 2; ++dt)
#pragma unroll
                for (int r4 = 0; r4 < 4; ++r4) {
                    const int d0 = 32 * dt + 8 * r4 + 4 * h;
                    f16x4 o4;
#pragma unroll
                    for (int e = 0; e < 4; ++e) o4[e] = (_Float16)((O[X][dt][4 * r4 + e] - mu) * rstd);
                    *(LAS f16x4*)(stg + q * 144 + 2 * d0) = o4;
                }
            asm volatile("s_waitcnt lgkmcnt(0)" ::: "memory");
#pragma unroll
            for (int i2 = 0; i2 < 4; ++i2) {
                const int row = 32 * X + 8 * i2 + srow;
                const f16x8 y = *(const LAS f16x8*)(stg + (8 * i2 + srow) * 144 + 16 * sch);
                const f16x8 gt = *(const f16x8*)(pb + ((X ? growb : growa) + (unsigned)(row * NP + C_RG + 64 * hd + 8 * sch)));
                f16x8 o8;
#pragma unroll
                for (int e = 0; e < 4; ++e) { o8[e] = (_Float16)((float)y[e] * rn0[e] * (float)gt[e]); o8[4 + e] = (_Float16)((float)y[4 + e] * rn1[e] * (float)gt[4 + e]); }
                *(f16x8*)(mix + ((size_t)b * SEQ + 64 * (X ? cqb : cqa) + row) * DM + 64 * hd + 8 * sch) = o8;
            }
            asm volatile("s_waitcnt lgkmcnt(0)" ::: "memory");
            __builtin_amdgcn_sched_barrier(0);
        }
    }
}
}
__device__ __forceinline__ void final_norm(float* out, const h16* x2h, const float* ssq2, const float* g, int G, int bx, int lane, int wave, const float* dbgleak) {
    const int gw = bx * NWAVES + wave, NGW = G * NWAVES;
    f32x4 gg[4];
#pragma unroll
    for (int j = 0; j < 4; ++j) gg[j] = ((const f32x4*)g)[2 * lane + 128 * (j >> 1) + (j & 1)];
    for (int row0 = 4 * gw; row0 < MTOK; row0 += 4 * NGW) {
        h16x8 v[4][2]; float rs[4];
#pragma unroll
        for (int rr = 0; rr < 4; ++rr) {
            const h16x8* xr = (const h16x8*)(x2h + (size_t)(row0 + rr) * DM);
            v[rr][0] = xr[lane]; v[rr][1] = xr[lane + 64]; rs[rr] = ssq2[row0 + rr];
        }
#pragma unroll
        for (int rr = 0; rr < 4; ++rr) {
            const int row = row0 + rr;
            const float rstd = rsqrtf(rs[rr] * (1.0f / DM) + EPS);
            f32x4* orow = (f32x4*)(out + (size_t)row * DM);
#pragma unroll
            for (int k = 0; k < 2; ++k) {
                f32x4 o0, o1;
#pragma unroll
                for (int e2 = 0; e2 < 4; ++e2) { o0[e2] = (float)v[rr][k][e2] * gg[2 * k][e2] * rstd; o1[e2] = (float)v[rr][k][4 + e2] * gg[2 * k + 1][e2] * rstd; }
#ifdef PROBE_LEAK
                if (row == 0 && lane == 0 && k == 0) o0[0] += dbgleak[0];
#endif
                orow[2 * lane + 128 * k] = o0; orow[2 * lane + 128 * k + 1] = o1;
            }
        }
    }
}

#ifndef EN_P0
#define EN_P0 1
#endif
#ifndef EN_P1
#define EN_P1 1
#endif
#ifndef EN_P1B
#define EN_P1B 1
#endif
#ifndef EN_RET
#define EN_RET 1
#endif
#ifndef EN_DSA
#define EN_DSA 1
#endif
#ifndef EN_P3A
#define EN_P3A 1
#endif
#ifndef EN_P3B
#define EN_P3B 1
#endif
#ifndef EN_P4
#define EN_P4 1
#endif
#ifndef EN_P5
#define EN_P5 1
#endif
#ifndef REP_P0
#define REP_P0 1
#endif
#ifndef REP_P1
#define REP_P1 1
#endif
#ifndef REP_RET
#define REP_RET 1
#endif
#ifndef REP_SEL
#define REP_SEL 1
#endif
#ifndef REP_ATT
#define REP_ATT 1
#endif
#if defined(PROBE_BAR)
#define XBAR(i) do { unsigned long long tb1_ = 0; if ((i) == PROBE_BAR) tb1_ = __builtin_amdgcn_s_memrealtime(); xcd_barrier(bar); \
        if ((i) == PROBE_BAR && threadIdx.x == 0) ((float*)(ws + WS_CTL) + 140100)[bx] = (float)(__builtin_amdgcn_s_memrealtime() - tb1_) * 0.001f; } while (0)
#else
#define XBAR(i) xcd_barrier(bar)
#endif
__global__ void __launch_bounds__(NTHR, 2) mega_fwd(Args a) {
    extern __shared__ __attribute__((aligned(16))) unsigned char lds_raw[];
    LAS unsigned char* lds = (LAS unsigned char*)lds_raw;
    volatile LAS unsigned* MISC = (volatile LAS unsigned*)(lds + MISC_OFF);
    const int wave = __builtin_amdgcn_readfirstlane((int)threadIdx.x >> 6);
    const int G = gridDim.x, bx = blockIdx.x;
#define PHASE_IDS() unsigned lz_ = 0u; asm volatile("" : "+v"(lz_)); int lane = (int)__builtin_amdgcn_mbcnt_hi(~0u, __builtin_amdgcn_mbcnt_lo(~0u, lz_)); asm volatile("" : "+v"(lane)); const int tid = wave * 64 + lane; (void)tid
    { PHASE_IDS();
    for (int u = tid; u < (LDS_BYTES - LDSCTL_OFF) / 4; u += NTHR) ((LAS unsigned*)(lds + LDSCTL_OFF))[u] = 0u; }
    __syncthreads();
    unsigned char* ws = a.ws;
    unsigned* ctl = (unsigned*)(ws + WS_CTL);
    float* ssq1 = (float*)(ws + WS_CTL); float* ssq2 = ssq1 + MTOK;
    const float2* tab = (const float2*)(ws + WS_TAB);
    h16* WinT = (h16*)(ws + WS_WIN); h16* WoutT = (h16*)(ws + WS_WOUT); h16* WgT = (h16*)(ws + WS_WG); h16* WpT = (h16*)(ws + WS_WP);
    h16* A0 = (h16*)(ws + WS_A0); h16* P16 = (h16*)(ws + WS_P16); h16* proj = (h16*)(ws + WS_PROJ); h16* mix = (h16*)(ws + WS_MIX); h16* pp = (h16*)(ws + WS_PP);
    h16* x1h = proj;
    h16* x2h = proj + (size_t)MTOK * DM;
    const float* rnorm = (const float*)(ws + WS_CTL) + 3 * MTOK;
    XcdBarrier bar = xcd_barrier_post(ctl + CW_BAR, MISC + 8);

#if EN_P0
    for (int rep = 0; rep < REP_P0; ++rep) { PHASE_IDS(); p0_prologue(a, lds, G, bx, tid, lane, wave); __syncthreads(); }
#endif
    XBAR(0);

#if EN_P1
    for (int rep = 0; rep < REP_P1; ++rep) {
        pg8::Gemm g{(const pg8::bf16_t*)A0, (const pg8::bf16_t*)WinT, MTOK, NP, DM, true};
#if defined(PROBE_GEMMWAIT) && !defined(PROBE_G4)
        g.dbg = (float*)(ws + WS_CTL) + 140000;
#endif
        pg8::StaticOrder S; S.init(MTOK, NP, G, bx);
        pg8::EpiProj E{proj, tab, a.kv_norm, (PG8_LAS float*)(lds + L_CKVSS)};
#ifdef STAGGER
        { const int k_ = (bx >> 3) & 3; for (int i_ = 0; i_ < k_ * STAGGER; ++i_) __builtin_amdgcn_s_sleep(127); }
#endif
#if defined(PROBE_CLK) && PROBE_CLK == 1
        const unsigned long long ck0 = __builtin_amdgcn_s_memtime(), cr0 = __builtin_amdgcn_s_memrealtime();
#endif
        pg8::gemm_phase<pg8::EpiProj, pg8::StaticOrder, true, true>(lds, g, S, E, wave);
#if defined(PROBE_CLK) && PROBE_CLK == 1
        if (bx == 0 && threadIdx.x == 0) { const unsigned long long ck1 = __builtin_amdgcn_s_memtime(), cr1 = __builtin_amdgcn_s_memrealtime(); ((float*)(ws + WS_CTL) + 140000)[0] = 10.0f * 0.1f * (float)(ck1 - ck0) / (float)(cr1 - cr0); }
#endif
    }
#endif
    XBAR(1);

#if EN_P1B && !FUSE_CKV
    { PHASE_IDS(); fix_ckv(proj, a.kv_norm, G, bx, lane, wave); }
    XBAR(2);
#endif
#if defined(PROBE_P2IDLE) || defined(PROBE_P2STAT)
    const unsigned long long p2_t0 = __builtin_amdgcn_s_memtime();
#endif

#if EN_RET && !RET_DYN
    for (int rep = 0; rep < REP_RET; ++rep) { PHASE_IDS(); for (int u = bx; u < BATCH * 8; u += G) ret2::retention_unit(lds, u >> 3, u & 7, proj, a.ret_norm, mix, lane, wave); }
#endif
#if EN_DSA && DYN_TAIL
    {
    constexpr int NS = DYN_NS, NB_T = BATCH - 4 * NS, NQ = NB_T * 64;
    unsigned* maskg = (unsigned*)(ws + WS_MASK);
    int tb = 0, tqb = 0;
    for (int step = 0;; ++step) {
        int mode, b, qb;
        if (step < 2 * NS) { const int j = step < NS ? step : step - NS, qq_ = ((bx & 63) + 16 * (j >> 1)) & 63; mode = step < NS ? 0 : 1; b = (bx >> 6) + 4 * j; qb = (j & 1) ? 63 - qq_ : qq_; }
        else if (((step - 2 * NS) & 1) == 0) {
            if (threadIdx.x == 0) MISC[12] = __hip_atomic_fetch_add(ctl + CW_QUEUE, 1u, __ATOMIC_RELAXED, __HIP_MEMORY_SCOPE_AGENT);
            __syncthreads(); const unsigned kq = MISC[12]; __syncthreads();
            if (kq >= (unsigned)NQ) break;
            tb = 4 * NS + (int)(kq % (unsigned)NB_T); tqb = 63 - (int)(kq / (unsigned)NB_T); mode = 0; b = tb; qb = tqb;
        } else { mode = 1; b = tb; qb = tqb; }
        if (mode == 0) { if (qb >= 8) { PHASE_IDS(); dsa::dsa_select_unit(lds, b, qb, proj, (float*)(ws + WS_SCR) + (size_t)bx * (32 * 2048), maskg, tid, lane, wave); } __syncthreads(); }
        else { PHASE_IDS(); int sb0_ = 0; dsa::dsa_attn_unit(lds, b, qb, proj, maskg, (const h16*)(ws + WS_WUK), (const h16*)(ws + WS_WUV), mix, tid, lane, wave, (float*)(ws + WS_CTL) + 140000, sb0_); __syncthreads(); }
    }
    }
#elif EN_DSA
    for (int rep = 0; rep < REP_SEL; ++rep) { PHASE_IDS();
    unsigned* maskg = (unsigned*)(ws + WS_MASK);
    for (int j = 0; j < 8; ++j) {
        const int b = (bx >> 6) + 4 * j, qq_ = ((bx & 63) + 16 * (j >> 1)) & 63, qb = (j & 1) ? 63 - qq_ : qq_;
        if (qb >= 8) dsa::dsa_select_unit(lds, b, qb, proj, (float*)(ws + WS_SCR) + (size_t)bx * (32 * 2048), maskg, tid, lane, wave);
    } }
    __syncthreads();
    for (int rep = 0; rep < REP_ATT; ++rep) { PHASE_IDS();
#if defined(PROBE_ATTLOOP) || defined(PROBE_ATTWAIT) || defined(PROBE_ATTSEG)
    const unsigned long long t_att0 = __builtin_amdgcn_s_memtime();
#endif
    const unsigned* maskg = (const unsigned*)(ws + WS_MASK);
    int sbase_ = 0;
    for (int j = 0; j < 8; ++j) {
        const int b = (bx >> 6) + 4 * j, qq_ = ((bx & 63) + 16 * (j >> 1)) & 63, qb = (j & 1) ? 63 - qq_ : qq_;
        dsa::dsa_attn_unit(lds, b, qb, proj, maskg, (const h16*)(ws + WS_WUK), (const h16*)(ws + WS_WUV), mix, tid, lane, wave, (float*)(ws + WS_CTL) + 140000, sbase_);
    }
    __syncthreads();
#if defined(PROBE_ATTLOOP) || defined(PROBE_ATTSEG)
    if (bx == 0 && wave == 0 && lane == 0) { float* dbg = (float*)(ws + WS_CTL) + 140000; dbg[0] = 50.0f * dbg[1] / (float)(__builtin_amdgcn_s_memtime() - t_att0); }
#endif
#ifdef PROBE_ATTWAIT
    if (bx == 0 && wave == PROBE_ATTWAIT - 1 && lane == 0) { float* dbg = (float*)(ws + WS_CTL) + 140000; dbg[0] = 50.0f * dbg[2] / (float)(__builtin_amdgcn_s_memtime() - t_att0); }
#endif
    }
#endif
#if EN_RET && RET_DYN
    {
        __syncthreads();
        unsigned nx = 0u;
        if (threadIdx.x == 0) MISC[12] = __hip_atomic_fetch_add(ctl + CW_QUEUE, 1u, __ATOMIC_RELAXED, __HIP_MEMORY_SCOPE_AGENT);
        __syncthreads();
        unsigned kq = MISC[12];
        while (kq < 1024u + (P16_TAIL ? 1024u : 0u)) {
            if (threadIdx.x == 0) nx = __hip_atomic_fetch_add(ctl + CW_QUEUE, 1u, __ATOMIC_RELAXED, __HIP_MEMORY_SCOPE_AGENT);
            if (kq < 1024u) { PHASE_IDS(); const int g = 3 - (int)(kq >> 8), u = (int)(kq & 255u); ret2::retention_unit(lds, u >> 3, u & 7, proj, a.ret_norm, mix, lane, wave, g, g + 1); }
#if P16_TAIL
            else {
                PHASE_IDS();
                const size_t base = (size_t)(kq - 1024u) * 4096 + tid;
                f32x4 v[8];
#pragma unroll
                for (int u2 = 0; u2 < 8; ++u2) v[u2] = ((const f32x4*)a.p)[base + (size_t)u2 * NTHR];
#pragma unroll
                for (int u2 = 0; u2 < 8; ++u2) { h16x4 o; o[0] = (h16)v[u2][0]; o[1] = (h16)v[u2][1]; o[2] = (h16)v[u2][2]; o[3] = (h16)v[u2][3]; ((h16x4*)P16)[base + (size_t)u2 * NTHR] = o; }
            }
#endif
            __syncthreads();
            if (threadIdx.x == 0) MISC[12] = nx;
            __syncthreads();
            kq = MISC[12];
        }
    }
#endif
#if defined(PROBE_P2IDLE) || defined(PROBE_P2STAT)
    const unsigned long long p2_t1 = __builtin_amdgcn_s_memtime();
#endif
    XBAR(3);
#if defined(PROBE_P2IDLE)
    if (bx == PROBE_P2IDLE - 1 && threadIdx.x == 0) { const unsigned long long p2_t2 = __builtin_amdgcn_s_memtime(); ((float*)(ws + WS_CTL) + 140000)[0] = 50.0f * (float)(p2_t2 - p2_t1) / (float)(p2_t2 - p2_t0); }
#endif
#if defined(PROBE_P2STAT)
    if (threadIdx.x == 0) { const unsigned long long p2_t2 = __builtin_amdgcn_s_memtime(); ((float*)(ws + WS_CTL) + 140100)[bx] = 50.0f * (float)(p2_t2 - p2_t1) / (float)(p2_t2 - p2_t0); }
#endif

#if EN_P3A
    {
        pg8::Gemm g{(const pg8::bf16_t*)mix, (const pg8::bf16_t*)WoutT, MTOK, DM, DM, false}; pg8::StaticOrder S; S.init(MTOK, DM, G, bx);
        pg8::EpiOut E{A0, rnorm, a.norm_mix, x1h, ssq1};
        pg8::gemm_phase<pg8::EpiOut, pg8::StaticOrder, true, true>(lds, g, S, E, wave);
    }
#endif
    __syncthreads();
#if EN_P3B
    {
        int kp = PLE; asm volatile("" : "+s"(kp));
        pg8::Gemm g{(const pg8::bf16_t*)P16, (const pg8::bf16_t*)WpT, MTOK, DM, kp, false}; pg8::StaticOrder S; S.init(MTOK, DM, G, bx);
        pg8::EpiPle E{pp};
        pg8::gemm_phase<pg8::EpiPle, pg8::StaticOrder, true, true>(lds, g, S, E, wave);
    }
#endif
    XBAR(4);

#if EN_P4
    {
        pg8::Gemm g{(const pg8::bf16_t*)x1h, (const pg8::bf16_t*)WgT, MTOK, DM, DM, false};
#if defined(PROBE_GEMMWAIT) && defined(PROBE_G4)
        g.dbg = (float*)(ws + WS_CTL) + 140000;
#endif
        pg8::StaticOrder S; S.init(MTOK, DM, G, bx);
        pg8::EpiGate E{x1h, pp, ssq1, x2h, ssq2};
        pg8::gemm_phase<pg8::EpiGate, pg8::StaticOrder, true, true>(lds, g, S, E, wave);
    }
#endif
    XBAR(5);

#if EN_P5
#if defined(PROBE_P2STAT) || defined(PROBE_BAR)
#ifndef PROBE_P2STAT
#define PROBE_P2STAT 1
#endif
    if (threadIdx.x == 0) { const float* st_ = (const float*)(ws + WS_CTL) + 140100; float mn = 1e9f, mx = -1e9f, sm = 0.f; for (int i = 0; i < 256; ++i) { const float v = st_[i]; mn = fminf(mn, v); mx = fmaxf(mx, v); sm += v; }
        ((float*)(ws + WS_CTL) + 140000)[0] = PROBE_P2STAT == 1 ? sm * (1.0f / 256.0f) : (PROBE_P2STAT == 2 ? mx : mn); }
    asm volatile("s_waitcnt vmcnt(0)" ::: "memory"); __syncthreads();
#endif
    { PHASE_IDS(); final_norm(a.out, x2h, ssq2, a.norm_final, G, bx, lane, wave, (const float*)(ws + WS_CTL) + 140000); }
#endif
}

extern "C" void kernel_launch(void* const* d_in, const int* in_sizes, int n_in, void* d_out, int out_size, void* d_ws, size_t ws_size, hipStream_t stream) {
    static int grid = 0;
    if (grid == 0) {
        if (n_in != 14 || ws_size < WS_END) { fprintf(stderr, "kernel_launch: unexpected inputs (n_in %d, ws %zu)\n", n_in, ws_size); grid = -1; return; }
        int dev = 0, cus = 0;
        if (hipGetDevice(&dev) != hipSuccess || hipDeviceGetAttribute(&cus, hipDeviceAttributeMultiprocessorCount, dev) != hipSuccess) { grid = -1; return; }
        if (hipFuncSetAttribute((const void*)mega_fwd, hipFuncAttributeMaxDynamicSharedMemorySize, LDS_BYTES) != hipSuccess) { fprintf(stderr, "kernel_launch: hipFuncSetAttribute failed\n"); grid = -1; return; }
        int nb = 0;
        if (hipOccupancyMaxActiveBlocksPerMultiprocessor(&nb, (const void*)mega_fwd, NTHR, LDS_BYTES) != hipSuccess || nb < 1) { fprintf(stderr, "kernel_launch: occupancy query failed (%d blocks per CU)\n", nb); grid = -1; return; }
        if (cus != 256) { fprintf(stderr, "kernel_launch: the mixer unit deal is written for 256 CUs (found %d)\n", cus); grid = -1; return; }
        grid = cus;
    }
    if (grid < 0) return;
    if (hipMemsetAsync((char*)d_ws + WS_CTL, 0, CTL_BYTES, stream) != hipSuccess) return;
    Args a{};
    a.x = (const float*)d_in[0]; a.p = (const float*)d_in[1]; a.pos = (const int*)d_in[2]; a.norm_mix = (const float*)d_in[3]; a.w_in = (const float*)d_in[4];
    a.ret_norm = (const float*)d_in[5]; a.kv_norm = (const float*)d_in[6]; a.w_uk = (const float*)d_in[7]; a.w_uv = (const float*)d_in[8]; a.w_out = (const float*)d_in[9];
    a.norm_ple = (const float*)d_in[10]; a.w_ple_gate = (const float*)d_in[11]; a.w_ple_proj = (const float*)d_in[12]; a.norm_final = (const float*)d_in[13];
    a.out = (float*)d_out; a.ws = (unsigned char*)d_ws;
    hipLaunchKernelGGL(mega_fwd, dim3(grid), dim3(NTHR), LDS_BYTES, stream, a);
}
```
